# Optimizing an MI355X kernel written in HIP

```python
import jax
import jax.numpy as jnp
from jax import lax
import numpy as np

D_MODEL = 2048
BATCH = 4
SEQ = 8192
DEPTH = 1

PLE_DIM = 256
EPS = 1e-6

ML_HEADS = 8
ML_DQK = 128
ML_DV = 256
ML_CHUNK = 64
GATE_CAP = 15.0
FGATE_BIAS = 3.0

SW_HEADS = 32
SW_KV_HEADS = 4
SW_GROUP = SW_HEADS // SW_KV_HEADS
SW_HD = 64
WINDOW = 128
SW_BLOCK = WINDOW

N_EXPERTS = 32
TOP_K = 4
D_FF = D_MODEL
SWIGLU_LIMIT = 7.0
SWIGLU_ALPHA = 1.702
MOE_BLOCK = 128

ML_QK_W = ML_HEADS * ML_DQK
ML_V_W = ML_HEADS * ML_DV
SW_Q_W = SW_HEADS * SW_HD
SW_KV_W = SW_KV_HEADS * SW_HD
IN_SIZES = (ML_QK_W, ML_QK_W, ML_V_W, ML_V_W, ML_HEADS, ML_HEADS, SW_Q_W, SW_KV_W, SW_KV_W, D_MODEL, D_MODEL)
D_IN = sum(IN_SIZES)

kernel_name = 'hybrid_mlstm_swa_moe_block'


def rms_norm(x, w):
    xf = x.astype(jnp.float32)
    y = xf * lax.rsqrt(jnp.mean(xf * xf, axis=-1, keepdims=True) + EPS)
    return (y * w.astype(jnp.float32)).astype(x.dtype)


def alibi_slopes(n_heads):
    return 2.0 ** (-8.0 * jnp.arange(1, n_heads + 1, dtype=jnp.float32) / n_heads)


def mlstm_branch(q, k, v, o_pre, i_pre, f_pre, norm_w):
    f32 = jnp.float32
    B, S = q.shape[0], q.shape[1]
    nc = S // ML_CHUNK

    def chunks(a, d):
        return a.astype(f32).reshape(B, nc, ML_CHUNK, ML_HEADS, d).transpose(1, 0, 3, 2, 4)

    def gate_chunks(a):
        return a.reshape(B, nc, ML_CHUNK, ML_HEADS).transpose(1, 0, 3, 2)

    qc = chunks(q, ML_DQK) * (ML_DQK ** -0.5)
    kc = chunks(k, ML_DQK)
    vc = chunks(v, ML_DV)
    log_i = gate_chunks(GATE_CAP * jnp.tanh(i_pre.astype(f32) / GATE_CAP))
    log_f = gate_chunks(jax.nn.log_sigmoid(GATE_CAP * jnp.tanh(f_pre.astype(f32) / GATE_CAP)))
    causal = jnp.tril(jnp.ones((ML_CHUNK, ML_CHUNK), dtype=bool))

    def step(carry, xs):
        C, n, m = carry
        qb, kb, vb, li, lf = xs
        b = jnp.cumsum(lf, axis=-1)
        g = b[..., -1]
        log_d = jnp.where(causal, b[..., :, None] - b[..., None, :] + li[..., None, :], -jnp.inf)
        log_inter = b + m[..., None]
        m_row = jnp.maximum(log_inter, log_d.max(axis=-1))
        inter = jnp.exp(log_inter - m_row)
        s = jnp.einsum('bhid,bhjd->bhij', qb, kb) * jnp.exp(log_d - m_row[..., None])
        num = jnp.einsum('bhij,bhjv->bhiv', s, vb) + inter[..., None] * jnp.einsum('bhid,bhdv->bhiv', qb, C)
        den = s.sum(axis=-1) + inter * jnp.einsum('bhid,bhd->bhi', qb, n)
        h = num / jnp.maximum(jnp.abs(den), jnp.exp(-m_row))[..., None]
        log_w = g[..., None] - b + li
        m_new = jnp.maximum(g + m, log_w.max(axis=-1))
        w = jnp.exp(log_w - m_new[..., None])
        decay = jnp.exp(g + m - m_new)
        C_new = decay[..., None, None] * C + jnp.einsum('bhj,bhjd,bhjv->bhdv', w, kb, vb)
        n_new = decay[..., None] * n + jnp.einsum('bhj,bhjd->bhd', w, kb)
        return (C_new, n_new, m_new), h

    init = (jnp.zeros((B, ML_HEADS, ML_DQK, ML_DV), f32),
            jnp.zeros((B, ML_HEADS, ML_DQK), f32),
            jnp.zeros((B, ML_HEADS), f32))
    _, h = lax.scan(step, init, (qc, kc, vc, log_i, log_f))
    h = h.transpose(1, 0, 3, 2, 4).reshape(B, S, ML_HEADS, ML_DV)
    h = h * lax.rsqrt(jnp.mean(h * h, axis=-1, keepdims=True) + EPS) * norm_w.astype(f32).reshape(ML_HEADS, ML_DV)
    h = h.reshape(B, S, ML_V_W) * jax.nn.sigmoid(o_pre.astype(f32))
    return h.astype(q.dtype)


def swa_branch(q, k, v, q_norm_w, k_norm_w, sinks):
    f32 = jnp.float32
    B, S = q.shape[0], q.shape[1]
    nb = S // SW_BLOCK
    q = rms_norm(q.reshape(B, S, SW_HEADS, SW_HD), q_norm_w)
    k = rms_norm(k.reshape(B, S, SW_KV_HEADS, SW_HD), k_norm_w)
    v = v.reshape(B, S, SW_KV_HEADS, SW_HD)
    qb = q.reshape(B, nb, SW_BLOCK, SW_KV_HEADS, SW_GROUP, SW_HD)

    def band(a):
        a = a.reshape(B, nb, SW_BLOCK, SW_KV_HEADS, SW_HD)
        prev = jnp.pad(a[:, :-1], ((0, 0), (1, 0), (0, 0), (0, 0), (0, 0)))
        return jnp.concatenate([prev, a], axis=2)

    kb, vb = band(k), band(v)
    scores = jnp.einsum('bnqhgd,bnkhd->bnhgqk', qb, kb).astype(f32) * (SW_HD ** -0.5)
    q_pos = jnp.arange(SW_BLOCK)[:, None] + SW_BLOCK
    k_pos = jnp.arange(2 * SW_BLOCK)[None, :]
    dist = q_pos - k_pos
    in_window = (dist >= 0) & (dist < WINDOW)
    has_prev = (jnp.arange(nb) > 0)[:, None, None] | (k_pos >= SW_BLOCK)[None]
    mask = (in_window[None] & has_prev)[None, :, None, None]
    slopes = alibi_slopes(SW_HEADS).reshape(SW_KV_HEADS, SW_GROUP)
    scores = scores - slopes[:, :, None, None] * dist.astype(f32)
    scores = jnp.where(mask, scores, -jnp.inf)
    sink = sinks.astype(f32).reshape(SW_KV_HEADS, SW_GROUP, 1, 1)
    m = jnp.maximum(scores.max(axis=-1, keepdims=True), sink)
    e = jnp.exp(scores - m)
    probs = e / (e.sum(axis=-1, keepdims=True) + jnp.exp(sink - m))
    out = jnp.einsum('bnhgqk,bnkhd->bnqhgd', probs.astype(v.dtype), vb)
    return out.reshape(B, S, SW_Q_W)


def moe_ffn(xn, w_router, b_router, w_up, b_up, w_down, b_down):
    B, S, D = xn.shape
    T = B * S
    xt = xn.reshape(T, D)
    logits = (xt @ w_router + b_router).astype(jnp.float32)
    top_val, top_idx = lax.top_k(logits, TOP_K)
    gates = jax.nn.softmax(top_val, axis=-1).astype(xn.dtype)
    flat_e = top_idx.reshape(-1)
    flat_tok = jnp.repeat(jnp.arange(T, dtype=jnp.int32), TOP_K)
    flat_g = gates.reshape(-1)
    order = jnp.argsort(flat_e)
    e_sorted, tok_sorted, g_sorted = flat_e[order], flat_tok[order], flat_g[order]
    counts = jnp.bincount(flat_e, length=N_EXPERTS)
    starts = jnp.cumsum(counts) - counts
    padded = (counts + MOE_BLOCK - 1) // MOE_BLOCK * MOE_BLOCK
    pad_ends = jnp.cumsum(padded)
    pad_starts = pad_ends - padded
    dest = pad_starts[e_sorted] + (jnp.arange(T * TOP_K) - starts[e_sorted])
    P = T * TOP_K + N_EXPERTS * MOE_BLOCK
    n_blocks = P // MOE_BLOCK
    buf_tok = jnp.zeros((P,), jnp.int32).at[dest].set(tok_sorted)
    buf_g = jnp.zeros((P,), xn.dtype).at[dest].set(g_sorted)
    block_e = jnp.minimum(jnp.searchsorted(pad_ends, jnp.arange(n_blocks) * MOE_BLOCK, side='right'), N_EXPERTS - 1)

    def expert_block(args):
        tok, g, e = args
        hb = xt[tok] @ w_up[e] + b_up[e]
        h_glu, h_lin = jnp.split(hb, 2, axis=-1)
        h_glu = jnp.minimum(h_glu, SWIGLU_LIMIT)
        h_lin = jnp.clip(h_lin, -SWIGLU_LIMIT, SWIGLU_LIMIT)
        act = h_glu * jax.nn.sigmoid(SWIGLU_ALPHA * h_glu) * (h_lin + 1.0)
        return (act @ w_down[e] + b_down[e]) * g[:, None]

    ys = lax.map(expert_block, (buf_tok.reshape(n_blocks, MOE_BLOCK), buf_g.reshape(n_blocks, MOE_BLOCK), block_e))
    out = jnp.zeros_like(xt).at[buf_tok].add(ys.reshape(P, D))
    return out.reshape(B, S, D)


def setup_inputs(seed: int = 0) -> dict:
    key = jax.random.key(seed)
    ks = jax.random.split(key, 24)
    f32 = jnp.float32
    nrm = lambda k, shape, scale: jax.random.normal(k, shape, f32) * scale
    gain = lambda k, shape: 1.0 + 0.05 * jax.random.normal(k, shape, f32)
    return {
        'x': nrm(ks[0], (BATCH, SEQ, D_MODEL), 1.0),
        'p': nrm(ks[1], (DEPTH, BATCH, SEQ, PLE_DIM), 1.0),
        'norm_mix_w': gain(ks[2], (DEPTH, D_MODEL)),
        'w_in': nrm(ks[3], (DEPTH, D_MODEL, D_IN), D_MODEL ** -0.5),
        'ml_igate_b': nrm(ks[4], (DEPTH, ML_HEADS), 0.1),
        'ml_fgate_b': FGATE_BIAS + nrm(ks[5], (DEPTH, ML_HEADS), 0.1),
        'ml_norm_w': gain(ks[6], (DEPTH, ML_V_W)),
        'sw_q_norm_w': gain(ks[7], (DEPTH, SW_HD)),
        'sw_k_norm_w': gain(ks[8], (DEPTH, SW_HD)),
        'sw_sinks': nrm(ks[9], (DEPTH, SW_HEADS), 0.5),
        'w_branch_a': nrm(ks[10], (DEPTH, ML_V_W, D_MODEL), ML_V_W ** -0.5),
        'w_branch_b': nrm(ks[11], (DEPTH, SW_Q_W, D_MODEL), SW_Q_W ** -0.5),
        'w_out': nrm(ks[12], (DEPTH, D_MODEL, D_MODEL), D_MODEL ** -0.5),
        'norm_ffn_w': gain(ks[13], (DEPTH, D_MODEL)),
        'w_router': nrm(ks[14], (DEPTH, D_MODEL, N_EXPERTS), D_MODEL ** -0.5),
        'b_router': nrm(ks[15], (DEPTH, N_EXPERTS), 0.01),
        'w_expert_up': nrm(ks[16], (DEPTH, N_EXPERTS, D_MODEL, 2 * D_FF), D_MODEL ** -0.5),
        'b_expert_up': nrm(ks[17], (DEPTH, N_EXPERTS, 2 * D_FF), 0.02),
        'w_expert_down': nrm(ks[18], (DEPTH, N_EXPERTS, D_FF, D_MODEL), D_FF ** -0.5),
        'b_expert_down': nrm(ks[19], (DEPTH, N_EXPERTS, D_MODEL), 0.02),
        'norm_ple_w': gain(ks[20], (DEPTH, D_MODEL)),
        'w_ple_gate': nrm(ks[21], (DEPTH, D_MODEL, D_MODEL), D_MODEL ** -0.5),
        'w_ple_proj': nrm(ks[22], (DEPTH, PLE_DIM, D_MODEL), PLE_DIM ** -0.5),
    }


def reference(x, p, norm_mix_w, w_in, ml_igate_b, ml_fgate_b, ml_norm_w, sw_q_norm_w, sw_k_norm_w, sw_sinks,
              w_branch_a, w_branch_b, w_out, norm_ffn_w, w_router, b_router, w_expert_up, b_expert_up,
              w_expert_down, b_expert_down, norm_ple_w, w_ple_gate, w_ple_proj):
    split_points = np.cumsum(IN_SIZES)[:-1].tolist()
    h = x
    for i in range(DEPTH):
        xn = rms_norm(h, norm_mix_w[i])
        proj = xn @ w_in[i]
        (ml_q, ml_k, ml_v, ml_o, ml_i, ml_f, sw_q, sw_k, sw_v, g_a, g_b) = jnp.split(proj, split_points, axis=-1)
        y_a = mlstm_branch(ml_q, ml_k, ml_v, ml_o, ml_i + ml_igate_b[i], ml_f + ml_fgate_b[i], ml_norm_w[i]) @ w_branch_a[i]
        y_b = swa_branch(sw_q, sw_k, sw_v, sw_q_norm_w[i], sw_k_norm_w[i], sw_sinks[i]) @ w_branch_b[i]
        mixed = jax.nn.sigmoid(g_a) * y_a + jax.nn.sigmoid(g_b) * y_b
        h = h + mixed @ w_out[i]
        h = h + moe_ffn(rms_norm(h, norm_ffn_w[i]), w_router[i], b_router[i], w_expert_up[i], b_expert_up[i],
                        w_expert_down[i], b_expert_down[i])
        gate = jax.nn.sigmoid(rms_norm(h, norm_ple_w[i]) @ w_ple_gate[i])
        h = h + gate * (p[i] @ w_ple_proj[i])
    return h
```

```cpp
#include <hip/hip_runtime.h>
#include <cstdio>
#include <cstdint>

#ifndef MK_N_LAUNCHES
#define MK_N_LAUNCHES 1
#endif

#define GAS __attribute__((address_space(1)))
#define LAS __attribute__((address_space(3)))
typedef unsigned short bf16_t;
typedef short bf16x8 __attribute__((ext_vector_type(8)));
typedef short s16x4 __attribute__((ext_vector_type(4)));
typedef float f32x2 __attribute__((ext_vector_type(2)));
typedef float f32x4 __attribute__((ext_vector_type(4)));
typedef float f32x16 __attribute__((ext_vector_type(16)));
typedef unsigned u32x2 __attribute__((ext_vector_type(2)));
typedef unsigned u32x4 __attribute__((ext_vector_type(4)));

constexpr int BATCH = 4, SEQ = 8192, T = BATCH * SEQ, D = 2048;
constexpr int PLE = 256;
constexpr int NE = 32, TOPK = 4, DFF = 2048, CAP = T;
constexpr int NPROJ = 13056;
constexpr int C_MLQ = 0, C_MLK = 1024, C_MLV = 2048, C_MLO = 4096, C_SWQ = 6144, C_SWK = 8192, C_SWV = 8448, C_GA = 8704, C_GB = 10752, C_GI = 12800, C_GF = 12808;
constexpr int DIN = 12816;
constexpr float EPS = 1e-6f;
constexpr float LOG2E = 1.4426950408889634f;
constexpr int ACT_ROWS = 139264;

constexpr size_t MiB = 1u << 20;
constexpr size_t WS_CTL = 0, CTL_ZERO_BYTES = 1 * MiB;
constexpr size_t WS_WIN = 2 * MiB;
constexpr size_t WS_WA = 54 * MiB, WS_WB = 62 * MiB, WS_WOUT = 70 * MiB, WS_WPG = 78 * MiB, WS_WPP = 86 * MiB, WS_WRP = 87 * MiB;
constexpr size_t WS_WUP = 96 * MiB;
constexpr size_t WS_WDN = 608 * MiB;
constexpr size_t WS_XN = 864 * MiB;
constexpr size_t WS_PROJ = 992 * MiB;
constexpr size_t WS_HML = 1808 * MiB;
constexpr size_t WS_ASW = 1936 * MiB;
constexpr size_t WS_YA = 2064 * MiB, WS_MIX = 2192 * MiB;
constexpr size_t WS_PBF = 2320 * MiB;
constexpr size_t WS_PP = 2336 * MiB;
constexpr size_t WS_ACT = 2464 * MiB;
constexpr size_t WS_YS = 3008 * MiB;
constexpr size_t WS_TOKL = 3520 * MiB, WS_GATEL = 3524 * MiB, WS_DESTL = 3528 * MiB, WS_RSL = 3532 * MiB;
constexpr size_t WS_END = 3536 * MiB;
constexpr int CW_TMO = 0, CW_CODE = 1;
constexpr int CW_BAR = 4096;
constexpr int CW_CUR = 16384;

constexpr int RING_BYTES = 131072;
constexpr int TAB_OFF = RING_BYTES;
constexpr int MISC_OFF = RING_BYTES + 8192;
constexpr int LDS_BYTES = 147456;
constexpr int NWAVES = 8;

#define RLX_AGENT __ATOMIC_RELAXED, __HIP_MEMORY_SCOPE_AGENT
#define LDS_WAIT() asm volatile("s_waitcnt lgkmcnt(0)" ::: "memory")
#define VM_WAIT() asm volatile("s_waitcnt vmcnt(0)" ::: "memory")

typedef __bf16 bf16x2_t __attribute__((ext_vector_type(2)));
__device__ __forceinline__ unsigned cvt_pk_bf16(float lo, float hi) { const f32x2 v = {lo, hi}; const bf16x2_t b = __builtin_convertvector(v, bf16x2_t); return __builtin_bit_cast(unsigned, b); }
__device__ __forceinline__ float bf_lo(unsigned w) { return __uint_as_float(w << 16); }
__device__ __forceinline__ float bf_hi(unsigned w) { return __uint_as_float(w & 0xffff0000u); }
__device__ __forceinline__ float bf1(bf16_t b) { return __uint_as_float(((unsigned)b) << 16); }
__device__ __forceinline__ float sigmoidf_(float x) { return 1.0f / (1.0f + __expf(-x)); }
__device__ __forceinline__ float wave_sum(float v) {
#pragma unroll
    for (int o = 1; o < 64; o <<= 1) v += __shfl_xor(v, o);
    return v;
}

namespace pg8 {
constexpr int BM = 256, BK = 64, HALF = 128, HTB = HALF * BK * 2, STAGE_BYTES = 8 * HTB, NXCD = 8, WGM = 8;
__host__ __device__ __forceinline__ int lds_byte(int r, int c) { const int st = (r >> 4) * 2 + (c >> 5), rr = r & 15, cc = c & 31, ob = rr * 64 + cc * 2; return st * 1024 + (ob ^ (((ob >> 9) & 1) << 5)); }
__host__ __device__ __forceinline__ void stage_rc(int b, int& R, int& C) { const int st = b / 1024, sb = b % 1024, swz = sb ^ (((sb >> 9) & 1) << 5); R = (st >> 1) * 16 + swz / 64; C = (st & 1) * 32 + (swz % 64) / 2; }
__host__ __device__ __forceinline__ int perm32(int rho) { const int n = rho >> 4, i = rho & 15; return 8 * (i >> 2) + 4 * n + (i & 3); }

struct Unit { int pm, pn, e, r0, cnt; };

__device__ __forceinline__ void map_unit(int L, int nM, int nN, int& pm, int& pn) {
    const int nwg = nM * nN;
    int wgid = L; { const int q = nwg / NXCD, r = nwg % NXCD, xcd = wgid % NXCD, off = wgid / NXCD; wgid = (xcd < r ? xcd * (q + 1) : r * (q + 1) + (xcd - r) * q) + off; }
    const int nig = WGM * nN, gid = wgid / nig, fm = gid * WGM, gsz = (nM - fm) < WGM ? (nM - fm) : WGM;
    pm = fm + ((wgid % nig) % gsz); pn = (wgid % nig) / gsz;
}

struct DenseSched {
    const bf16_t* A; const bf16_t* Bt; int nM, nN, G, c;
    __device__ __forceinline__ bool next(int i, Unit& u) const { const long L = (long)i * G + c; if (L >= (long)nM * nN) return false; map_unit((int)L, nM, nN, u.pm, u.pn); u.e = 0; u.r0 = 0; u.cnt = 0; return true; }
    __device__ __forceinline__ const char* a_base() const { return (const char*)A; }
    __device__ __forceinline__ void a_offs(const Unit& u, const int (&R)[2], const int (&C)[2], int K, unsigned (&vo)[2][2]) const {
#pragma unroll
        for (int h = 0; h < 2; ++h)
#pragma unroll
            for (int i = 0; i < 2; ++i) vo[h][i] = (unsigned)((u.pm * BM + h * HALF + R[i]) * K + C[i]) * 2u;
    }
    __device__ __forceinline__ const char* b_tile(const Unit& u, int K) const { return (const char*)Bt + (size_t)u.pn * BM * K * 2; }
};

template <class Epi, class Sched>
__device__ __forceinline__ void gemm_phase(LAS unsigned char* lds, const int K, const Sched& S, const Epi& E) {
    const int tid = threadIdx.x, wid = __builtin_amdgcn_readfirstlane(tid >> 6), lane = tid & 63, wr = wid >> 2, wc = wid & 3, fr = lane & 15, fq = lane >> 4;
    const int nt = K / BK;
    int Rr[2], Cc[2]; unsigned voffB[2];
#pragma unroll
    for (int i = 0; i < 2; ++i) { int R, C; stage_rc(tid * 16 + i * 8192, R, C); Rr[i] = R; Cc[i] = C; const int Rb = Epi::PERM ? ((R & ~31) + perm32(R & 31)) : R; voffB[i] = (unsigned)(Rb * K + C) * 2u; }
    const size_t kstep = (size_t)(BK * 2);
    const size_t hstep = (size_t)HALF * K * 2;
    const unsigned ldsw = (unsigned)wid * 1024u;
    const int aoff = lds_byte(wr * 64 + fr, fq * 8), boff = lds_byte(wc * 32 + fr, fq * 8);
#define PG8_SA(b, h) (((b) * 2 + (h)) * HTB)
#define PG8_SB(b, h) ((4 + (b) * 2 + (h)) * HTB)
#define PG8_STAGE(bufoff, gbase, voff) do { _Pragma("unroll") for (int _i = 0; _i < 2; ++_i) \
        __builtin_amdgcn_global_load_lds((const unsigned*)((const char*)(gbase) + (voff)[_i]), (LAS unsigned*)(lds + (bufoff) + ldsw + _i * 8192), 16, 0, 0); } while (0)
#define PG8_LDA(dst, b, h) do { _Pragma("unroll") for (int m = 0; m < 4; ++m) _Pragma("unroll") for (int k = 0; k < 2; ++k) dst[m][k] = *(const LAS bf16x8*)(lds + PG8_SA(b, h) + aoff + m * 2048 + k * 1024); } while (0)
#define PG8_LDB(dst, b, h) do { _Pragma("unroll") for (int n = 0; n < 2; ++n) _Pragma("unroll") for (int k = 0; k < 2; ++k) dst[n][k] = *(const LAS bf16x8*)(lds + PG8_SB(b, h) + boff + n * 2048 + k * 1024); } while (0)
#define PG8_MMA(ai, bj, At, Bt) do { __builtin_amdgcn_s_setprio(1); _Pragma("unroll") for (int m = 0; m < 4; ++m) _Pragma("unroll") for (int n = 0; n < 2; ++n) _Pragma("unroll") for (int k = 0; k < 2; ++k) \
        acc[ai][bj][m][n] = __builtin_amdgcn_mfma_f32_16x16x32_bf16(Bt[n][k], At[m][k], acc[ai][bj][m][n], 0, 0, 0); __builtin_amdgcn_s_setprio(0); } while (0)
#define PG8_WAIT_V(n) asm volatile("s_waitcnt vmcnt(" #n ")" ::: "memory")
#define PG8_WAIT_L(n) asm volatile("s_waitcnt lgkmcnt(" #n ")" ::: "memory")
#define PG8_BAR __builtin_amdgcn_s_barrier()
#define PG8_SCHED __builtin_amdgcn_sched_barrier(0)
    Unit cur, nxt; int ui = 0;
    if (!S.next(0, cur)) return;
    f32x4 acc[2][2][4][2];
#pragma unroll
    for (int a = 0; a < 2; ++a)
#pragma unroll
        for (int b = 0; b < 2; ++b)
#pragma unroll
            for (int m = 0; m < 4; ++m)
#pragma unroll
                for (int n = 0; n < 2; ++n) acc[a][b][m][n] = (f32x4){0.f, 0.f, 0.f, 0.f};
    bf16x8 At[4][2], B0[2][2], B1[2][2];
    unsigned cvo[2][2], nvo[2][2];
    S.a_offs(cur, Rr, Cc, K, cvo);
    const char* const aB = S.a_base();
    const char* cB = S.b_tile(cur, K);
    PG8_STAGE(PG8_SB(0, 0), cB, voffB); PG8_STAGE(PG8_SB(0, 1), cB + hstep, voffB); PG8_STAGE(PG8_SA(0, 0), aB, cvo[0]); PG8_STAGE(PG8_SA(0, 1), aB, cvo[1]);
    if (wr == 1) PG8_BAR;
    PG8_WAIT_V(2); PG8_BAR;
    PG8_STAGE(PG8_SB(1, 0), cB + kstep, voffB); PG8_STAGE(PG8_SA(1, 0), aB + kstep, cvo[0]); PG8_STAGE(PG8_SB(1, 1), cB + hstep + kstep, voffB);
    PG8_WAIT_V(6); PG8_BAR;
    for (;;) {
        const bool has_next = S.next(ui + 1, nxt);
        const char* nB = cB;
        if (has_next) { S.a_offs(nxt, Rr, Cc, K, nvo); nB = S.b_tile(nxt, K); }
        else {
#pragma unroll
            for (int h = 0; h < 2; ++h)
#pragma unroll
                for (int i = 0; i < 2; ++i) nvo[h][i] = cvo[h][i];
        }
        for (int t = 0; t < nt; t += 2) {
            const bool last = (t == nt - 2);
            const char* a1 = aB + (size_t)(t + 1) * kstep;
            const char* a2 = last ? aB : aB + (size_t)(t + 2) * kstep; const char* b2 = last ? nB : cB + (size_t)(t + 2) * kstep;
            const char* a3 = a2 + kstep; const char* b3 = b2 + kstep;
            unsigned o2[2][2];
#pragma unroll
            for (int h = 0; h < 2; ++h)
#pragma unroll
                for (int i = 0; i < 2; ++i) o2[h][i] = last ? nvo[h][i] : cvo[h][i];
            PG8_LDB(B0, 0, 0); PG8_LDB(B1, 0, 1); PG8_SCHED; PG8_LDA(At, 0, 0); PG8_STAGE(PG8_SA(1, 1), a1, cvo[1]);
            PG8_WAIT_V(8); PG8_WAIT_L(0); PG8_BAR; PG8_MMA(0, 0, At, B0); PG8_MMA(0, 1, At, B1); PG8_BAR; PG8_SCHED;
            PG8_LDA(At, 0, 1); PG8_STAGE(PG8_SB(0, 0), b2, voffB); PG8_STAGE(PG8_SB(0, 1), b2 + hstep, voffB); PG8_STAGE(PG8_SA(0, 0), a2, o2[0]);
            PG8_WAIT_V(8); PG8_WAIT_L(0); PG8_BAR; PG8_MMA(1, 0, At, B0); PG8_MMA(1, 1, At, B1); PG8_BAR; PG8_SCHED;
            PG8_LDB(B0, 1, 0); PG8_LDB(B1, 1, 1); PG8_SCHED; PG8_LDA(At, 1, 0); PG8_STAGE(PG8_SA(0, 1), a2, o2[1]);
            PG8_WAIT_V(8); PG8_WAIT_L(0); PG8_BAR; PG8_MMA(0, 0, At, B0); PG8_MMA(0, 1, At, B1); PG8_BAR; PG8_SCHED;
            PG8_LDA(At, 1, 1); PG8_STAGE(PG8_SB(1, 0), b3, voffB); PG8_STAGE(PG8_SB(1, 1), b3 + hstep, voffB); PG8_STAGE(PG8_SA(1, 0), a3, o2[0]);
            PG8_WAIT_V(8); PG8_WAIT_L(0); PG8_BAR; PG8_MMA(1, 0, At, B0); PG8_MMA(1, 1, At, B1); PG8_BAR; PG8_SCHED;
        }
        if (wr == 0) PG8_BAR;
        E(acc, cur, wr, wc, fr, fq);
        if (!has_next) break;
#pragma unroll
        for (int a = 0; a < 2; ++a)
#pragma unroll
            for (int b = 0; b < 2; ++b)
#pragma unroll
                for (int m = 0; m < 4; ++m)
#pragma unroll
                    for (int n = 0; n < 2; ++n) acc[a][b][m][n] = (f32x4){0.f, 0.f, 0.f, 0.f};
        cur = nxt; cB = nB; ++ui;
#pragma unroll
        for (int h = 0; h < 2; ++h)
#pragma unroll
            for (int i = 0; i < 2; ++i) cvo[h][i] = nvo[h][i];
        if (wr == 1) PG8_BAR;
    }
    PG8_WAIT_V(0);
    PG8_BAR;
#undef PG8_SA
#undef PG8_SB
#undef PG8_STAGE
#undef PG8_LDA
#undef PG8_LDB
#undef PG8_MMA
#undef PG8_WAIT_V
#undef PG8_WAIT_L
#undef PG8_BAR
#undef PG8_SCHED
}

__device__ __forceinline__ u32x4 pack8(const f32x4 v0, const f32x4 v1) { u32x4 w; w.x = cvt_pk_bf16(v0[0], v0[1]); w.y = cvt_pk_bf16(v0[2], v0[3]); w.z = cvt_pk_bf16(v1[0], v1[1]); w.w = cvt_pk_bf16(v1[2], v1[3]); return w; }
__device__ __forceinline__ void unpack8(const u32x4 w, f32x4& v0, f32x4& v1) { v0 = (f32x4){bf_lo(w.x), bf_hi(w.x), bf_lo(w.y), bf_hi(w.y)}; v1 = (f32x4){bf_lo(w.z), bf_hi(w.z), bf_lo(w.w), bf_hi(w.w)}; }
__device__ __forceinline__ f32x4 sig4(const f32x4 v) { return (f32x4){sigmoidf_(v[0]), sigmoidf_(v[1]), sigmoidf_(v[2]), sigmoidf_(v[3])}; }

struct EpiStoreBf16 {
    static constexpr bool PERM = true;
    bf16_t* O; int ldc;
    __device__ __forceinline__ void operator()(const f32x4 (&acc)[2][2][4][2], const Unit& u, int wr, int wc, int fr, int fq) const {
        const int row0 = u.pm * BM + wr * 64 + fr, col0 = u.pn * BM + wc * 32 + 8 * fq;
#pragma unroll
        for (int ai = 0; ai < 2; ++ai)
#pragma unroll
            for (int m = 0; m < 4; ++m) { bf16_t* rowp = O + (size_t)(row0 + ai * HALF + m * 16) * ldc + col0;
#pragma unroll
                for (int bj = 0; bj < 2; ++bj) *(u32x4*)(rowp + bj * HALF) = pack8(acc[ai][bj][m][0], acc[ai][bj][m][1]); }
    }
};
template <bool ADD> struct EpiGate {
    static constexpr bool PERM = true;
    bf16_t* O; const bf16_t* Gt; int ldg; const bf16_t* Y;
    __device__ __forceinline__ void operator()(const f32x4 (&acc)[2][2][4][2], const Unit& u, int wr, int wc, int fr, int fq) const {
        const int row0 = u.pm * BM + wr * 64 + fr, col0 = u.pn * BM + wc * 32 + 8 * fq;
#pragma unroll
        for (int ai = 0; ai < 2; ++ai)
#pragma unroll
            for (int m = 0; m < 4; ++m) { const size_t row = (size_t)(row0 + ai * HALF + m * 16);
#pragma unroll
                for (int bj = 0; bj < 2; ++bj) {
                    const u32x4 gw = *(const u32x4*)(Gt + row * ldg + col0 + bj * HALF); f32x4 g0, g1; unpack8(gw, g0, g1);
                    f32x4 v0 = sig4(g0) * acc[ai][bj][m][0], v1 = sig4(g1) * acc[ai][bj][m][1];
                    if (ADD) { const u32x4 yw = *(const u32x4*)(Y + row * D + col0 + bj * HALF); f32x4 y0, y1; unpack8(yw, y0, y1); v0 += y0; v1 += y1; }
                    *(u32x4*)(O + row * D + col0 + bj * HALF) = pack8(v0, v1); } }
    }
};
struct EpiResF32 {
    static constexpr bool PERM = false;
    const float* X; float* O;
    __device__ __forceinline__ void operator()(const f32x4 (&acc)[2][2][4][2], const Unit& u, int wr, int wc, int fr, int fq) const {
        const int row0 = u.pm * BM + wr * 64 + fr, col0 = u.pn * BM + wc * 32 + 4 * fq;
#pragma unroll
        for (int ai = 0; ai < 2; ++ai)
#pragma unroll
            for (int m = 0; m < 4; ++m) { const size_t off = (size_t)(row0 + ai * HALF + m * 16) * D + col0;
#pragma unroll
                for (int bj = 0; bj < 2; ++bj)
#pragma unroll
                    for (int n = 0; n < 2; ++n) { const f32x4 xv = *(const f32x4*)(X + off + bj * HALF + n * 16); *(f32x4*)(O + off + bj * HALF + n * 16) = xv + acc[ai][bj][m][n]; } }
    }
};
struct EpiPle {
    static constexpr bool PERM = false;
    float* O; const bf16_t* PP;
    __device__ __forceinline__ void operator()(const f32x4 (&acc)[2][2][4][2], const Unit& u, int wr, int wc, int fr, int fq) const {
        const int row0 = u.pm * BM + wr * 64 + fr, col0 = u.pn * BM + wc * 32 + 4 * fq;
#pragma unroll
        for (int ai = 0; ai < 2; ++ai)
#pragma unroll
            for (int m = 0; m < 4; ++m) { const size_t off = (size_t)(row0 + ai * HALF + m * 16) * D + col0;
#pragma unroll
                for (int bj = 0; bj < 2; ++bj)
#pragma unroll
                    for (int n = 0; n < 2; ++n) { const size_t o = off + bj * HALF + n * 16; const f32x4 hv = *(const f32x4*)(O + o); const u32x2 pw = *(const u32x2*)(PP + o);
                        const f32x4 pv = (f32x4){bf_lo(pw.x), bf_hi(pw.x), bf_lo(pw.y), bf_hi(pw.y)}; *(f32x4*)(O + o) = hv + sig4(acc[ai][bj][m][n]) * pv; } }
    }
};
}

#define XB_TMO      128
#define XB_XCNT(j)  (256  + 64 * (j))
#define XB_XSUB(j)  (1280 + 64 * (j))
#define XB_XGEN(j)  (2304 + 64 * (j))
#define XB_TOP      3328
#define XB_TOPGEN   3392
#define XCD_BAR_WORDS 3456
#define XB_SPIN_CAP (1u << 22)

__device__ __forceinline__ unsigned xb_ld(unsigned* p)              { return __hip_atomic_load(p, __ATOMIC_RELAXED, __HIP_MEMORY_SCOPE_AGENT); }
__device__ __forceinline__ unsigned xb_add(unsigned* p, unsigned v) { return __hip_atomic_fetch_add(p, v, __ATOMIC_RELAXED, __HIP_MEMORY_SCOPE_AGENT); }
__device__ __forceinline__ unsigned xb_xcc_id() { return (unsigned)__builtin_amdgcn_s_getreg((3 << 11) | 20) & 0xFu; }
#define XB_SPIN(cond, bar) do { unsigned _sp = 0; while (cond) { __builtin_amdgcn_s_sleep(1); \
    if ((++_sp & 255u) == 0u) { if (xb_ld(&(bar)[XB_TMO])) break; if (_sp > XB_SPIN_CAP) { atomicAdd(&(bar)[XB_TMO], 1u); break; } } } } while (0)

struct XcdBarrier { unsigned* bar; unsigned x; volatile LAS unsigned* st; };

__device__ __forceinline__ XcdBarrier xcd_barrier_post(unsigned* bar, volatile LAS unsigned* st) {
    XcdBarrier b; b.bar = bar; b.x = xb_xcc_id(); b.st = st;
    if (threadIdx.x == 0) (void)xb_add(&bar[XB_XCNT(b.x)], 1u);
    return b;
}
__device__ __forceinline__ void xcd_barrier_complete(unsigned* bar, unsigned x, unsigned& nloc, unsigned& nx) {
    const unsigned G = gridDim.x * gridDim.y * gridDim.z;
    unsigned sum, cnt, mine, sp = 0u;
    for (;;) {
        sum = 0u; cnt = 0u; mine = 0u;
#pragma unroll
        for (unsigned j = 0; j < 16; ++j) { const unsigned c = xb_ld(&bar[XB_XCNT(j)]); sum += c; cnt += (c > 0u) ? 1u : 0u; mine = (j == x) ? c : mine; }
        if (sum == G) break;
        __builtin_amdgcn_s_sleep(1);
        if ((++sp & 255u) == 0u) { if (xb_ld(&bar[XB_TMO])) break; if (sp > XB_SPIN_CAP) { atomicAdd(&bar[XB_TMO], 1u); break; } }
    }
    nloc = mine > 0u ? mine : 1u; nx = cnt > 0u ? cnt : 1u;
}
__device__ __forceinline__ void xcd_barrier(const XcdBarrier& b) {
    asm volatile("s_waitcnt vmcnt(0)" ::: "memory");
    __syncthreads();
    if (threadIdx.x == 0) {
        unsigned* bar = b.bar;
        __builtin_amdgcn_s_waitcnt(0);
        unsigned nloc = b.st[0], nx = b.st[1];
        if (nloc == 0u) { xcd_barrier_complete(bar, b.x, nloc, nx); b.st[0] = nloc; b.st[1] = nx; }
        const unsigned old = xb_add(&bar[XB_XSUB(b.x)], 1u);
        const unsigned gen = old / nloc;
        if (old + 1u == (gen + 1u) * nloc) {
            __builtin_amdgcn_fence(__ATOMIC_RELEASE, "agent");
            asm volatile("s_waitcnt vmcnt(0)" ::: "memory");
            const unsigned og = xb_add(&bar[XB_TOP], 1u);
            const unsigned tg = og / nx;
            if (og + 1u == (tg + 1u) * nx) xb_add(&bar[XB_TOPGEN], 1u);
            else XB_SPIN(xb_ld(&bar[XB_TOPGEN]) == tg, bar);
            __builtin_amdgcn_fence(__ATOMIC_ACQUIRE, "agent");
            xb_add(&bar[XB_XGEN(b.x)], 1u);
            asm volatile("s_waitcnt vmcnt(0)" ::: "memory");
        } else {
            XB_SPIN(xb_ld(&bar[XB_XGEN(b.x)]) == gen, bar);
            __builtin_amdgcn_fence(__ATOMIC_ACQUIRE, "agent");
            asm volatile("s_waitcnt vmcnt(0)" ::: "memory");
        }
    }
    __syncthreads();
}

struct Frame {
    LAS unsigned char* lds;
    unsigned* ctl;
    int tid, lane, wave, vcu, G;
    unsigned char* ws;
};
struct Args { const float* in[23]; float* out; unsigned char* ws; int ph_lo, ph_hi; };

template <class RowMap>
__device__ __forceinline__ void transpose_item(const float* W, int K, int N, bf16_t* WT, const RowMap rm, LAS float* scr, int item, int lane) {
    const int nblk = (N + 31) / 32, kb = item / nblk, nb = item % nblk, k0 = 64 * kb, n0 = 32 * nb;
    const int nc = n0 + (lane & 31); const bool ok = nc < N;
#pragma unroll 8
    for (int i = 0; i < 32; ++i) { const int kk = 2 * i + (lane >> 5); scr[kk * 33 + (lane & 31)] = ok ? W[(size_t)(k0 + kk) * N + nc] : 0.f; }
    LDS_WAIT(); asm volatile("" ::: "memory");
    const int c = lane & 7;
#pragma unroll
    for (int j = 0; j < 4; ++j) { const int n = (lane >> 3) + 8 * j; const LAS float* s = scr + (8 * c) * 33 + n;
        u32x4 o; o.x = cvt_pk_bf16(s[0 * 33], s[1 * 33]); o.y = cvt_pk_bf16(s[2 * 33], s[3 * 33]); o.z = cvt_pk_bf16(s[4 * 33], s[5 * 33]); o.w = cvt_pk_bf16(s[6 * 33], s[7 * 33]);
        if (n0 + n < N) *(u32x4*)(WT + (size_t)rm(n0 + n) * K + k0 + 8 * c) = o; }
    LDS_WAIT(); asm volatile("" ::: "memory");
}
struct MapId { __device__ __forceinline__ int operator()(int n) const { return n; } };
struct MapWin { __device__ __forceinline__ int operator()(int n) const { return n < 6144 ? n : (n < 6160 ? C_GI + (n - 6144) : n - 16); } };
struct MapUp { __device__ __forceinline__ int operator()(int n) const { const int c = n & 2047, lin = n >> 11; return 256 * (c >> 7) + 128 * lin + (c & 127); } };

__device__ __forceinline__ void rms_row_to_bf16(const float* xrow, const float* w, bf16_t* orow, int lane) {
    f32x4 v[4][2]; float s = 0.f;
#pragma unroll
    for (int j = 0; j < 4; ++j)
#pragma unroll
        for (int q = 0; q < 2; ++q) { v[j][q] = *(const f32x4*)(xrow + 512 * j + 8 * lane + 4 * q); s += (v[j][q].x * v[j][q].x + v[j][q].y * v[j][q].y) + (v[j][q].z * v[j][q].z + v[j][q].w * v[j][q].w); }
    const float rstd = 1.0f / sqrtf(wave_sum(s) * (1.f / D) + EPS);
#pragma unroll
    for (int j = 0; j < 4; ++j) { const f32x4 w0 = *(const f32x4*)(w + 512 * j + 8 * lane), w1 = *(const f32x4*)(w + 512 * j + 8 * lane + 4);
        *(u32x4*)(orow + 512 * j + 8 * lane) = pg8::pack8(v[j][0] * rstd * w0, v[j][1] * rstd * w1); }
}

__device__ __forceinline__ void p0_prologue(Frame& F, const Args& a) {
    LAS float* scr = (LAS float*)(F.lds + F.wave * 16384);
    const int gw = F.vcu * NWAVES + F.wave, NGW = F.G * NWAVES;
    unsigned char* ws = F.ws;
    for (int m = gw; m < T; m += NGW) rms_row_to_bf16(a.in[0] + (size_t)m * D, a.in[2], (bf16_t*)(ws + WS_XN) + (size_t)m * D, F.lane);
    { const float* p = a.in[1]; bf16_t* pb = (bf16_t*)(ws + WS_PBF);
      for (size_t i = ((size_t)gw * 64 + F.lane) * 8; i < (size_t)T * PLE; i += (size_t)NGW * 64 * 8) { const f32x4 v0 = *(const f32x4*)(p + i), v1 = *(const f32x4*)(p + i + 4); *(u32x4*)(pb + i) = pg8::pack8(v0, v1); } }
    { const float* wr = a.in[14]; float* wp = (float*)(ws + WS_WRP);
      for (int i = gw * 64 + F.lane; i < 128 * 64 * 8; i += NGW * 64) { const int j = i & 7, ln = (i >> 3) & 63, s = i >> 9, c = ln & 15, kq = ln >> 4; wp[i] = wr[(size_t)(16 * s + 4 * kq + (j & 3)) * NE + c + 16 * (j >> 2)]; } }
    { u32x4* z = (u32x4*)((bf16_t*)(ws + WS_WIN) + (size_t)12816 * D);
      for (int i = gw * 64 + F.lane; i < 240 * D / 8; i += NGW * 64) z[i] = (u32x4){0u, 0u, 0u, 0u}; }
    constexpr int I_IN = (D / 64) * ((DIN + 31) / 32);
    constexpr int I_SQ = (D / 64) * (D / 32);
    constexpr int I_PP = (PLE / 64) * (D / 32);
    constexpr int I_UP = (D / 64) * (2 * DFF / 32);
    constexpr int I_DN = (DFF / 64) * (D / 32);
    constexpr int NITEMS = I_IN + 4 * I_SQ + I_PP + NE * I_UP + NE * I_DN;
    for (int it = gw; it < NITEMS; it += NGW) {
        int r = it;
        if (r < I_IN) { transpose_item(a.in[3], D, DIN, (bf16_t*)(ws + WS_WIN), MapWin(), scr, r, F.lane); continue; } r -= I_IN;
        if (r < I_SQ) { transpose_item(a.in[10], D, D, (bf16_t*)(ws + WS_WA), MapId(), scr, r, F.lane); continue; } r -= I_SQ;
        if (r < I_SQ) { transpose_item(a.in[11], D, D, (bf16_t*)(ws + WS_WB), MapId(), scr, r, F.lane); continue; } r -= I_SQ;
        if (r < I_SQ) { transpose_item(a.in[12], D, D, (bf16_t*)(ws + WS_WOUT), MapId(), scr, r, F.lane); continue; } r -= I_SQ;
        if (r < I_SQ) { transpose_item(a.in[21], D, D, (bf16_t*)(ws + WS_WPG), MapId(), scr, r, F.lane); continue; } r -= I_SQ;
        if (r < I_PP) { transpose_item(a.in[22], PLE, D, (bf16_t*)(ws + WS_WPP), MapId(), scr, r, F.lane); continue; } r -= I_PP;
        if (r < NE * I_UP) { const int e = r / I_UP; transpose_item(a.in[16] + (size_t)e * D * 2 * DFF, D, 2 * DFF, (bf16_t*)(ws + WS_WUP) + (size_t)e * 2 * DFF * D, MapUp(), scr, r % I_UP, F.lane); continue; } r -= NE * I_UP;
        { const int e = r / I_DN; transpose_item(a.in[18] + (size_t)e * DFF * D, DFF, D, (bf16_t*)(ws + WS_WDN) + (size_t)e * D * DFF, MapId(), scr, r % I_DN, F.lane); }
    }
}

namespace ml {
constexpr int NC = SEQ / 64;
constexpr int QS = 0, QS_SZ = 64 * 272, KS = 2 * QS_SZ, KT = KS + 64 * 272, VT = KT + 128 * 144, VT_SZ = 32 * 144, SS = VT + 2 * VT_SZ, CT = SS + 64 * 144, CT_SZ = 32 * 272,
              BB = CT + 2 * CT_SZ, AA = BB + 512, WW = AA + 512, GG = WW + 512, RS = GG + 32, QN = RS + 256, NV = QN + 256, ML_END = NV + 1024;
static_assert(ML_END <= RING_BYTES, "mLSTM LDS");
__device__ __forceinline__ f32x4 mfma16(bf16x8 a, bf16x8 b, f32x4 c) { return __builtin_amdgcn_mfma_f32_16x16x32_bf16(a, b, c, 0, 0, 0); }

__device__ __forceinline__ void mlstm_unit(LAS unsigned char* lds, const bf16_t* PROJ, bf16_t* HML, const float* igb, const float* fgb, int b, int h, int sl) {
    const int tid = threadIdx.x, lane = tid & 63, wid = __builtin_amdgcn_readfirstlane(tid >> 6), fr = lane & 15, fq = lane >> 4;
    const size_t row0 = (size_t)b * SEQ;
    const float scale = 0.08838834764831845f;
    const int qrow[2] = {tid >> 4, (tid + 512) >> 4}, qch = tid & 15;
    const int vrow = (tid & 255) >> 2, vch = tid & 3;
    u32x4 rq[2], rk[2], rv; float gi = 0.f, gf = 0.f;
    const float ib = igb[h], fb = fgb[h];
#define ML_LOAD(c) do { const bf16_t* base = PROJ + (row0 + (size_t)(c) * 64) * NPROJ; \
        _Pragma("unroll") for (int u = 0; u < 2; ++u) { rq[u] = *(const u32x4*)(base + (size_t)qrow[u] * NPROJ + C_MLQ + h * 128 + 8 * qch); rk[u] = *(const u32x4*)(base + (size_t)qrow[u] * NPROJ + C_MLK + h * 128 + 8 * qch); } \
        if (tid < 256) rv = *(const u32x4*)(base + (size_t)vrow * NPROJ + C_MLV + h * 256 + 32 * sl + 8 * vch); \
        if (wid == 7) { gi = bf1(base[(size_t)lane * NPROJ + C_GI + h]); gf = bf1(base[(size_t)lane * NPROJ + C_GF + h]); } } while (0)
#define ML_STORE(p) do { \
        _Pragma("unroll") for (int u = 0; u < 2; ++u) { *(LAS u32x4*)(lds + QS + (p) * QS_SZ + qrow[u] * 272 + qch * 16) = rq[u]; *(LAS u32x4*)(lds + KS + qrow[u] * 272 + qch * 16) = rk[u]; \
            const unsigned kw[4] = {rk[u].x, rk[u].y, rk[u].z, rk[u].w}; \
            _Pragma("unroll") for (int e = 0; e < 4; ++e) { *(LAS bf16_t*)(lds + KT + (8 * qch + 2 * e) * 144 + qrow[u] * 2) = (bf16_t)(kw[e] & 0xffffu); *(LAS bf16_t*)(lds + KT + (8 * qch + 2 * e + 1) * 144 + qrow[u] * 2) = (bf16_t)(kw[e] >> 16); } } \
        if (tid < 256) { const unsigned vw[4] = {rv.x, rv.y, rv.z, rv.w}; \
            _Pragma("unroll") for (int e = 0; e < 4; ++e) { *(LAS bf16_t*)(lds + VT + (p) * VT_SZ + (8 * vch + 2 * e) * 144 + vrow * 2) = (bf16_t)(vw[e] & 0xffffu); *(LAS bf16_t*)(lds + VT + (p) * VT_SZ + (8 * vch + 2 * e + 1) * 144 + vrow * 2) = (bf16_t)(vw[e] >> 16); } } \
        if (wid == 7) { const float li = 15.f * tanhf((gi + ib) * (1.f / 15.f)); const float fz = 15.f * tanhf((gf + fb) * (1.f / 15.f)); const float lf = fminf(fz, 0.f) - log1pf(__expf(-fabsf(fz))); \
            float bsum = lf; _Pragma("unroll") for (int o = 1; o < 64; o <<= 1) { const float tv = __shfl_up(bsum, o); if (lane >= o) bsum += tv; } \
            const float g = __shfl(bsum, 63); const float aj = li - bsum; \
            *(LAS float*)(lds + BB + (p) * 256 + lane * 4) = bsum; *(LAS float*)(lds + AA + (p) * 256 + lane * 4) = aj; *(LAS float*)(lds + WW + (p) * 256 + lane * 4) = __expf(g + aj); if (lane == 0) *(LAS float*)(lds + GG + (p) * 16) = g; } } while (0)
    f32x4 Creg[2][2];
#pragma unroll
    for (int a = 0; a < 2; ++a)
#pragma unroll
        for (int c = 0; c < 2; ++c) Creg[a][c] = (f32x4){0.f, 0.f, 0.f, 0.f};
    for (int i = tid; i < CT_SZ / 4; i += 512) *(LAS unsigned*)(lds + CT + i * 4) = 0u;
    if (tid < 128) *(LAS float*)(lds + NV + tid * 4) = 0.f;
    ML_LOAD(0);
    ML_STORE(0);
    __syncthreads();
    for (int c = 0; c < NC; ++c) {
        const int p = c & 1;
        if (c + 1 < NC) ML_LOAD(c + 1);
        if (wid < 4) {
            const int it = wid, i = 16 * it + fr; const float bi = *(const LAS float*)(lds + BB + p * 256 + i * 4); float rsum = 0.f;
            for (int jt = 0; jt <= it; ++jt) {
                f32x4 acc = (f32x4){0.f, 0.f, 0.f, 0.f};
#pragma unroll
                for (int ks = 0; ks < 4; ++ks) { const bf16x8 A = *(const LAS bf16x8*)(lds + KS + (16 * jt + fr) * 272 + (32 * ks + 8 * fq) * 2); const bf16x8 B = *(const LAS bf16x8*)(lds + QS + p * QS_SZ + (16 * it + fr) * 272 + (32 * ks + 8 * fq) * 2); acc = mfma16(A, B, acc); }
                const f32x4 aj = *(const LAS f32x4*)(lds + AA + p * 256 + (16 * jt + 4 * fq) * 4);
                float v[4];
#pragma unroll
                for (int r = 0; r < 4; ++r) { const int j = 16 * jt + 4 * fq + r; v[r] = (j <= i) ? acc[r] * scale * __expf(bi + aj[r]) : 0.f; rsum += v[r]; }
                u32x2 w; w.x = cvt_pk_bf16(v[0], v[1]); w.y = cvt_pk_bf16(v[2], v[3]);
                *(LAS u32x2*)(lds + SS + i * 144 + (16 * jt + 4 * fq) * 2) = w;
            }
            if ((it & 1) == 0) *(LAS u32x2*)(lds + SS + i * 144 + (16 * (it + 1) + 4 * fq) * 2) = (u32x2){0u, 0u};
            rsum += __shfl_xor(rsum, 16); rsum += __shfl_xor(rsum, 32);
            if (fq == 0) *(LAS float*)(lds + RS + i * 4) = rsum;
        } else {
            const int x = wid - 4; const float eg = __expf(*(const LAS float*)(lds + GG + p * 16));
            bf16x8 Af[2][2], Bf[2][2];
#pragma unroll
            for (int ks = 0; ks < 2; ++ks) {
                const f32x4 w0 = *(const LAS f32x4*)(lds + WW + p * 256 + (32 * ks + 8 * fq) * 4), w1 = *(const LAS f32x4*)(lds + WW + p * 256 + (32 * ks + 8 * fq + 4) * 4);
#pragma unroll
                for (int dl = 0; dl < 2; ++dl) { const u32x4 raw = *(const LAS u32x4*)(lds + KT + (16 * (2 * x + dl) + fr) * 144 + (32 * ks + 8 * fq) * 2);
                    u32x4 sc; sc.x = cvt_pk_bf16(bf_lo(raw.x) * w0[0], bf_hi(raw.x) * w0[1]); sc.y = cvt_pk_bf16(bf_lo(raw.y) * w0[2], bf_hi(raw.y) * w0[3]);
                    sc.z = cvt_pk_bf16(bf_lo(raw.z) * w1[0], bf_hi(raw.z) * w1[1]); sc.w = cvt_pk_bf16(bf_lo(raw.w) * w1[2], bf_hi(raw.w) * w1[3]);
                    Af[dl][ks] = __builtin_bit_cast(bf16x8, sc); }
#pragma unroll
                for (int dv = 0; dv < 2; ++dv) Bf[dv][ks] = *(const LAS bf16x8*)(lds + VT + p * VT_SZ + (16 * dv + fr) * 144 + (32 * ks + 8 * fq) * 2);
            }
#pragma unroll
            for (int dl = 0; dl < 2; ++dl)
#pragma unroll
                for (int dv = 0; dv < 2; ++dv) { f32x4 cacc = Creg[dl][dv] * eg; cacc = mfma16(Af[dl][0], Bf[dv][0], cacc); cacc = mfma16(Af[dl][1], Bf[dv][1], cacc); Creg[dl][dv] = cacc;
                    u32x2 w; w.x = cvt_pk_bf16(cacc[0], cacc[1]); w.y = cvt_pk_bf16(cacc[2], cacc[3]);
                    *(LAS u32x2*)(lds + CT + (p ^ 1) * CT_SZ + (16 * dv + fr) * 272 + (16 * (2 * x + dl) + 4 * fq) * 2) = w; }
            const int tt = tid - 256;
            { const int i = tt >> 2, q4 = tt & 3; float s = 0.f;
#pragma unroll
              for (int e = 0; e < 4; ++e) { const u32x4 qw = *(const LAS u32x4*)(lds + QS + p * QS_SZ + i * 272 + (32 * q4 + 8 * e) * 2); const f32x4 n0 = *(const LAS f32x4*)(lds + NV + p * 512 + (32 * q4 + 8 * e) * 4), n1 = *(const LAS f32x4*)(lds + NV + p * 512 + (32 * q4 + 8 * e + 4) * 4);
                  s += bf_lo(qw.x) * n0[0] + bf_hi(qw.x) * n0[1] + bf_lo(qw.y) * n0[2] + bf_hi(qw.y) * n0[3] + bf_lo(qw.z) * n1[0] + bf_hi(qw.z) * n1[1] + bf_lo(qw.w) * n1[2] + bf_hi(qw.w) * n1[3]; }
              s += __shfl_xor(s, 1); s += __shfl_xor(s, 2);
              if (q4 == 0) *(LAS float*)(lds + QN + i * 4) = s; }
            { const int d = tt >> 1, hh = tt & 1; float s = 0.f;
#pragma unroll
              for (int e = 0; e < 4; ++e) { const u32x4 kw = *(const LAS u32x4*)(lds + KT + d * 144 + (32 * hh + 8 * e) * 2); const f32x4 w0 = *(const LAS f32x4*)(lds + WW + p * 256 + (32 * hh + 8 * e) * 4), w1 = *(const LAS f32x4*)(lds + WW + p * 256 + (32 * hh + 8 * e + 4) * 4);
                  s += bf_lo(kw.x) * w0[0] + bf_hi(kw.x) * w0[1] + bf_lo(kw.y) * w0[2] + bf_hi(kw.y) * w0[3] + bf_lo(kw.z) * w1[0] + bf_hi(kw.z) * w1[1] + bf_lo(kw.w) * w1[2] + bf_hi(kw.w) * w1[3]; }
              s += __shfl_xor(s, 1);
              if (hh == 0) *(LAS float*)(lds + NV + (p ^ 1) * 512 + d * 4) = eg * *(const LAS float*)(lds + NV + p * 512 + d * 4) + s; }
        }
        __syncthreads();
        {
            const int it = wid >> 1, dv = wid & 1;
            f32x4 h1 = (f32x4){0.f, 0.f, 0.f, 0.f}, h2 = (f32x4){0.f, 0.f, 0.f, 0.f};
            for (int ks = 0; ks <= (it >> 1); ++ks) { const bf16x8 A = *(const LAS bf16x8*)(lds + SS + (16 * it + fr) * 144 + (32 * ks + 8 * fq) * 2); const bf16x8 B = *(const LAS bf16x8*)(lds + VT + p * VT_SZ + (16 * dv + fr) * 144 + (32 * ks + 8 * fq) * 2); h1 = mfma16(A, B, h1); }
#pragma unroll
            for (int ks = 0; ks < 4; ++ks) { const bf16x8 A = *(const LAS bf16x8*)(lds + QS + p * QS_SZ + (16 * it + fr) * 272 + (32 * ks + 8 * fq) * 2); const bf16x8 B = *(const LAS bf16x8*)(lds + CT + p * CT_SZ + (16 * dv + fr) * 272 + (32 * ks + 8 * fq) * 2); h2 = mfma16(A, B, h2); }
            const f32x4 bi = *(const LAS f32x4*)(lds + BB + p * 256 + (16 * it + 4 * fq) * 4), rs = *(const LAS f32x4*)(lds + RS + (16 * it + 4 * fq) * 4), qn = *(const LAS f32x4*)(lds + QN + (16 * it + 4 * fq) * 4);
            bf16_t* orow = HML + (row0 + (size_t)c * 64 + 16 * it + 4 * fq) * D + h * 256 + 32 * sl + 16 * dv + fr;
#pragma unroll
            for (int r = 0; r < 4; ++r) { const float eb = __expf(bi[r]) * scale; const float num = h1[r] + eb * h2[r], den = rs[r] + eb * qn[r]; const float hv = num / fmaxf(fabsf(den), 1.0f);
                orow[(size_t)r * D] = (bf16_t)(cvt_pk_bf16(hv, 0.f) & 0xffffu); }
        }
        if (c + 1 < NC) ML_STORE(p ^ 1);
        __syncthreads();
    }
#undef ML_LOAD
#undef ML_STORE
}
}

namespace swa {
constexpr int KSO = 0, VSO = 256 * 144, WSF = 2 * 256 * 144, SWA_END = WSF + 8 * 256;
static_assert(SWA_END <= RING_BYTES, "SWA LDS");
__device__ __forceinline__ int crow(int r, int hi) { return (r & 3) + 8 * (r >> 2) + 4 * hi; }
typedef short v4i16_t __attribute__((ext_vector_type(4)));
__device__ __forceinline__ s16x4 vtr(const LAS unsigned char* p) { return __builtin_bit_cast(s16x4, __builtin_amdgcn_ds_read_tr16_b64_v4i16((LAS v4i16_t*)p)); }

__device__ __forceinline__ void swa_unit(LAS unsigned char* lds, const bf16_t* PROJ, bf16_t* ASW, const float* wq, const float* wk, const float* sinks, int b, int nb, int kvh) {
    const int tid = threadIdx.x, lane = tid & 63, wid = __builtin_amdgcn_readfirstlane(tid >> 6), r32 = lane & 31, hi = lane >> 5;
    const size_t rowbase = (size_t)b * SEQ + (size_t)nb * 128;
#pragma unroll
    for (int u = 0; u < 4; ++u) {
        const int id = tid + 512 * u, row = id >> 3, ch = id & 7; const bool valid = (nb > 0) || (row >= 128);
        u32x4 kw = (u32x4){0u, 0u, 0u, 0u}, vw = (u32x4){0u, 0u, 0u, 0u};
        if (valid) { const bf16_t* rp = PROJ + (rowbase - 128 + row) * NPROJ; kw = *(const u32x4*)(rp + C_SWK + kvh * 64 + 8 * ch); vw = *(const u32x4*)(rp + C_SWV + kvh * 64 + 8 * ch); }
        f32x4 k0, k1; pg8::unpack8(kw, k0, k1);
        float ss = (k0[0] * k0[0] + k0[1] * k0[1]) + (k0[2] * k0[2] + k0[3] * k0[3]) + (k1[0] * k1[0] + k1[1] * k1[1]) + (k1[2] * k1[2] + k1[3] * k1[3]);
        ss += __shfl_xor(ss, 1); ss += __shfl_xor(ss, 2); ss += __shfl_xor(ss, 4);
        const float r = 1.0f / sqrtf(ss * (1.f / 64.f) + EPS);
        const f32x4 w0 = *(const f32x4*)(wk + 8 * ch), w1 = *(const f32x4*)(wk + 8 * ch + 4);
        *(LAS u32x4*)(lds + KSO + row * 144 + ch * 16) = pg8::pack8(k0 * r * w0, k1 * r * w1);
        *(LAS u32x4*)(lds + VSO + row * 144 + ch * 16) = vw;
    }
    __syncthreads();
    const int hd = kvh * 8 + wid;
    const float slope = exp2f(-(float)(hd + 1) * 0.25f) * LOG2E, sinkl = sinks[hd] * LOG2E;
    LAS float* wsf = (LAS float*)(lds + WSF + wid * 256);
    for (int qt = 0; qt < 4; ++qt) {
        bf16x8 qf[4];
        { const bf16_t* qp = PROJ + (rowbase + 32 * qt + r32) * NPROJ + C_SWQ + hd * 64 + 8 * hi; f32x4 q0[4], q1[4]; float ss = 0.f;
#pragma unroll
          for (int ds = 0; ds < 4; ++ds) { const u32x4 w = *(const u32x4*)(qp + 16 * ds); pg8::unpack8(w, q0[ds], q1[ds]);
              ss += (q0[ds][0] * q0[ds][0] + q0[ds][1] * q0[ds][1]) + (q0[ds][2] * q0[ds][2] + q0[ds][3] * q0[ds][3]) + (q1[ds][0] * q1[ds][0] + q1[ds][1] * q1[ds][1]) + (q1[ds][2] * q1[ds][2] + q1[ds][3] * q1[ds][3]); }
          ss += __shfl_xor(ss, 32);
          const float r = (1.0f / sqrtf(ss * (1.f / 64.f) + EPS)) * 0.125f * LOG2E;
#pragma unroll
          for (int ds = 0; ds < 4; ++ds) { const f32x4 w0 = *(const f32x4*)(wq + 16 * ds + 8 * hi), w1 = *(const f32x4*)(wq + 16 * ds + 8 * hi + 4); qf[ds] = __builtin_bit_cast(bf16x8, pg8::pack8(q0[ds] * r * w0, q1[ds] * r * w1)); } }
        f32x16 s[5];
#pragma unroll
        for (int kk = 0; kk < 5; ++kk) { const int kt = qt + kk; f32x16 a = {};
#pragma unroll
            for (int ds = 0; ds < 4; ++ds) { const bf16x8 A = *(const LAS bf16x8*)(lds + KSO + (32 * kt + r32) * 144 + (16 * ds + 8 * hi) * 2); a = __builtin_amdgcn_mfma_f32_32x32x16_bf16(A, qf[ds], a, 0, 0, 0); }
            s[kk] = a; __builtin_amdgcn_sched_barrier(0); }
        int dbase = 128 + r32 - 4 * hi; asm volatile("" : "+v"(dbase));
        const float fbase = (float)dbase; const int jlim = ((nb > 0) ? 0 : 128) - 32 * qt - 4 * hi;
        float m = sinkl;
#pragma unroll
        for (int kk = 0; kk < 5; ++kk)
#pragma unroll
            for (int r = 0; r < 16; ++r) { const int ckr = 32 * kk + (r & 3) + 8 * (r >> 2); const int dist = dbase - ckr; const bool valid = ((unsigned)dist < 128u) && (ckr >= jlim);
                const float v = valid ? s[kk][r] - slope * (fbase - (float)ckr) : -INFINITY; s[kk][r] = v; m = fmaxf(m, v); }
        m = fmaxf(m, __shfl_xor(m, 32));
        float l = 0.f;
#pragma unroll
        for (int kk = 0; kk < 5; ++kk)
#pragma unroll
            for (int r = 0; r < 16; ++r) { const float p = exp2f(s[kk][r] - m); s[kk][r] = p; l += p; }
        l += __shfl_xor(l, 32);
        l += exp2f(sinkl - m);
        if (hi == 0) wsf[r32] = 1.0f / l;
        f32x16 o[2]; o[0] = (f32x16){}; o[1] = (f32x16){};
#pragma unroll
        for (int kk = 0; kk < 5; ++kk) { const int kt = qt + kk;
#pragma unroll
            for (int s2 = 0; s2 < 2; ++s2) {
                u32x4 pw; pw.x = cvt_pk_bf16(s[kk][8 * s2 + 0], s[kk][8 * s2 + 1]); pw.y = cvt_pk_bf16(s[kk][8 * s2 + 2], s[kk][8 * s2 + 3]); pw.z = cvt_pk_bf16(s[kk][8 * s2 + 4], s[kk][8 * s2 + 5]); pw.w = cvt_pk_bf16(s[kk][8 * s2 + 6], s[kk][8 * s2 + 7]);
                const bf16x8 pa = __builtin_bit_cast(bf16x8, pw);
                const int key = 32 * kt + 16 * s2 + 4 * hi + ((lane & 15) >> 2);
#pragma unroll
                for (int d0 = 0; d0 < 2; ++d0) { const LAS unsigned char* vp = lds + VSO + key * 144 + (32 * d0 + 16 * ((lane >> 4) & 1) + 4 * (lane & 3)) * 2;
                    const s16x4 lo = vtr(vp), hh = vtr(vp + 8 * 144);
                    const bf16x8 B = (bf16x8){lo[0], lo[1], lo[2], lo[3], hh[0], hh[1], hh[2], hh[3]};
                    o[d0] = __builtin_amdgcn_mfma_f32_32x32x16_bf16(pa, B, o[d0], 0, 0, 0); }
                __builtin_amdgcn_sched_barrier(0); } }
        LDS_WAIT();
#pragma unroll
        for (int r = 0; r < 16; ++r) { const float rl = wsf[crow(r, hi)]; bf16_t* op = ASW + (rowbase + 32 * qt + crow(r, hi)) * D + hd * 64 + r32;
            op[0] = (bf16_t)(cvt_pk_bf16(o[0][r] * rl, 0.f) & 0xffffu); op[32] = (bf16_t)(cvt_pk_bf16(o[1][r] * rl, 0.f) & 0xffffu); }
    }
    __syncthreads();
}
}

namespace moe {
using pg8::Unit; using pg8::BM; using pg8::HALF;
struct Tables { const LAS int* tstart; const LAS int* cnt; const LAS int* tile_e; };
__device__ __forceinline__ int build_tables(LAS unsigned char* tab, const unsigned* cur) {
    LAS int* tstart = (LAS int*)tab; LAS int* cnt = (LAS int*)(tab + 256); LAS int* tile_e = (LAS int*)(tab + 512);
    const int tid = threadIdx.x;
    if (tid < NE) cnt[tid] = (int)__hip_atomic_load(cur + 64 * tid, RLX_AGENT);
    __syncthreads();
    if (tid == 0) { int s = 0; for (int e = 0; e < NE; ++e) { tstart[e] = s; s += (cnt[e] + 255) >> 8; } tstart[NE] = s; }
    __syncthreads();
    const int nrt = tstart[NE];
    for (int t = tid; t < nrt; t += 512) { int e = 0; for (int k = 1; k < NE; ++k) if (tstart[k] <= t) e = k; tile_e[t] = e; }
    __syncthreads();
    return nrt;
}
struct UpSched {
    const bf16_t* A; const bf16_t* Bt; const int* tokl; Tables tb; int nrt, nN, G, c;
    __device__ __forceinline__ bool next(int i, Unit& u) const { const long L = (long)i * G + c; if (L >= (long)nrt * nN) return false; pg8::map_unit((int)L, nrt, nN, u.pm, u.pn); u.e = tb.tile_e[u.pm]; u.r0 = (u.pm - tb.tstart[u.e]) * BM; u.cnt = tb.cnt[u.e]; return true; }
    __device__ __forceinline__ const char* a_base() const { return (const char*)A; }
    __device__ __forceinline__ void a_offs(const Unit& u, const int (&R)[2], const int (&C)[2], int K, unsigned (&vo)[2][2]) const {
#pragma unroll
        for (int h = 0; h < 2; ++h)
#pragma unroll
            for (int i = 0; i < 2; ++i) { const int rl = u.r0 + h * HALF + R[i]; const int tok = rl < u.cnt ? tokl[(size_t)u.e * CAP + rl] : 0; vo[h][i] = (unsigned)(tok * K + C[i]) * 2u; }
    }
    __device__ __forceinline__ const char* b_tile(const Unit& u, int K) const { return (const char*)Bt + ((size_t)u.e * 2 * DFF + (size_t)u.pn * BM) * K * 2; }
};
struct DownSched {
    const bf16_t* A; const bf16_t* Bt; Tables tb; int nrt, nN, G, c;
    __device__ __forceinline__ bool next(int i, Unit& u) const { const long L = (long)i * G + c; if (L >= (long)nrt * nN) return false; pg8::map_unit((int)L, nrt, nN, u.pm, u.pn); u.e = tb.tile_e[u.pm]; u.r0 = (u.pm - tb.tstart[u.e]) * BM; u.cnt = tb.cnt[u.e]; return true; }
    __device__ __forceinline__ const char* a_base() const { return (const char*)A; }
    __device__ __forceinline__ void a_offs(const Unit& u, const int (&R)[2], const int (&C)[2], int K, unsigned (&vo)[2][2]) const {
#pragma unroll
        for (int h = 0; h < 2; ++h)
#pragma unroll
            for (int i = 0; i < 2; ++i) vo[h][i] = (unsigned)((u.pm * BM + h * HALF + R[i]) * K + C[i]) * 2u;
    }
    __device__ __forceinline__ const char* b_tile(const Unit& u, int K) const { return (const char*)Bt + ((size_t)u.e * D + (size_t)u.pn * BM) * K * 2; }
};
struct EpiUp {
    static constexpr bool PERM = true;
    bf16_t* ACT; const float* bup; const float* rsl;
    __device__ __forceinline__ void operator()(const f32x4 (&acc)[2][2][4][2], const Unit& u, int wr, int wc, int fr, int fq) const {
        const int oc = u.pn * HALF + wc * 32 + 8 * fq;
        const float* bg = bup + (size_t)u.e * 2 * DFF + oc; const float* bl = bg + DFF;
        const f32x4 bg0 = *(const f32x4*)bg, bg1 = *(const f32x4*)(bg + 4), bl0 = *(const f32x4*)bl, bl1 = *(const f32x4*)(bl + 4);
#pragma unroll
        for (int ai = 0; ai < 2; ++ai)
#pragma unroll
            for (int m = 0; m < 4; ++m) { const int rt = ai * HALF + wr * 64 + m * 16 + fr; const int rl = u.r0 + rt; const float rs = rl < u.cnt ? rsl[(size_t)u.e * CAP + rl] : 0.f;
                f32x4 o[2];
#pragma unroll
                for (int n = 0; n < 2; ++n) { const f32x4 g = acc[ai][0][m][n] * rs + (n ? bg1 : bg0), l = acc[ai][1][m][n] * rs + (n ? bl1 : bl0);
#pragma unroll
                    for (int j = 0; j < 4; ++j) { const float gg = fminf(g[j], 7.0f), ll = fminf(fmaxf(l[j], -7.0f), 7.0f); o[n][j] = gg * sigmoidf_(1.702f * gg) * (ll + 1.0f); } }
                *(u32x4*)(ACT + (size_t)(u.pm * BM + rt) * DFF + oc) = pg8::pack8(o[0], o[1]); }
    }
};
struct EpiDown {
    static constexpr bool PERM = true;
    bf16_t* YS; const float* bdn; const float* gatel; const int* destl;
    __device__ __forceinline__ void operator()(const f32x4 (&acc)[2][2][4][2], const Unit& u, int wr, int wc, int fr, int fq) const {
        const int col0 = u.pn * BM + wc * 32 + 8 * fq;
        f32x4 bv[2][2];
#pragma unroll
        for (int bj = 0; bj < 2; ++bj)
#pragma unroll
            for (int n = 0; n < 2; ++n) bv[bj][n] = *(const f32x4*)(bdn + (size_t)u.e * D + col0 + bj * HALF + 4 * n);
#pragma unroll
        for (int ai = 0; ai < 2; ++ai)
#pragma unroll
            for (int m = 0; m < 4; ++m) { const int rl = u.r0 + ai * HALF + wr * 64 + m * 16 + fr;
                if (rl < u.cnt) { const float g = gatel[(size_t)u.e * CAP + rl]; const int dest = destl[(size_t)u.e * CAP + rl];
#pragma unroll
                    for (int bj = 0; bj < 2; ++bj) *(u32x4*)(YS + (size_t)dest * D + col0 + bj * HALF) = pg8::pack8((acc[ai][bj][m][0] + bv[bj][0]) * g, (acc[ai][bj][m][1] + bv[bj][1]) * g); } }
    }
};
}

__device__ __forceinline__ void ml_norm_rows(Frame& F, const Args& a) {
    const int gw = F.vcu * NWAVES + F.wave, NGW = F.G * NWAVES, lane = F.lane;
    bf16_t* HML = (bf16_t*)(F.ws + WS_HML); const bf16_t* PROJ = (const bf16_t*)(F.ws + WS_PROJ); const float* nw = a.in[6];
    for (int m = gw; m < T; m += NGW) {
        bf16_t* hr = HML + (size_t)m * D; const bf16_t* orow = PROJ + (size_t)m * NPROJ + C_MLO;
#pragma unroll
        for (int j = 0; j < 4; ++j) { const int c0 = 512 * j + 8 * lane;
            const u32x4 hw = *(const u32x4*)(hr + c0), ow = *(const u32x4*)(orow + c0); f32x4 h0, h1, o0, o1; pg8::unpack8(hw, h0, h1); pg8::unpack8(ow, o0, o1);
            float ss = (h0[0] * h0[0] + h0[1] * h0[1]) + (h0[2] * h0[2] + h0[3] * h0[3]) + (h1[0] * h1[0] + h1[1] * h1[1]) + (h1[2] * h1[2] + h1[3] * h1[3]);
#pragma unroll
            for (int o = 1; o < 32; o <<= 1) ss += __shfl_xor(ss, o);
            const float r = 1.0f / sqrtf(ss * (1.f / 256.f) + EPS);
            const f32x4 w0 = *(const f32x4*)(nw + c0), w1 = *(const f32x4*)(nw + c0 + 4);
            *(u32x4*)(hr + c0) = pg8::pack8(h0 * r * w0 * pg8::sig4(o0), h1 * r * w1 * pg8::sig4(o1)); }
    }
}

__device__ __forceinline__ void route_phase(Frame& F, const Args& a) {
    LAS unsigned char* lds = F.lds;
    LAS float* w2s = (LAS float*)(lds);
    LAS float* lg = (LAS float*)(lds + 8192);
    LAS float* rsd = (LAS float*)(lds + 8192 + 8 * 16 * 33 * 4);
    LAS int* sel_e = (LAS int*)(lds + 32768);
    LAS float* sel_g = (LAS float*)(lds + 32768 + 2048);
    LAS int* hist = (LAS int*)(lds + 32768 + 4096);
    LAS int* basep = (LAS int*)(lds + 32768 + 4096 + 128);
    const int tid = F.tid, lane = F.lane, wid = F.wave, c16 = lane & 15, kq = lane >> 4;
    const float* h1 = a.out; const float* w2 = a.in[13]; const float* br = a.in[15]; const float* wrp = (const float*)(F.ws + WS_WRP);
    bf16_t* XN = (bf16_t*)(F.ws + WS_XN);
    int* tokl = (int*)(F.ws + WS_TOKL); float* gatel = (float*)(F.ws + WS_GATEL); int* destl = (int*)(F.ws + WS_DESTL); float* rsl = (float*)(F.ws + WS_RSL);
    unsigned* cur = F.ctl + CW_CUR;
    for (int i = tid; i < D; i += 512) w2s[i] = w2[i];
    __syncthreads();
    for (int tb = blockIdx.x; tb < T / 128; tb += F.G) {
        if (tid < NE) hist[tid] = 0;
        const int row0 = tb * 128 + wid * 16;
        const float* xr = h1 + (size_t)(row0 + c16) * D + 4 * kq; bf16_t* xo = XN + (size_t)(row0 + c16) * D + 4 * kq;
        f32x4 acc0 = (f32x4){0.f, 0.f, 0.f, 0.f}, acc1 = (f32x4){0.f, 0.f, 0.f, 0.f}; float ss = 0.f;
#pragma unroll 4
        for (int s = 0; s < 128; ++s) {
            const f32x4 xv = *(const f32x4*)(xr + 16 * s); const f32x4 wv = *(const LAS f32x4*)(w2s + 16 * s + 4 * kq);
            const f32x4 b0 = *(const f32x4*)(wrp + ((size_t)s * 64 + lane) * 8), b1 = *(const f32x4*)(wrp + ((size_t)s * 64 + lane) * 8 + 4);
            ss += (xv[0] * xv[0] + xv[1] * xv[1]) + (xv[2] * xv[2] + xv[3] * xv[3]);
            const f32x4 xw = xv * wv;
            u32x2 o; o.x = cvt_pk_bf16(xw[0], xw[1]); o.y = cvt_pk_bf16(xw[2], xw[3]); *(u32x2*)(xo + 16 * s) = o;
#pragma unroll
            for (int j = 0; j < 4; ++j) { acc0 = __builtin_amdgcn_mfma_f32_16x16x4f32(xw[j], b0[j], acc0, 0, 0, 0); acc1 = __builtin_amdgcn_mfma_f32_16x16x4f32(xw[j], b1[j], acc1, 0, 0, 0); }
        }
        ss += __shfl_xor(ss, 16); ss += __shfl_xor(ss, 32);
        const float rstd = 1.0f / sqrtf(ss * (1.f / D) + EPS);
        if (kq == 0) rsd[wid * 16 + c16] = rstd;
        LDS_WAIT();
        { const float bb0 = br[c16], bb1 = br[c16 + 16];
#pragma unroll
          for (int r = 0; r < 4; ++r) { const float rr = rsd[wid * 16 + 4 * kq + r]; lg[(wid * 16 + 4 * kq + r) * 33 + c16] = acc0[r] * rr + bb0; lg[(wid * 16 + 4 * kq + r) * 33 + c16 + 16] = acc1[r] * rr + bb1; } }
        LDS_WAIT();
        if (lane < 16) {
            const LAS float* lr = lg + (wid * 16 + lane) * 33; unsigned taken = 0u; float tv[4]; int te[4];
#pragma unroll
            for (int k = 0; k < 4; ++k) { float best = -INFINITY; int bi = 0;
                for (int e = 0; e < NE; ++e) { const float v = lr[e]; const bool ok = !((taken >> e) & 1u) && (v > best); best = ok ? v : best; bi = ok ? e : bi; }
                taken |= 1u << bi; tv[k] = best; te[k] = bi; }
            float ex[4], sum = 0.f;
#pragma unroll
            for (int k = 0; k < 4; ++k) { ex[k] = __expf(tv[k] - tv[0]); sum += ex[k]; }
            const float inv = 1.0f / sum;
#pragma unroll
            for (int k = 0; k < 4; ++k) { sel_e[(wid * 16 + lane) * 4 + k] = te[k]; sel_g[(wid * 16 + lane) * 4 + k] = ex[k] * inv; }
        }
        __syncthreads();
        const int prow = wid * 16 + (lane >> 2), pk = lane & 3;
        const int pe = sel_e[prow * 4 + pk]; const float pg = sel_g[prow * 4 + pk];
        const int lr_ = __hip_atomic_fetch_add(hist + pe, 1, __ATOMIC_RELAXED, __HIP_MEMORY_SCOPE_WORKGROUP);
        __syncthreads();
        if (tid < NE) basep[tid] = (int)__hip_atomic_fetch_add(cur + 64 * tid, (unsigned)hist[tid], RLX_AGENT);
        __syncthreads();
        { const int pos = basep[pe] + lr_; const int token = tb * 128 + prow; const size_t li = (size_t)pe * CAP + pos;
          tokl[li] = token; gatel[li] = pg; destl[li] = token * 4 + pk; rsl[li] = rsd[prow]; }
        __syncthreads();
    }
}

__device__ __forceinline__ void combine_rows(Frame& F, const Args& a) {
    const int gw = F.vcu * NWAVES + F.wave, NGW = F.G * NWAVES, lane = F.lane;
    float* out = a.out; const bf16_t* YS = (const bf16_t*)(F.ws + WS_YS); bf16_t* XN = (bf16_t*)(F.ws + WS_XN); const float* w3 = a.in[20];
    for (int m = gw; m < T; m += NGW) {
        float* hr = out + (size_t)m * D; f32x4 v[4][2]; float s = 0.f;
#pragma unroll
        for (int j = 0; j < 4; ++j) { const int c0 = 512 * j + 8 * lane; v[j][0] = *(const f32x4*)(hr + c0); v[j][1] = *(const f32x4*)(hr + c0 + 4);
#pragma unroll
            for (int k = 0; k < 4; ++k) { const u32x4 yw = *(const u32x4*)(YS + ((size_t)m * 4 + k) * D + c0); f32x4 y0, y1; pg8::unpack8(yw, y0, y1); v[j][0] += y0; v[j][1] += y1; }
            *(f32x4*)(hr + c0) = v[j][0]; *(f32x4*)(hr + c0 + 4) = v[j][1];
#pragma unroll
            for (int q = 0; q < 2; ++q) s += (v[j][q].x * v[j][q].x + v[j][q].y * v[j][q].y) + (v[j][q].z * v[j][q].z + v[j][q].w * v[j][q].w); }
        const float rstd = 1.0f / sqrtf(wave_sum(s) * (1.f / D) + EPS);
#pragma unroll
        for (int j = 0; j < 4; ++j) { const int c0 = 512 * j + 8 * lane; const f32x4 w0 = *(const f32x4*)(w3 + c0), w1 = *(const f32x4*)(w3 + c0 + 4);
            *(u32x4*)(XN + (size_t)m * D + c0) = pg8::pack8(v[j][0] * rstd * w0, v[j][1] * rstd * w1); }
    }
}

constexpr int NPHASE = 12;
__global__ void __launch_bounds__(NWAVES * 64, 2) mk_fwd(Args args) {
    extern __shared__ __attribute__((aligned(16))) unsigned char lds_raw[];
    Frame F;
    F.lds = (LAS unsigned char*)lds_raw;
    F.tid = threadIdx.x; F.lane = F.tid & 63; F.wave = __builtin_amdgcn_readfirstlane(F.tid >> 6);
    F.G = gridDim.x; { const int bx = blockIdx.x; F.vcu = (F.G % 8 == 0) ? (bx % 8) * (F.G / 8) + bx / 8 : bx; }
    F.ws = args.ws; F.ctl = (unsigned*)(args.ws + WS_CTL);
    volatile LAS unsigned* MISC = (volatile LAS unsigned*)(F.lds + MISC_OFF);
    for (int u = F.tid; u < 64; u += NWAVES * 64) MISC[u] = 0u;
    __syncthreads();
    XcdBarrier bar; bar.bar = F.ctl + CW_BAR; bar.x = 0; bar.st = nullptr;
    if (MK_N_LAUNCHES == 1) bar = xcd_barrier_post(F.ctl + CW_BAR, MISC + 8);
    unsigned char* ws = args.ws;
    const int lo = args.ph_lo, hi = args.ph_hi;
#define IN(k) (lo <= (k) && (k) < hi)
#define SEAM(k) do { if (IN(k) && IN((k) + 1)) xcd_barrier(bar); } while (0)
    bf16_t* const XN = (bf16_t*)(ws + WS_XN); bf16_t* const PROJ = (bf16_t*)(ws + WS_PROJ);
    const int bx = (int)blockIdx.x;

    if (IN(0)) { p0_prologue(F, args); } SEAM(0);
    if (IN(1)) { pg8::DenseSched S{XN, (const bf16_t*)(ws + WS_WIN), T / 256, NPROJ / 256, F.G, bx}; pg8::EpiStoreBf16 E{PROJ, NPROJ}; pg8::gemm_phase(F.lds, D, S, E); } SEAM(1);
    if (IN(2)) { for (int u = F.vcu; u < 256; u += F.G) ml::mlstm_unit(F.lds, PROJ, (bf16_t*)(ws + WS_HML), args.in[4], args.in[5], u >> 6, (u >> 3) & 7, u & 7); } SEAM(2);
    if (IN(3)) { ml_norm_rows(F, args);
        for (int u = F.vcu; u < 1024; u += F.G) swa::swa_unit(F.lds, PROJ, (bf16_t*)(ws + WS_ASW), args.in[7], args.in[8], args.in[9], u >> 8, (u >> 2) & 63, u & 3); } SEAM(3);
    if (IN(4)) { pg8::DenseSched S{(const bf16_t*)(ws + WS_HML), (const bf16_t*)(ws + WS_WA), T / 256, D / 256, F.G, bx}; pg8::EpiGate<false> E{(bf16_t*)(ws + WS_YA), PROJ + C_GA, NPROJ, nullptr}; pg8::gemm_phase(F.lds, D, S, E); } SEAM(4);
    if (IN(5)) { pg8::DenseSched S{(const bf16_t*)(ws + WS_ASW), (const bf16_t*)(ws + WS_WB), T / 256, D / 256, F.G, bx}; pg8::EpiGate<true> E{(bf16_t*)(ws + WS_MIX), PROJ + C_GB, NPROJ, (const bf16_t*)(ws + WS_YA)}; pg8::gemm_phase(F.lds, D, S, E); } SEAM(5);
    if (IN(6)) { pg8::DenseSched S{(const bf16_t*)(ws + WS_MIX), (const bf16_t*)(ws + WS_WOUT), T / 256, D / 256, F.G, bx}; pg8::EpiResF32 E{args.in[0], args.out}; pg8::gemm_phase(F.lds, D, S, E); } SEAM(6);
    if (IN(7)) { route_phase(F, args); } SEAM(7);
    if (IN(8)) { const int nrt = moe::build_tables(F.lds + TAB_OFF, F.ctl + CW_CUR);
        moe::Tables tb{(const LAS int*)(F.lds + TAB_OFF), (const LAS int*)(F.lds + TAB_OFF + 256), (const LAS int*)(F.lds + TAB_OFF + 512)};
        moe::UpSched S{XN, (const bf16_t*)(ws + WS_WUP), (const int*)(ws + WS_TOKL), tb, nrt, 2 * DFF / 256, F.G, bx}; moe::EpiUp E{(bf16_t*)(ws + WS_ACT), args.in[17], (const float*)(ws + WS_RSL)}; pg8::gemm_phase(F.lds, D, S, E); } SEAM(8);
    if (IN(9)) { const int nrt = moe::build_tables(F.lds + TAB_OFF, F.ctl + CW_CUR);
        moe::Tables tb{(const LAS int*)(F.lds + TAB_OFF), (const LAS int*)(F.lds + TAB_OFF + 256), (const LAS int*)(F.lds + TAB_OFF + 512)};
        moe::DownSched S{(const bf16_t*)(ws + WS_ACT), (const bf16_t*)(ws + WS_WDN), tb, nrt, D / 256, F.G, bx}; moe::EpiDown E{(bf16_t*)(ws + WS_YS), args.in[19], (const float*)(ws + WS_GATEL), (const int*)(ws + WS_DESTL)}; pg8::gemm_phase(F.lds, DFF, S, E); } SEAM(9);
    if (IN(10)) { combine_rows(F, args);
        pg8::DenseSched S{(const bf16_t*)(ws + WS_PBF), (const bf16_t*)(ws + WS_WPP), T / 256, D / 256, F.G, bx}; pg8::EpiStoreBf16 E{(bf16_t*)(ws + WS_PP), D}; pg8::gemm_phase(F.lds, PLE, S, E); } SEAM(10);
    if (IN(11)) { pg8::DenseSched S{XN, (const bf16_t*)(ws + WS_WPG), T / 256, D / 256, F.G, bx}; pg8::EpiPle E{args.out, (const bf16_t*)(ws + WS_PP)}; pg8::gemm_phase(F.lds, D, S, E); }
#undef IN
#undef SEAM
}


#ifdef DBG_DUMP
__global__ void dbg_dump(const bf16_t* src, int ld, int coff, float* out) {
    for (size_t i = (size_t)blockIdx.x * blockDim.x + threadIdx.x; i < (size_t)T * D; i += (size_t)gridDim.x * blockDim.x) { const size_t r = i / D, c = i % D; out[i] = bf1(src[r * ld + coff + c]); }
}
#endif
extern "C" void kernel_launch(void* const* d_in, const int* in_sizes, int n_in, void* d_out, int out_size, void* d_ws, size_t ws_size, hipStream_t stream) {
    static int grid = 0;
    if (grid == 0) {
        if (n_in != 23 || in_sizes[0] != T * D || out_size != T * D || ws_size < WS_END) { fprintf(stderr, "kernel_launch: unexpected shapes (n_in %d, in0 %d, out %d, ws %zu; need ws >= %zu); nothing launched\n", n_in, n_in > 0 ? in_sizes[0] : -1, out_size, ws_size, (size_t)WS_END); grid = -1; return; }
        int dev = 0, cus = 0, per_cu = 0;
        if (hipGetDevice(&dev) != hipSuccess || hipDeviceGetAttribute(&cus, hipDeviceAttributeMultiprocessorCount, dev) != hipSuccess) { fprintf(stderr, "kernel_launch: device query failed\n"); grid = -1; return; }
        if (hipFuncSetAttribute((const void*)mk_fwd, hipFuncAttributeMaxDynamicSharedMemorySize, LDS_BYTES) != hipSuccess) { fprintf(stderr, "kernel_launch: hipFuncSetAttribute failed\n"); grid = -1; return; }
        if (hipOccupancyMaxActiveBlocksPerMultiprocessor(&per_cu, (const void*)mk_fwd, NWAVES * 64, LDS_BYTES) != hipSuccess || per_cu < 1) fprintf(stderr, "kernel_launch: occupancy query reports %d workgroups per CU\n", per_cu);
        (void)hipGetLastError();
        grid = cus;
    }
    if (grid < 0) return;
    if (hipMemsetAsync((char*)d_ws + WS_CTL, 0, CTL_ZERO_BYTES, stream) != hipSuccess) { fprintf(stderr, "kernel_launch: memset failed\n"); return; }
    Args a{};
    for (int i = 0; i < 23; ++i) a.in[i] = (const float*)d_in[i];
    a.out = (float*)d_out; a.ws = (unsigned char*)d_ws;
#ifndef DBG_LAST
#define DBG_LAST NPHASE
#endif
    for (int li = 0; li < MK_N_LAUNCHES && li < DBG_LAST; ++li) {
        a.ph_lo = (MK_N_LAUNCHES == 1) ? 0 : li; a.ph_hi = (MK_N_LAUNCHES == 1) ? NPHASE : li + 1;
        hipLaunchKernelGGL(mk_fwd, dim3(grid), dim3(NWAVES * 64), LDS_BYTES, stream, a);
        const hipError_t le = hipPeekAtLastError();
        if (le != hipSuccess) { fprintf(stderr, "kernel_launch: launch %d failed: %s\n", li, hipGetErrorName(le)); break; }
    }
#ifdef DBG_DUMP
    { const bf16_t* s = (const bf16_t*)((unsigned char*)d_ws + DBG_DUMP_OFF); hipLaunchKernelGGL(dbg_dump, dim3(2048), dim3(256), 0, stream, s, DBG_DUMP_LD, DBG_DUMP_COL, (float*)d_out); }
#endif
}
```

```cpp
#include <hip/hip_runtime.h>
#include <cstdio>
#include <cstdint>

#ifndef MK_N_LAUNCHES
#define MK_N_LAUNCHES 1
#endif

#define GAS __attribute__((address_space(1)))
#define LAS __attribute__((address_space(3)))
typedef unsigned short bf16_t;
typedef short bf16x8 __attribute__((ext_vector_type(8)));
typedef short s16x4 __attribute__((ext_vector_type(4)));
typedef float f32x2 __attribute__((ext_vector_type(2)));
typedef float f32x4 __attribute__((ext_vector_type(4)));
typedef float f32x16 __attribute__((ext_vector_type(16)));
typedef unsigned u32x2 __attribute__((ext_vector_type(2)));
typedef unsigned u32x4 __attribute__((ext_vector_type(4)));
typedef int i32x4 __attribute__((ext_vector_type(4)));

constexpr int BATCH = 4, SEQ = 8192, T = BATCH * SEQ, D = 2048;
constexpr int PLE = 256;
constexpr int NE = 32, TOPK = 4, DFF = 2048, CAP = T;
constexpr int NPROJ = 13056;
constexpr int C_MLQ = 0, C_MLK = 1024, C_MLV = 2048, C_MLO = 4096, C_SWQ = 6144, C_SWK = 8192, C_SWV = 8448, C_GA = 8704, C_GB = 10752, C_GI = 12800, C_GF = 12808;
constexpr int DIN = 12816;
constexpr float EPS = 1e-6f;
constexpr float LOG2E = 1.4426950408889634f;
constexpr int ACT_ROWS = 139264;

constexpr size_t MiB = 1u << 20;
constexpr size_t WS_CTL = 0, CTL_ZERO_BYTES = 1 * MiB;
constexpr size_t WS_WIN = 2 * MiB;
constexpr size_t WS_WA = 54 * MiB, WS_WB = 62 * MiB, WS_WOUT = 70 * MiB, WS_WPG = 78 * MiB, WS_WPP = 86 * MiB, WS_WRP = 87 * MiB, WS_SWUP = 88 * MiB, WS_SWIN = 89 * MiB, WS_SA1 = 90 * MiB;
constexpr size_t WS_WUP = 96 * MiB;
constexpr size_t WS_WDN = 608 * MiB;
constexpr size_t WS_XN = 864 * MiB;
constexpr size_t WS_PROJ = 992 * MiB;
constexpr size_t WS_HML = 1808 * MiB;
constexpr size_t WS_ASW = 1936 * MiB;
constexpr size_t WS_YA = 2064 * MiB, WS_MIX = 2192 * MiB;
constexpr size_t WS_PBF = 2320 * MiB;
constexpr size_t WS_PP = 2336 * MiB;
constexpr size_t WS_ACT = 2464 * MiB;
constexpr size_t WS_YS = 3008 * MiB;
constexpr size_t WS_TOKL = 3520 * MiB, WS_GATEL = 3524 * MiB, WS_DESTL = 3528 * MiB, WS_RSL = 3532 * MiB;
constexpr size_t WS_END = 3536 * MiB;
constexpr int CW_TMO = 0, CW_CODE = 1;
constexpr int CW_BAR = 4096;
constexpr int CW_CUR = 16384;

constexpr int RING_BYTES = 131072;
constexpr int TAB_OFF = RING_BYTES;
constexpr int MISC_OFF = RING_BYTES + 8192;
constexpr int LDS_BYTES = 147456;
constexpr int NWAVES = 8;

#define RLX_AGENT __ATOMIC_RELAXED, __HIP_MEMORY_SCOPE_AGENT
#define LDS_WAIT() asm volatile("s_waitcnt lgkmcnt(0)" ::: "memory")
#define VM_WAIT() asm volatile("s_waitcnt vmcnt(0)" ::: "memory")

typedef __bf16 bf16x2_t __attribute__((ext_vector_type(2)));
__device__ __forceinline__ unsigned cvt_pk_bf16(float lo, float hi) { const f32x2 v = {lo, hi}; const bf16x2_t b = __builtin_convertvector(v, bf16x2_t); return __builtin_bit_cast(unsigned, b); }
__device__ __forceinline__ float bf_lo(unsigned w) { return __uint_as_float(w << 16); }
__device__ __forceinline__ float bf_hi(unsigned w) { return __uint_as_float(w & 0xffff0000u); }
__device__ __forceinline__ float bf1(bf16_t b) { return __uint_as_float(((unsigned)b) << 16); }
__device__ __forceinline__ float sigmoidf_(float x) { return 1.0f / (1.0f + __expf(-x)); }
__device__ __forceinline__ float wave_sum(float v) {
#pragma unroll
    for (int o = 1; o < 64; o <<= 1) v += __shfl_xor(v, o);
    return v;
}

namespace pg8 {
constexpr int BM = 256, BK = 64, HALF = 128, HTB = HALF * BK * 2, STAGE_BYTES = 8 * HTB, NXCD = 8, WGM = 8;
__host__ __device__ __forceinline__ int lds_byte(int r, int c) { const int st = (r >> 4) * 2 + (c >> 5), rr = r & 15, cc = c & 31, ob = rr * 64 + cc * 2; return st * 1024 + (ob ^ (((ob >> 9) & 1) << 5)); }
__host__ __device__ __forceinline__ void stage_rc(int b, int& R, int& C) { const int st = b / 1024, sb = b % 1024, swz = sb ^ (((sb >> 9) & 1) << 5); R = (st >> 1) * 16 + swz / 64; C = (st & 1) * 32 + (swz % 64) / 2; }
__host__ __device__ __forceinline__ int perm32(int rho) { const int n = rho >> 4, i = rho & 15; return 8 * (i >> 2) + 4 * n + (i & 3); }

struct Unit { int pm, pn, e, r0, cnt; };

__device__ __forceinline__ void map_unit(int L, int nM, int nN, int& pm, int& pn) {
    const int nwg = nM * nN;
    int wgid = L; { const int q = nwg / NXCD, r = nwg % NXCD, xcd = wgid % NXCD, off = wgid / NXCD; wgid = (xcd < r ? xcd * (q + 1) : r * (q + 1) + (xcd - r) * q) + off; }
    const int nig = WGM * nN, gid = wgid / nig, fm = gid * WGM, gsz = (nM - fm) < WGM ? (nM - fm) : WGM;
    pm = fm + ((wgid % nig) % gsz); pn = (wgid % nig) / gsz;
}

struct DenseSched {
    static constexpr bool GATHER = false;
    const bf16_t* A; const bf16_t* Bt; int nM, nN, G, c;
    __device__ __forceinline__ bool next(int i, Unit& u) const { const long L = (long)i * G + c; if (L >= (long)nM * nN) return false; map_unit((int)L, nM, nN, u.pm, u.pn); u.e = 0; u.r0 = 0; u.cnt = 0; return true; }
    __device__ __forceinline__ const char* a_base() const { return (const char*)A; }
    __device__ __forceinline__ void a_offs(const Unit& u, const int (&R)[2], const int (&C)[2], int Kb, unsigned (&vo)[2][2]) const {
#pragma unroll
        for (int h = 0; h < 2; ++h)
#pragma unroll
            for (int i = 0; i < 2; ++i) vo[h][i] = (unsigned)(u.pm * BM + h * HALF + R[i]) * (unsigned)Kb + (unsigned)C[i] * 2u;
    }
    __device__ __forceinline__ const char* a_tile(const Unit& u, int Kb) const { return (const char*)A + (size_t)u.pm * BM * Kb; }
    __device__ __forceinline__ const char* b_tile(const Unit& u, int Kb) const { return (const char*)Bt + (size_t)u.pn * BM * Kb; }
};
template <bool I8> struct AccSel { typedef f32x4 type; };
template <> struct AccSel<true> { typedef i32x4 type; };

template <bool I8> __device__ __forceinline__ typename AccSel<I8>::type mma1(const bf16x8 a, const bf16x8 b, const typename AccSel<I8>::type c) {
    if constexpr (I8) return __builtin_amdgcn_mfma_i32_16x16x64_i8(__builtin_bit_cast(i32x4, a), __builtin_bit_cast(i32x4, b), c, 0, 0, 0);
    else return __builtin_amdgcn_mfma_f32_16x16x32_bf16(a, b, c, 0, 0, 0);
}
template <class Epi, class Sched>
__device__ __forceinline__ void gemm_phase(LAS unsigned char* lds, const int Kb, const Sched& S, const Epi& E) {
    constexpr bool I8 = Epi::I8;
    typedef typename AccSel<I8>::type acc_t;
    const int tid = threadIdx.x, wid = __builtin_amdgcn_readfirstlane(tid >> 6), lane = tid & 63, wr = wid >> 2, wc = wid & 3, fr = lane & 15, fq = lane >> 4;
    const int K = Kb;
    const int nt = Kb / (BK * 2);
    int Rr[2], Cc[2]; unsigned voffB[2];
#pragma unroll
    for (int i = 0; i < 2; ++i) { int R, C; stage_rc(tid * 16 + i * 8192, R, C); Rr[i] = R; Cc[i] = C; const int Rb = Epi::PERM ? ((R & ~31) + perm32(R & 31)) : R; voffB[i] = (unsigned)(Rb * Kb + C * 2); }
    const size_t kstep = (size_t)(BK * 2);
    const size_t hstep = (size_t)HALF * Kb;
    const unsigned ldsw = (unsigned)wid * 1024u;
    const int aoff = lds_byte(wr * 64 + fr, fq * 8), boff = lds_byte(wc * 32 + fr, fq * 8);
#define PG8_SA(b, h) (((b) * 2 + (h)) * HTB)
#define PG8_SB(b, h) ((4 + (b) * 2 + (h)) * HTB)
#define PG8_STAGE(bufoff, gbase, voff) do { _Pragma("unroll") for (int _i = 0; _i < 2; ++_i) \
        __builtin_amdgcn_global_load_lds((const unsigned*)((const char*)(gbase) + (voff)[_i]), (LAS unsigned*)(lds + (bufoff) + ldsw + _i * 8192), 16, 0, 0); } while (0)
#define PG8_LDA(dst, b, h) do { _Pragma("unroll") for (int m = 0; m < 4; ++m) _Pragma("unroll") for (int k = 0; k < 2; ++k) dst[m][k] = *(const LAS bf16x8*)(lds + PG8_SA(b, h) + aoff + m * 2048 + k * 1024); } while (0)
#define PG8_LDB(dst, b, h) do { _Pragma("unroll") for (int n = 0; n < 2; ++n) _Pragma("unroll") for (int k = 0; k < 2; ++k) dst[n][k] = *(const LAS bf16x8*)(lds + PG8_SB(b, h) + boff + n * 2048 + k * 1024); } while (0)
#define PG8_MMA(ai, bj, At, Bt) do { __builtin_amdgcn_s_setprio(1); _Pragma("unroll") for (int m = 0; m < 4; ++m) _Pragma("unroll") for (int n = 0; n < 2; ++n) _Pragma("unroll") for (int k = 0; k < 2; ++k) \
        acc[ai][bj][m][n] = mma1<I8>(Bt[n][k], At[m][k], acc[ai][bj][m][n]); __builtin_amdgcn_s_setprio(0); } while (0)
#define PG8_WAIT_V(n) asm volatile("s_waitcnt vmcnt(" #n ")" ::: "memory")
#define PG8_WAIT_L(n) asm volatile("s_waitcnt lgkmcnt(" #n ")" ::: "memory")
#define PG8_BAR __builtin_amdgcn_s_barrier()
#define PG8_SCHED __builtin_amdgcn_sched_barrier(0)
    Unit cur, nxt; int ui = 0;
    if (!S.next(0, cur)) return;
    acc_t acc[2][2][4][2];
#pragma unroll
    for (int a = 0; a < 2; ++a)
#pragma unroll
        for (int b = 0; b < 2; ++b)
#pragma unroll
            for (int m = 0; m < 4; ++m)
#pragma unroll
                for (int n = 0; n < 2; ++n) acc[a][b][m][n] = (acc_t){0, 0, 0, 0};
    bf16x8 At[4][2], B0[2][2], B1[2][2];
    constexpr bool GA = Sched::GATHER;
    unsigned cvo[2][2], nvo[2][2];
    if constexpr (GA) S.a_offs(cur, Rr, Cc, K, cvo);
    else {
#pragma unroll
        for (int h = 0; h < 2; ++h)
#pragma unroll
            for (int i = 0; i < 2; ++i) cvo[h][i] = (unsigned)(h * HALF + Rr[i]) * (unsigned)Kb + (unsigned)Cc[i] * 2u;
    }
    const char* cA = S.a_tile(cur, K);
    const char* cB = S.b_tile(cur, K);
    PG8_STAGE(PG8_SB(0, 0), cB, voffB); PG8_STAGE(PG8_SB(0, 1), cB + hstep, voffB); PG8_STAGE(PG8_SA(0, 0), cA, cvo[0]); PG8_STAGE(PG8_SA(0, 1), cA, cvo[1]);
    if (wr == 1) PG8_BAR;
    PG8_WAIT_V(2); PG8_BAR;
    PG8_STAGE(PG8_SB(1, 0), cB + kstep, voffB); PG8_STAGE(PG8_SA(1, 0), cA + kstep, cvo[0]); PG8_STAGE(PG8_SB(1, 1), cB + hstep + kstep, voffB);
    PG8_WAIT_V(6); PG8_BAR;
    for (;;) {
        const bool has_next = S.next(ui + 1, nxt);
        const char* nB = cB; const char* nA = cA;
        if (has_next) { if constexpr (GA) S.a_offs(nxt, Rr, Cc, K, nvo); nB = S.b_tile(nxt, K); nA = S.a_tile(nxt, K); }
        else if constexpr (GA) {
#pragma unroll
            for (int h = 0; h < 2; ++h)
#pragma unroll
                for (int i = 0; i < 2; ++i) nvo[h][i] = cvo[h][i];
        }
        for (int t = 0; t < nt; t += 2) {
            const bool last = (t == nt - 2);
            const char* a1 = cA + (size_t)(t + 1) * kstep;
            const char* a2 = last ? nA : cA + (size_t)(t + 2) * kstep; const char* b2 = last ? nB : cB + (size_t)(t + 2) * kstep;
            const char* a3 = a2 + kstep; const char* b3 = b2 + kstep;
#define PG8_O2(h) (GA ? (last ? nvo[h] : cvo[h]) : cvo[h])
            PG8_LDB(B0, 0, 0); PG8_LDB(B1, 0, 1); PG8_SCHED; PG8_LDA(At, 0, 0); PG8_STAGE(PG8_SA(1, 1), a1, cvo[1]);
            PG8_WAIT_V(8); PG8_WAIT_L(0); PG8_BAR; PG8_MMA(0, 0, At, B0); PG8_MMA(0, 1, At, B1); PG8_BAR; PG8_SCHED;
            PG8_LDA(At, 0, 1); PG8_STAGE(PG8_SB(0, 0), b2, voffB); PG8_STAGE(PG8_SB(0, 1), b2 + hstep, voffB); PG8_STAGE(PG8_SA(0, 0), a2, PG8_O2(0));
            PG8_WAIT_V(8); PG8_WAIT_L(0); PG8_BAR; PG8_MMA(1, 0, At, B0); PG8_MMA(1, 1, At, B1); PG8_BAR; PG8_SCHED;
            PG8_LDB(B0, 1, 0); PG8_LDB(B1, 1, 1); PG8_SCHED; PG8_LDA(At, 1, 0); PG8_STAGE(PG8_SA(0, 1), a2, PG8_O2(1));
            PG8_WAIT_V(8); PG8_WAIT_L(0); PG8_BAR; PG8_MMA(0, 0, At, B0); PG8_MMA(0, 1, At, B1); PG8_BAR; PG8_SCHED;
            PG8_LDA(At, 1, 1); PG8_STAGE(PG8_SB(1, 0), b3, voffB); PG8_STAGE(PG8_SB(1, 1), b3 + hstep, voffB); PG8_STAGE(PG8_SA(1, 0), a3, PG8_O2(0));
            PG8_WAIT_V(8); PG8_WAIT_L(0); PG8_BAR; PG8_MMA(1, 0, At, B0); PG8_MMA(1, 1, At, B1); PG8_BAR; PG8_SCHED;
#undef PG8_O2
        }
        if (wr == 0) PG8_BAR;
        E(acc, cur, wr, wc, fr, fq);
        if (!has_next) break;
#pragma unroll
        for (int a = 0; a < 2; ++a)
#pragma unroll
            for (int b = 0; b < 2; ++b)
#pragma unroll
                for (int m = 0; m < 4; ++m)
#pragma unroll
                    for (int n = 0; n < 2; ++n) acc[a][b][m][n] = (acc_t){0, 0, 0, 0};
        cur = nxt; cB = nB; cA = nA; ++ui;
        if constexpr (GA) {
#pragma unroll
            for (int h = 0; h < 2; ++h)
#pragma unroll
                for (int i = 0; i < 2; ++i) cvo[h][i] = nvo[h][i];
        }
        if (wr == 1) PG8_BAR;
    }
    PG8_WAIT_V(0);
    PG8_BAR;
#undef PG8_SA
#undef PG8_SB
#undef PG8_STAGE
#undef PG8_LDA
#undef PG8_LDB
#undef PG8_MMA
#undef PG8_WAIT_V
#undef PG8_WAIT_L
#undef PG8_BAR
#undef PG8_SCHED
}

__device__ __forceinline__ u32x4 pack8(const f32x4 v0, const f32x4 v1) { u32x4 w; w.x = cvt_pk_bf16(v0[0], v0[1]); w.y = cvt_pk_bf16(v0[2], v0[3]); w.z = cvt_pk_bf16(v1[0], v1[1]); w.w = cvt_pk_bf16(v1[2], v1[3]); return w; }
__device__ __forceinline__ void unpack8(const u32x4 w, f32x4& v0, f32x4& v1) { v0 = (f32x4){bf_lo(w.x), bf_hi(w.x), bf_lo(w.y), bf_hi(w.y)}; v1 = (f32x4){bf_lo(w.z), bf_hi(w.z), bf_lo(w.w), bf_hi(w.w)}; }
__device__ __forceinline__ f32x4 sig4(const f32x4 v) { return (f32x4){sigmoidf_(v[0]), sigmoidf_(v[1]), sigmoidf_(v[2]), sigmoidf_(v[3])}; }

struct EpiStoreBf16 {
    static constexpr bool PERM = true, I8 = false;
    bf16_t* O; int ldc;
    __device__ __forceinline__ void operator()(const f32x4 (&acc)[2][2][4][2], const Unit& u, int wr, int wc, int fr, int fq) const {
        const int row0 = u.pm * BM + wr * 64 + fr, col0 = u.pn * BM + wc * 32 + 8 * fq;
#pragma unroll
        for (int ai = 0; ai < 2; ++ai)
#pragma unroll
            for (int m = 0; m < 4; ++m) { bf16_t* rowp = O + (size_t)(row0 + ai * HALF + m * 16) * ldc + col0;
#pragma unroll
                for (int bj = 0; bj < 2; ++bj) *(u32x4*)(rowp + bj * HALF) = pack8(acc[ai][bj][m][0], acc[ai][bj][m][1]); }
    }
};
struct EpiProjI8 {
    static constexpr bool PERM = true, I8 = true;
    bf16_t* O; int ldc; const float* sa; const float* sw;
    __device__ __forceinline__ void operator()(const i32x4 (&acc)[2][2][4][2], const Unit& u, int wr, int wc, int fr, int fq) const {
        const int row0 = u.pm * BM + wr * 64 + fr, col0 = u.pn * BM + wc * 32 + 8 * fq;
        f32x4 sc[2][2];
#pragma unroll
        for (int bj = 0; bj < 2; ++bj)
#pragma unroll
            for (int n = 0; n < 2; ++n) sc[bj][n] = *(const f32x4*)(sw + col0 + bj * HALF + 4 * n);
#pragma unroll
        for (int ai = 0; ai < 2; ++ai)
#pragma unroll
            for (int m = 0; m < 4; ++m) { const int row = row0 + ai * HALF + m * 16; const float rs = sa[row]; bf16_t* rowp = O + (size_t)row * ldc + col0;
#pragma unroll
                for (int bj = 0; bj < 2; ++bj) *(u32x4*)(rowp + bj * HALF) = pack8(__builtin_convertvector(acc[ai][bj][m][0], f32x4) * rs * sc[bj][0], __builtin_convertvector(acc[ai][bj][m][1], f32x4) * rs * sc[bj][1]); }
    }
};
template <bool ADD> struct EpiGate {
    static constexpr bool PERM = true, I8 = false;
    bf16_t* O; const bf16_t* Gt; int ldg; const bf16_t* Y;
    __device__ __forceinline__ void operator()(const f32x4 (&acc)[2][2][4][2], const Unit& u, int wr, int wc, int fr, int fq) const {
        const int row0 = u.pm * BM + wr * 64 + fr, col0 = u.pn * BM + wc * 32 + 8 * fq;
#pragma unroll
        for (int ai = 0; ai < 2; ++ai)
#pragma unroll
            for (int m = 0; m < 4; ++m) { const size_t row = (size_t)(row0 + ai * HALF + m * 16);
#pragma unroll
                for (int bj = 0; bj < 2; ++bj) {
                    const u32x4 gw = *(const u32x4*)(Gt + row * ldg + col0 + bj * HALF); f32x4 g0, g1; unpack8(gw, g0, g1);
                    f32x4 v0 = sig4(g0) * acc[ai][bj][m][0], v1 = sig4(g1) * acc[ai][bj][m][1];
                    if (ADD) { const u32x4 yw = *(const u32x4*)(Y + row * D + col0 + bj * HALF); f32x4 y0, y1; unpack8(yw, y0, y1); v0 += y0; v1 += y1; }
                    *(u32x4*)(O + row * D + col0 + bj * HALF) = pack8(v0, v1); } }
    }
};
struct EpiResF32 {
    static constexpr bool PERM = false, I8 = false;
    const float* X; float* O;
    __device__ __forceinline__ void operator()(const f32x4 (&acc)[2][2][4][2], const Unit& u, int wr, int wc, int fr, int fq) const {
        const int row0 = u.pm * BM + wr * 64 + fr, col0 = u.pn * BM + wc * 32 + 4 * fq;
#pragma unroll
        for (int ai = 0; ai < 2; ++ai)
#pragma unroll
            for (int m = 0; m < 4; ++m) { const size_t off = (size_t)(row0 + ai * HALF + m * 16) * D + col0;
#pragma unroll
                for (int bj = 0; bj < 2; ++bj)
#pragma unroll
                    for (int n = 0; n < 2; ++n) { const f32x4 xv = *(const f32x4*)(X + off + bj * HALF + n * 16); *(f32x4*)(O + off + bj * HALF + n * 16) = xv + acc[ai][bj][m][n]; } }
    }
};
struct EpiPle {
    static constexpr bool PERM = false, I8 = false;
    float* O; const bf16_t* PP;
    __device__ __forceinline__ void operator()(const f32x4 (&acc)[2][2][4][2], const Unit& u, int wr, int wc, int fr, int fq) const {
        const int row0 = u.pm * BM + wr * 64 + fr, col0 = u.pn * BM + wc * 32 + 4 * fq;
#pragma unroll
        for (int ai = 0; ai < 2; ++ai)
#pragma unroll
            for (int m = 0; m < 4; ++m) { const size_t off = (size_t)(row0 + ai * HALF + m * 16) * D + col0;
#pragma unroll
                for (int bj = 0; bj < 2; ++bj)
#pragma unroll
                    for (int n = 0; n < 2; ++n) { const size_t o = off + bj * HALF + n * 16; const f32x4 hv = *(const f32x4*)(O + o); const u32x2 pw = *(const u32x2*)(PP + o);
                        const f32x4 pv = (f32x4){bf_lo(pw.x), bf_hi(pw.x), bf_lo(pw.y), bf_hi(pw.y)}; *(f32x4*)(O + o) = hv + sig4(acc[ai][bj][m][n]) * pv; } }
    }
};
}

#define XB_TMO      128
#define XB_XCNT(j)  (256  + 64 * (j))
#define XB_XSUB(j)  (1280 + 64 * (j))
#define XB_XGEN(j)  (2304 + 64 * (j))
#define XB_TOP      3328
#define XB_TOPGEN   3392
#define XCD_BAR_WORDS 3456
#define XB_SPIN_CAP (1u << 22)

__device__ __forceinline__ unsigned xb_ld(unsigned* p)              { return __hip_atomic_load(p, __ATOMIC_RELAXED, __HIP_MEMORY_SCOPE_AGENT); }
__device__ __forceinline__ unsigned xb_add(unsigned* p, unsigned v) { return __hip_atomic_fetch_add(p, v, __ATOMIC_RELAXED, __HIP_MEMORY_SCOPE_AGENT); }
__device__ __forceinline__ unsigned xb_xcc_id() { return (unsigned)__builtin_amdgcn_s_getreg((3 << 11) | 20) & 0xFu; }
#define XB_SPIN(cond, bar) do { unsigned _sp = 0; while (cond) { __builtin_amdgcn_s_sleep(1); \
    if ((++_sp & 255u) == 0u) { if (xb_ld(&(bar)[XB_TMO])) break; if (_sp > XB_SPIN_CAP) { atomicAdd(&(bar)[XB_TMO], 1u); break; } } } } while (0)

struct XcdBarrier { unsigned* bar; unsigned x; volatile LAS unsigned* st; };

__device__ __forceinline__ XcdBarrier xcd_barrier_post(unsigned* bar, volatile LAS unsigned* st) {
    XcdBarrier b; b.bar = bar; b.x = xb_xcc_id(); b.st = st;
    if (threadIdx.x == 0) (void)xb_add(&bar[XB_XCNT(b.x)], 1u);
    return b;
}
__device__ __forceinline__ void xcd_barrier_complete(unsigned* bar, unsigned x, unsigned& nloc, unsigned& nx) {
    const unsigned G = gridDim.x * gridDim.y * gridDim.z;
    unsigned sum, cnt, mine, sp = 0u;
    for (;;) {
        sum = 0u; cnt = 0u; mine = 0u;
#pragma unroll
        for (unsigned j = 0; j < 16; ++j) { const unsigned c = xb_ld(&bar[XB_XCNT(j)]); sum += c; cnt += (c > 0u) ? 1u : 0u; mine = (j == x) ? c : mine; }
        if (sum == G) break;
        __builtin_amdgcn_s_sleep(1);
        if ((++sp & 255u) == 0u) { if (xb_ld(&bar[XB_TMO])) break; if (sp > XB_SPIN_CAP) { atomicAdd(&bar[XB_TMO], 1u); break; } }
    }
    nloc = mine > 0u ? mine : 1u; nx = cnt > 0u ? cnt : 1u;
}
__device__ __forceinline__ void xcd_barrier(const XcdBarrier& b) {
    asm volatile("s_waitcnt vmcnt(0)" ::: "memory");
    __syncthreads();
    if (threadIdx.x == 0) {
        unsigned* bar = b.bar;
        __builtin_amdgcn_s_waitcnt(0);
        unsigned nloc = b.st[0], nx = b.st[1];
        if (nloc == 0u) { xcd_barrier_complete(bar, b.x, nloc, nx); b.st[0] = nloc; b.st[1] = nx; }
        const unsigned old = xb_add(&bar[XB_XSUB(b.x)], 1u);
        const unsigned gen = old / nloc;
        if (old + 1u == (gen + 1u) * nloc) {
            __builtin_amdgcn_fence(__ATOMIC_RELEASE, "agent");
            asm volatile("s_waitcnt vmcnt(0)" ::: "memory");
            const unsigned og = xb_add(&bar[XB_TOP], 1u);
            const unsigned tg = og / nx;
            if (og + 1u == (tg + 1u) * nx) xb_add(&bar[XB_TOPGEN], 1u);
            else XB_SPIN(xb_ld(&bar[XB_TOPGEN]) == tg, bar);
            __builtin_amdgcn_fence(__ATOMIC_ACQUIRE, "agent");
            xb_add(&bar[XB_XGEN(b.x)], 1u);
            asm volatile("s_waitcnt vmcnt(0)" ::: "memory");
        } else {
            XB_SPIN(xb_ld(&bar[XB_XGEN(b.x)]) == gen, bar);
            __builtin_amdgcn_fence(__ATOMIC_ACQUIRE, "agent");
            asm volatile("s_waitcnt vmcnt(0)" ::: "memory");
        }
    }
    __syncthreads();
}

struct Frame {
    LAS unsigned char* lds;
    unsigned* ctl;
    int tid, lane, wave, vcu, G;
    unsigned char* ws;
};
struct Args { const float* in[23]; float* out; unsigned char* ws; int ph_lo, ph_hi; };

template <class RowMap>
__device__ __forceinline__ void transpose_item(const float* W, int K, int N, bf16_t* WT, const RowMap rm, LAS float* scr, int item, int lane) {
    const int nblk = (N + 31) / 32, kb = item / nblk, nb = item % nblk, k0 = 64 * kb, n0 = 32 * nb;
    const int nc = n0 + (lane & 31); const bool ok = nc < N;
    float tv[32];
#pragma unroll
    for (int i = 0; i < 32; ++i) tv[i] = W[(size_t)(k0 + 2 * i + (lane >> 5)) * N + (ok ? nc : n0)];
#pragma unroll
    for (int i = 0; i < 32; ++i) scr[(2 * i + (lane >> 5)) * 33 + (lane & 31)] = ok ? tv[i] : 0.f;
    LDS_WAIT(); asm volatile("" ::: "memory");
    const int c = lane & 7;
#pragma unroll
    for (int j = 0; j < 4; ++j) { const int n = (lane >> 3) + 8 * j; const LAS float* s = scr + (8 * c) * 33 + n;
        u32x4 o; o.x = cvt_pk_bf16(s[0 * 33], s[1 * 33]); o.y = cvt_pk_bf16(s[2 * 33], s[3 * 33]); o.z = cvt_pk_bf16(s[4 * 33], s[5 * 33]); o.w = cvt_pk_bf16(s[6 * 33], s[7 * 33]);
        if (n0 + n < N) *(u32x4*)(WT + (size_t)rm(n0 + n) * K + k0 + 8 * c) = o; }
    LDS_WAIT(); asm volatile("" ::: "memory");
}
template <class RowMap, class ScaleMap>
__device__ __forceinline__ void quant_panel_wg(const float* W, int N, signed char* WT, float* sw, const RowMap rm, const ScaleMap sm, LAS float* scr, LAS float* wmax, int nb, int wave, int lane) {
    const int n0 = 32 * nb, nc = n0 + (lane & 31); const bool ok = nc < N;
    const float* wp = W + (size_t)(256 * wave + (lane >> 5)) * N + (ok ? nc : n0);
    float v[4][32]; float mx = 0.f;
#pragma unroll
    for (int kb = 0; kb < 4; ++kb)
#pragma unroll
        for (int i = 0; i < 32; ++i) v[kb][i] = wp[(size_t)(64 * kb + 2 * i) * N];
#pragma unroll
    for (int kb = 0; kb < 4; ++kb)
#pragma unroll
        for (int i = 0; i < 32; ++i) mx = fmaxf(mx, fabsf(v[kb][i]));
    mx = fmaxf(mx, __shfl_xor(mx, 32));
    if (lane < 32) wmax[wave * 32 + lane] = ok ? mx : 0.f;
    __syncthreads();
    float cm = 1e-30f;
#pragma unroll
    for (int w = 0; w < 8; ++w) cm = fmaxf(cm, wmax[w * 32 + (lane & 31)]);
    const float qs = 127.0f / cm;
    if (wave == 0 && lane < 32 && ok) sw[sm(nc)] = cm * (1.0f / 127.0f);
    const int n = lane >> 1, half = lane & 1; const bool okw = (n0 + n) < N;
    signed char* orow = WT + (size_t)rm(okw ? n0 + n : n0) * 2048 + 256 * wave + 32 * half;
#pragma unroll
    for (int kb = 0; kb < 4; ++kb) {
#pragma unroll
        for (int i = 0; i < 32; ++i) scr[(2 * i + (lane >> 5)) * 33 + (lane & 31)] = ok ? v[kb][i] * qs : 0.f;
        LDS_WAIT(); asm volatile("" ::: "memory");
        unsigned w[8];
#pragma unroll
        for (int q = 0; q < 8; ++q) { unsigned pk = 0u;
#pragma unroll
            for (int b = 0; b < 4; ++b) { const int iv = __float2int_rn(scr[(32 * half + 4 * q + b) * 33 + n]); pk |= ((unsigned)iv & 0xffu) << (8 * b); }
            w[q] = pk; }
        if (okw) { *(u32x4*)(orow + 64 * kb) = (u32x4){w[0], w[1], w[2], w[3]}; *(u32x4*)(orow + 64 * kb + 16) = (u32x4){w[4], w[5], w[6], w[7]}; }
        LDS_WAIT(); asm volatile("" ::: "memory");
    }
    __syncthreads();
}
struct MapId { __device__ __forceinline__ int operator()(int n) const { return n; } };
struct MapWin { __device__ __forceinline__ int operator()(int n) const { return n < 6144 ? n : (n < 6160 ? C_GI + (n - 6144) : n - 16); } };
struct MapUp { __device__ __forceinline__ int operator()(int n) const { const int c = n & 2047, lin = n >> 11; return 256 * (c >> 7) + 128 * lin + (c & 127); } };

__device__ __forceinline__ void rms_row_to_bf16(const float* xrow, const float* w, bf16_t* orow, int lane) {
    f32x4 v[4][2]; float s = 0.f;
#pragma unroll
    for (int j = 0; j < 4; ++j)
#pragma unroll
        for (int q = 0; q < 2; ++q) { v[j][q] = *(const f32x4*)(xrow + 512 * j + 8 * lane + 4 * q); s += (v[j][q].x * v[j][q].x + v[j][q].y * v[j][q].y) + (v[j][q].z * v[j][q].z + v[j][q].w * v[j][q].w); }
    const float rstd = 1.0f / sqrtf(wave_sum(s) * (1.f / D) + EPS);
#pragma unroll
    for (int j = 0; j < 4; ++j) { const f32x4 w0 = *(const f32x4*)(w + 512 * j + 8 * lane), w1 = *(const f32x4*)(w + 512 * j + 8 * lane + 4);
        *(u32x4*)(orow + 512 * j + 8 * lane) = pg8::pack8(v[j][0] * rstd * w0, v[j][1] * rstd * w1); }
}

__device__ __forceinline__ void rms_row_to_i8(const float* xrow, const float* w, signed char* orow, float* sa, int lane) {
    f32x4 v[4][2]; float s = 0.f;
#pragma unroll
    for (int j = 0; j < 4; ++j)
#pragma unroll
        for (int q = 0; q < 2; ++q) { v[j][q] = *(const f32x4*)(xrow + 512 * j + 8 * lane + 4 * q); s += (v[j][q].x * v[j][q].x + v[j][q].y * v[j][q].y) + (v[j][q].z * v[j][q].z + v[j][q].w * v[j][q].w); }
    const float rstd = 1.0f / sqrtf(wave_sum(s) * (1.f / D) + EPS);
    float amax = 0.f;
#pragma unroll
    for (int j = 0; j < 4; ++j)
#pragma unroll
        for (int q = 0; q < 2; ++q) { const f32x4 wv = *(const f32x4*)(w + 512 * j + 8 * lane + 4 * q); v[j][q] = v[j][q] * rstd * wv; amax = fmaxf(fmaxf(amax, fmaxf(fabsf(v[j][q].x), fabsf(v[j][q].y))), fmaxf(fabsf(v[j][q].z), fabsf(v[j][q].w))); }
#pragma unroll
    for (int o = 1; o < 64; o <<= 1) amax = fmaxf(amax, __shfl_xor(amax, o));
    amax = fmaxf(amax, 1e-30f); const float qs = 127.0f / amax;
    if (lane == 0) *sa = amax * (1.0f / 127.0f);
#pragma unroll
    for (int j = 0; j < 4; ++j) { u32x2 o;
#pragma unroll
        for (int q = 0; q < 2; ++q) { const f32x4 t = v[j][q] * qs; const unsigned pk = ((unsigned)__float2int_rn(t.x) & 0xffu) | (((unsigned)__float2int_rn(t.y) & 0xffu) << 8) | (((unsigned)__float2int_rn(t.z) & 0xffu) << 16) | (((unsigned)__float2int_rn(t.w) & 0xffu) << 24); if (q == 0) o.x = pk; else o.y = pk; }
        *(u32x2*)(orow + 512 * j + 8 * lane) = o; }
}
__device__ __forceinline__ void p0_prologue(Frame& F, const Args& a) {
    LAS float* scr = (LAS float*)(F.lds + F.wave * 16384);
    const int gw = F.vcu * NWAVES + F.wave, NGW = F.G * NWAVES;
    unsigned char* ws = F.ws;
    for (int m = gw; m < T; m += NGW) rms_row_to_i8(a.in[0] + (size_t)m * D, a.in[2], (signed char*)(ws + WS_XN) + (size_t)m * D, (float*)(ws + WS_SA1) + m, F.lane);
    { const float* p = a.in[1]; bf16_t* pb = (bf16_t*)(ws + WS_PBF);
      for (size_t i = ((size_t)gw * 64 + F.lane) * 8; i < (size_t)T * PLE; i += (size_t)NGW * 64 * 8) { const f32x4 v0 = *(const f32x4*)(p + i), v1 = *(const f32x4*)(p + i + 4); *(u32x4*)(pb + i) = pg8::pack8(v0, v1); } }
    { const float* wr = a.in[14]; float* wp = (float*)(ws + WS_WRP);
      for (int i = gw * 64 + F.lane; i < 128 * 64 * 8; i += NGW * 64) { const int j = i & 7, ln = (i >> 3) & 63, s = i >> 9, c = ln & 15, kq = ln >> 4; wp[i] = wr[(size_t)(16 * s + 4 * kq + (j & 3)) * NE + c + 16 * (j >> 2)]; } }
    { u32x4* z = (u32x4*)((signed char*)(ws + WS_WIN) + (size_t)12816 * D);
      for (int i = gw * 64 + F.lane; i < 240 * D / 16; i += NGW * 64) z[i] = (u32x4){0u, 0u, 0u, 0u};
      float* zs = (float*)(ws + WS_SWIN) + 12816; for (int i = gw * 64 + F.lane; i < 240; i += NGW * 64) zs[i] = 0.f; }
    constexpr int J_IN = (DIN + 31) / 32;
    constexpr int J_UP = 2 * DFF / 32;
    constexpr int I_SQ = (D / 64) * (D / 32);
    constexpr int I_PP = (PLE / 64) * (D / 32);
    constexpr int I_DN = (DFF / 64) * (D / 32);
    LAS float* wmax = (LAS float*)(F.lds + 8 * 16384);
    for (int job = F.vcu; job < J_IN + NE * J_UP; job += F.G) {
        if (job < J_IN) quant_panel_wg(a.in[3], DIN, (signed char*)(ws + WS_WIN), (float*)(ws + WS_SWIN), MapWin(), MapWin(), scr, wmax, job, F.wave, F.lane);
        else { const int r = job - J_IN, e = r / J_UP; quant_panel_wg(a.in[16] + (size_t)e * D * 2 * DFF, 2 * DFF, (signed char*)(ws + WS_WUP) + (size_t)e * 2 * DFF * D, (float*)(ws + WS_SWUP) + (size_t)e * 2 * DFF, MapUp(), MapId(), scr, wmax, r % J_UP, F.wave, F.lane); }
    }
    constexpr int NITEMS = 4 * I_SQ + I_PP + NE * I_DN;
    for (int it = gw; it < NITEMS; it += NGW) {
        int r = it;
        if (r < I_SQ) { transpose_item(a.in[10], D, D, (bf16_t*)(ws + WS_WA), MapId(), scr, r, F.lane); continue; } r -= I_SQ;
        if (r < I_SQ) { transpose_item(a.in[11], D, D, (bf16_t*)(ws + WS_WB), MapId(), scr, r, F.lane); continue; } r -= I_SQ;
        if (r < I_SQ) { transpose_item(a.in[12], D, D, (bf16_t*)(ws + WS_WOUT), MapId(), scr, r, F.lane); continue; } r -= I_SQ;
        if (r < I_SQ) { transpose_item(a.in[21], D, D, (bf16_t*)(ws + WS_WPG), MapId(), scr, r, F.lane); continue; } r -= I_SQ;
        if (r < I_PP) { transpose_item(a.in[22], PLE, D, (bf16_t*)(ws + WS_WPP), MapId(), scr, r, F.lane); continue; } r -= I_PP;
        { const int e = r / I_DN; transpose_item(a.in[18] + (size_t)e * DFF * D, DFF, D, (bf16_t*)(ws + WS_WDN) + (size_t)e * D * DFF, MapId(), scr, r % I_DN, F.lane); }
    }
}

namespace ml {
constexpr int NC = SEQ / 64;
constexpr int QS = 0, QS_SZ = 64 * 272, KS = 2 * QS_SZ, KT = KS + 64 * 272, VT = KT + 128 * 144, VT_SZ = 32 * 144, SS = VT + 2 * VT_SZ, CT = SS + 64 * 144, CT_SZ = 32 * 272,
              BB = CT + 2 * CT_SZ, AA = BB + 512, WW = AA + 512, GG = WW + 512, RS = GG + 32, QN = RS + 256, NV = QN + 256, ML_END = NV + 1024;
static_assert(ML_END <= RING_BYTES, "mLSTM LDS");
__device__ __forceinline__ f32x4 mfma16(bf16x8 a, bf16x8 b, f32x4 c) { return __builtin_amdgcn_mfma_f32_16x16x32_bf16(a, b, c, 0, 0, 0); }

__device__ __forceinline__ void mlstm_unit(LAS unsigned char* lds, const bf16_t* PROJ, bf16_t* HML, const float* igb, const float* fgb, int b, int h, int sl) {
    const int tid = threadIdx.x, lane = tid & 63, wid = __builtin_amdgcn_readfirstlane(tid >> 6), fr = lane & 15, fq = lane >> 4;
    const size_t row0 = (size_t)b * SEQ;
    const float scale = 0.08838834764831845f;
    const int qrow[2] = {tid >> 4, (tid + 512) >> 4}, qch = tid & 15;
    const int vrow = (tid & 255) >> 2, vch = tid & 3;
    u32x4 rq[2], rk[2], rv; float gi = 0.f, gf = 0.f;
    const float ib = igb[h], fb = fgb[h];
#define ML_LOAD(c) do { const bf16_t* base = PROJ + (row0 + (size_t)(c) * 64) * NPROJ; \
        _Pragma("unroll") for (int u = 0; u < 2; ++u) { rq[u] = *(const u32x4*)(base + (size_t)qrow[u] * NPROJ + C_MLQ + h * 128 + 8 * qch); rk[u] = *(const u32x4*)(base + (size_t)qrow[u] * NPROJ + C_MLK + h * 128 + 8 * qch); } \
        if (tid < 256) rv = *(const u32x4*)(base + (size_t)vrow * NPROJ + C_MLV + h * 256 + 32 * sl + 8 * vch); \
        if (wid == 7) { gi = bf1(base[(size_t)lane * NPROJ + C_GI + h]); gf = bf1(base[(size_t)lane * NPROJ + C_GF + h]); } } while (0)
#define ML_STORE(p) do { \
        _Pragma("unroll") for (int u = 0; u < 2; ++u) { *(LAS u32x4*)(lds + QS + (p) * QS_SZ + qrow[u] * 272 + qch * 16) = rq[u]; *(LAS u32x4*)(lds + KS + qrow[u] * 272 + qch * 16) = rk[u]; \
            const unsigned kw[4] = {rk[u].x, rk[u].y, rk[u].z, rk[u].w}; \
            _Pragma("unroll") for (int e = 0; e < 4; ++e) { *(LAS bf16_t*)(lds + KT + (8 * qch + 2 * e) * 144 + qrow[u] * 2) = (bf16_t)(kw[e] & 0xffffu); *(LAS bf16_t*)(lds + KT + (8 * qch + 2 * e + 1) * 144 + qrow[u] * 2) = (bf16_t)(kw[e] >> 16); } } \
        if (tid < 256) { const unsigned vw[4] = {rv.x, rv.y, rv.z, rv.w}; \
            _Pragma("unroll") for (int e = 0; e < 4; ++e) { *(LAS bf16_t*)(lds + VT + (p) * VT_SZ + (8 * vch + 2 * e) * 144 + vrow * 2) = (bf16_t)(vw[e] & 0xffffu); *(LAS bf16_t*)(lds + VT + (p) * VT_SZ + (8 * vch + 2 * e + 1) * 144 + vrow * 2) = (bf16_t)(vw[e] >> 16); } } \
        if (wid == 7) { const float li = 15.f * tanhf((gi + ib) * (1.f / 15.f)); const float fz = 15.f * tanhf((gf + fb) * (1.f / 15.f)); const float lf = fminf(fz, 0.f) - log1pf(__expf(-fabsf(fz))); \
            float bsum = lf; _Pragma("unroll") for (int o = 1; o < 64; o <<= 1) { const float tv = __shfl_up(bsum, o); if (lane >= o) bsum += tv; } \
            const float g = __shfl(bsum, 63); const float aj = li - bsum; \
            *(LAS float*)(lds + BB + (p) * 256 + lane * 4) = bsum; *(LAS float*)(lds + AA + (p) * 256 + lane * 4) = aj; *(LAS float*)(lds + WW + (p) * 256 + lane * 4) = __expf(g + aj); if (lane == 0) *(LAS float*)(lds + GG + (p) * 16) = g; } } while (0)
    f32x4 Creg[2][2];
#pragma unroll
    for (int a = 0; a < 2; ++a)
#pragma unroll
        for (int c = 0; c < 2; ++c) Creg[a][c] = (f32x4){0.f, 0.f, 0.f, 0.f};
    for (int i = tid; i < CT_SZ / 4; i += 512) *(LAS unsigned*)(lds + CT + i * 4) = 0u;
    if (tid < 128) *(LAS float*)(lds + NV + tid * 4) = 0.f;
    ML_LOAD(0);
    ML_STORE(0);
    __syncthreads();
    for (int c = 0; c < NC; ++c) {
        const int p = c & 1;
        if (c + 1 < NC) ML_LOAD(c + 1);
        if (wid < 4) {
            const int it = wid, i = 16 * it + fr; const float bi = *(const LAS float*)(lds + BB + p * 256 + i * 4); float rsum = 0.f;
            for (int jt = 0; jt <= it; ++jt) {
                f32x4 acc = (f32x4){0.f, 0.f, 0.f, 0.f};
#pragma unroll
                for (int ks = 0; ks < 4; ++ks) { const bf16x8 A = *(const LAS bf16x8*)(lds + KS + (16 * jt + fr) * 272 + (32 * ks + 8 * fq) * 2); const bf16x8 B = *(const LAS bf16x8*)(lds + QS + p * QS_SZ + (16 * it + fr) * 272 + (32 * ks + 8 * fq) * 2); acc = mfma16(A, B, acc); }
                const f32x4 aj = *(const LAS f32x4*)(lds + AA + p * 256 + (16 * jt + 4 * fq) * 4);
                float v[4];
#pragma unroll
                for (int r = 0; r < 4; ++r) { const int j = 16 * jt + 4 * fq + r; v[r] = (j <= i) ? acc[r] * scale * __expf(bi + aj[r]) : 0.f; rsum += v[r]; }
                u32x2 w; w.x = cvt_pk_bf16(v[0], v[1]); w.y = cvt_pk_bf16(v[2], v[3]);
                *(LAS u32x2*)(lds + SS + i * 144 + (16 * jt + 4 * fq) * 2) = w;
            }
            if ((it & 1) == 0) *(LAS u32x2*)(lds + SS + i * 144 + (16 * (it + 1) + 4 * fq) * 2) = (u32x2){0u, 0u};
            rsum += __shfl_xor(rsum, 16); rsum += __shfl_xor(rsum, 32);
            if (fq == 0) *(LAS float*)(lds + RS + i * 4) = rsum;
        } else {
            const int x = wid - 4; const float eg = __expf(*(const LAS float*)(lds + GG + p * 16));
            bf16x8 Af[2][2], Bf[2][2];
#pragma unroll
            for (int ks = 0; ks < 2; ++ks) {
                const f32x4 w0 = *(const LAS f32x4*)(lds + WW + p * 256 + (32 * ks + 8 * fq) * 4), w1 = *(const LAS f32x4*)(lds + WW + p * 256 + (32 * ks + 8 * fq + 4) * 4);
#pragma unroll
                for (int dl = 0; dl < 2; ++dl) { const u32x4 raw = *(const LAS u32x4*)(lds + KT + (16 * (2 * x + dl) + fr) * 144 + (32 * ks + 8 * fq) * 2);
                    u32x4 sc; sc.x = cvt_pk_bf16(bf_lo(raw.x) * w0[0], bf_hi(raw.x) * w0[1]); sc.y = cvt_pk_bf16(bf_lo(raw.y) * w0[2], bf_hi(raw.y) * w0[3]);
                    sc.z = cvt_pk_bf16(bf_lo(raw.z) * w1[0], bf_hi(raw.z) * w1[1]); sc.w = cvt_pk_bf16(bf_lo(raw.w) * w1[2], bf_hi(raw.w) * w1[3]);
                    Af[dl][ks] = __builtin_bit_cast(bf16x8, sc); }
#pragma unroll
                for (int dv = 0; dv < 2; ++dv) Bf[dv][ks] = *(const LAS bf16x8*)(lds + VT + p * VT_SZ + (16 * dv + fr) * 144 + (32 * ks + 8 * fq) * 2);
            }
#pragma unroll
            for (int dl = 0; dl < 2; ++dl)
#pragma unroll
                for (int dv = 0; dv < 2; ++dv) { f32x4 cacc = Creg[dl][dv] * eg; cacc = mfma16(Af[dl][0], Bf[dv][0], cacc); cacc = mfma16(Af[dl][1], Bf[dv][1], cacc); Creg[dl][dv] = cacc;
                    u32x2 w; w.x = cvt_pk_bf16(cacc[0], cacc[1]); w.y = cvt_pk_bf16(cacc[2], cacc[3]);
                    *(LAS u32x2*)(lds + CT + (p ^ 1) * CT_SZ + (16 * dv + fr) * 272 + (16 * (2 * x + dl) + 4 * fq) * 2) = w; }
            const int tt = tid - 256;
            { const int i = tt >> 2, q4 = tt & 3; float s = 0.f;
#pragma unroll
              for (int e = 0; e < 4; ++e) { const u32x4 qw = *(const LAS u32x4*)(lds + QS + p * QS_SZ + i * 272 + (32 * q4 + 8 * e) * 2); const f32x4 n0 = *(const LAS f32x4*)(lds + NV + p * 512 + (32 * q4 + 8 * e) * 4), n1 = *(const LAS f32x4*)(lds + NV + p * 512 + (32 * q4 + 8 * e + 4) * 4);
                  s += bf_lo(qw.x) * n0[0] + bf_hi(qw.x) * n0[1] + bf_lo(qw.y) * n0[2] + bf_hi(qw.y) * n0[3] + bf_lo(qw.z) * n1[0] + bf_hi(qw.z) * n1[1] + bf_lo(qw.w) * n1[2] + bf_hi(qw.w) * n1[3]; }
              s += __shfl_xor(s, 1); s += __shfl_xor(s, 2);
              if (q4 == 0) *(LAS float*)(lds + QN + i * 4) = s; }
            { const int d = tt >> 1, hh = tt & 1; float s = 0.f;
#pragma unroll
              for (int e = 0; e < 4; ++e) { const u32x4 kw = *(const LAS u32x4*)(lds + KT + d * 144 + (32 * hh + 8 * e) * 2); const f32x4 w0 = *(const LAS f32x4*)(lds + WW + p * 256 + (32 * hh + 8 * e) * 4), w1 = *(const LAS f32x4*)(lds + WW + p * 256 + (32 * hh + 8 * e + 4) * 4);
                  s += bf_lo(kw.x) * w0[0] + bf_hi(kw.x) * w0[1] + bf_lo(kw.y) * w0[2] + bf_hi(kw.y) * w0[3] + bf_lo(kw.z) * w1[0] + bf_hi(kw.z) * w1[1] + bf_lo(kw.w) * w1[2] + bf_hi(kw.w) * w1[3]; }
              s += __shfl_xor(s, 1);
              if (hh == 0) *(LAS float*)(lds + NV + (p ^ 1) * 512 + d * 4) = eg * *(const LAS float*)(lds + NV + p * 512 + d * 4) + s; }
        }
        __syncthreads();
        {
            const int it = wid >> 1, dv = wid & 1;
            f32x4 h1 = (f32x4){0.f, 0.f, 0.f, 0.f}, h2 = (f32x4){0.f, 0.f, 0.f, 0.f};
            for (int ks = 0; ks <= (it >> 1); ++ks) { const bf16x8 A = *(const LAS bf16x8*)(lds + SS + (16 * it + fr) * 144 + (32 * ks + 8 * fq) * 2); const bf16x8 B = *(const LAS bf16x8*)(lds + VT + p * VT_SZ + (16 * dv + fr) * 144 + (32 * ks + 8 * fq) * 2); h1 = mfma16(A, B, h1); }
#pragma unroll
            for (int ks = 0; ks < 4; ++ks) { const bf16x8 A = *(const LAS bf16x8*)(lds + QS + p * QS_SZ + (16 * it + fr) * 272 + (32 * ks + 8 * fq) * 2); const bf16x8 B = *(const LAS bf16x8*)(lds + CT + p * CT_SZ + (16 * dv + fr) * 272 + (32 * ks + 8 * fq) * 2); h2 = mfma16(A, B, h2); }
            const f32x4 bi = *(const LAS f32x4*)(lds + BB + p * 256 + (16 * it + 4 * fq) * 4), rs = *(const LAS f32x4*)(lds + RS + (16 * it + 4 * fq) * 4), qn = *(const LAS f32x4*)(lds + QN + (16 * it + 4 * fq) * 4);
            bf16_t* orow = HML + (row0 + (size_t)c * 64 + 16 * it + 4 * fq) * D + h * 256 + 32 * sl + 16 * dv + fr;
#pragma unroll
            for (int r = 0; r < 4; ++r) { const float eb = __expf(bi[r]) * scale; const float num = h1[r] + eb * h2[r], den = rs[r] + eb * qn[r]; const float hv = num / fmaxf(fabsf(den), 1.0f);
                orow[(size_t)r * D] = (bf16_t)(cvt_pk_bf16(hv, 0.f) & 0xffffu); }
        }
        if (c + 1 < NC) ML_STORE(p ^ 1);
        __syncthreads();
    }
#undef ML_LOAD
#undef ML_STORE
}
}

namespace swa {
constexpr int KSO = 0, VSO = 256 * 144, WSF = 2 * 256 * 144, SWA_END = WSF + 8 * 256;
static_assert(SWA_END <= RING_BYTES, "SWA LDS");
__device__ __forceinline__ int crow(int r, int hi) { return (r & 3) + 8 * (r >> 2) + 4 * hi; }
typedef short v4i16_t __attribute__((ext_vector_type(4)));
__device__ __forceinline__ s16x4 vtr(const LAS unsigned char* p) { return __builtin_bit_cast(s16x4, __builtin_amdgcn_ds_read_tr16_b64_v4i16((LAS v4i16_t*)p)); }

__device__ __forceinline__ void swa_unit(LAS unsigned char* lds, const bf16_t* PROJ, bf16_t* ASW, const float* wq, const float* wk, const float* sinks, int b, int nb, int kvh) {
    const int tid = threadIdx.x, lane = tid & 63, wid = __builtin_amdgcn_readfirstlane(tid >> 6), r32 = lane & 31, hi = lane >> 5;
    const size_t rowbase = (size_t)b * SEQ + (size_t)nb * 128;
#pragma unroll
    for (int u = 0; u < 4; ++u) {
        const int id = tid + 512 * u, row = id >> 3, ch = id & 7; const bool valid = (nb > 0) || (row >= 128);
        u32x4 kw = (u32x4){0u, 0u, 0u, 0u}, vw = (u32x4){0u, 0u, 0u, 0u};
        if (valid) { const bf16_t* rp = PROJ + (rowbase - 128 + row) * NPROJ; kw = *(const u32x4*)(rp + C_SWK + kvh * 64 + 8 * ch); vw = *(const u32x4*)(rp + C_SWV + kvh * 64 + 8 * ch); }
        f32x4 k0, k1; pg8::unpack8(kw, k0, k1);
        float ss = (k0[0] * k0[0] + k0[1] * k0[1]) + (k0[2] * k0[2] + k0[3] * k0[3]) + (k1[0] * k1[0] + k1[1] * k1[1]) + (k1[2] * k1[2] + k1[3] * k1[3]);
        ss += __shfl_xor(ss, 1); ss += __shfl_xor(ss, 2); ss += __shfl_xor(ss, 4);
        const float r = 1.0f / sqrtf(ss * (1.f / 64.f) + EPS);
        const f32x4 w0 = *(const f32x4*)(wk + 8 * ch), w1 = *(const f32x4*)(wk + 8 * ch + 4);
        *(LAS u32x4*)(lds + KSO + row * 144 + ch * 16) = pg8::pack8(k0 * r * w0, k1 * r * w1);
        *(LAS u32x4*)(lds + VSO + row * 144 + ch * 16) = vw;
    }
    __syncthreads();
    const int hd = kvh * 8 + wid;
    const float slope = exp2f(-(float)(hd + 1) * 0.25f) * LOG2E, sinkl = sinks[hd] * LOG2E;
    LAS float* wsf = (LAS float*)(lds + WSF + wid * 256);
    for (int qt = 0; qt < 4; ++qt) {
        bf16x8 qf[4];
        { const bf16_t* qp = PROJ + (rowbase + 32 * qt + r32) * NPROJ + C_SWQ + hd * 64 + 8 * hi; f32x4 q0[4], q1[4]; float ss = 0.f;
#pragma unroll
          for (int ds = 0; ds < 4; ++ds) { const u32x4 w = *(const u32x4*)(qp + 16 * ds); pg8::unpack8(w, q0[ds], q1[ds]);
              ss += (q0[ds][0] * q0[ds][0] + q0[ds][1] * q0[ds][1]) + (q0[ds][2] * q0[ds][2] + q0[ds][3] * q0[ds][3]) + (q1[ds][0] * q1[ds][0] + q1[ds][1] * q1[ds][1]) + (q1[ds][2] * q1[ds][2] + q1[ds][3] * q1[ds][3]); }
          ss += __shfl_xor(ss, 32);
          const float r = (1.0f / sqrtf(ss * (1.f / 64.f) + EPS)) * 0.125f * LOG2E;
#pragma unroll
          for (int ds = 0; ds < 4; ++ds) { const f32x4 w0 = *(const f32x4*)(wq + 16 * ds + 8 * hi), w1 = *(const f32x4*)(wq + 16 * ds + 8 * hi + 4); qf[ds] = __builtin_bit_cast(bf16x8, pg8::pack8(q0[ds] * r * w0, q1[ds] * r * w1)); } }
        f32x16 s[5];
#pragma unroll
        for (int kk = 0; kk < 5; ++kk) { const int kt = qt + kk; f32x16 a = {};
#pragma unroll
            for (int ds = 0; ds < 4; ++ds) { const bf16x8 A = *(const LAS bf16x8*)(lds + KSO + (32 * kt + r32) * 144 + (16 * ds + 8 * hi) * 2); a = __builtin_amdgcn_mfma_f32_32x32x16_bf16(A, qf[ds], a, 0, 0, 0); }
            s[kk] = a; __builtin_amdgcn_sched_barrier(0); }
        int dbase = 128 + r32 - 4 * hi; asm volatile("" : "+v"(dbase));
        const float fbase = (float)dbase; const int jlim = ((nb > 0) ? 0 : 128) - 32 * qt - 4 * hi;
        float m = sinkl;
#pragma unroll
        for (int kk = 0; kk < 5; ++kk)
#pragma unroll
            for (int r = 0; r < 16; ++r) { const int ckr = 32 * kk + (r & 3) + 8 * (r >> 2); const int dist = dbase - ckr; const bool valid = ((unsigned)dist < 128u) && (ckr >= jlim);
                const float v = valid ? s[kk][r] - slope * (fbase - (float)ckr) : -INFINITY; s[kk][r] = v; m = fmaxf(m, v); }
        m = fmaxf(m, __shfl_xor(m, 32));
        float l = 0.f;
#pragma unroll
        for (int kk = 0; kk < 5; ++kk)
#pragma unroll
            for (int r = 0; r < 16; ++r) { const float p = exp2f(s[kk][r] - m); s[kk][r] = p; l += p; }
        l += __shfl_xor(l, 32);
        l += exp2f(sinkl - m);
        if (hi == 0) wsf[r32] = 1.0f / l;
        f32x16 o[2]; o[0] = (f32x16){}; o[1] = (f32x16){};
#pragma unroll
        for (int kk = 0; kk < 5; ++kk) { const int kt = qt + kk;
#pragma unroll
            for (int s2 = 0; s2 < 2; ++s2) {
                u32x4 pw; pw.x = cvt_pk_bf16(s[kk][8 * s2 + 0], s[kk][8 * s2 + 1]); pw.y = cvt_pk_bf16(s[kk][8 * s2 + 2], s[kk][8 * s2 + 3]); pw.z = cvt_pk_bf16(s[kk][8 * s2 + 4], s[kk][8 * s2 + 5]); pw.w = cvt_pk_bf16(s[kk][8 * s2 + 6], s[kk][8 * s2 + 7]);
                const bf16x8 pa = __builtin_bit_cast(bf16x8, pw);
                const int key = 32 * kt + 16 * s2 + 4 * hi + ((lane & 15) >> 2);
#pragma unroll
                for (int d0 = 0; d0 < 2; ++d0) { const LAS unsigned char* vp = lds + VSO + key * 144 + (32 * d0 + 16 * ((lane >> 4) & 1) + 4 * (lane & 3)) * 2;
                    const s16x4 lo = vtr(vp), hh = vtr(vp + 8 * 144);
                    const bf16x8 B = (bf16x8){lo[0], lo[1], lo[2], lo[3], hh[0], hh[1], hh[2], hh[3]};
                    o[d0] = __builtin_amdgcn_mfma_f32_32x32x16_bf16(pa, B, o[d0], 0, 0, 0); }
                __builtin_amdgcn_sched_barrier(0); } }
        LDS_WAIT();
#pragma unroll
        for (int r = 0; r < 16; ++r) { const float rl = wsf[crow(r, hi)]; bf16_t* op = ASW + (rowbase + 32 * qt + crow(r, hi)) * D + hd * 64 + r32;
            op[0] = (bf16_t)(cvt_pk_bf16(o[0][r] * rl, 0.f) & 0xffffu); op[32] = (bf16_t)(cvt_pk_bf16(o[1][r] * rl, 0.f) & 0xffffu); }
    }
    __syncthreads();
}
}

namespace moe {
using pg8::Unit; using pg8::BM; using pg8::HALF;
struct Tables { const LAS int* tstart; const LAS int* cnt; const LAS int* tile_e; };
__device__ __forceinline__ int build_tables(LAS unsigned char* tab, const unsigned* cur) {
    LAS int* tstart = (LAS int*)tab; LAS int* cnt = (LAS int*)(tab + 256); LAS int* tile_e = (LAS int*)(tab + 512);
    const int tid = threadIdx.x;
    if (tid < NE) cnt[tid] = (int)__hip_atomic_load(cur + 64 * tid, RLX_AGENT);
    __syncthreads();
    if (tid == 0) { int s = 0; for (int e = 0; e < NE; ++e) { tstart[e] = s; s += (cnt[e] + 255) >> 8; } tstart[NE] = s; }
    __syncthreads();
    const int nrt = tstart[NE];
    for (int t = tid; t < nrt; t += 512) { int e = 0; for (int k = 1; k < NE; ++k) if (tstart[k] <= t) e = k; tile_e[t] = e; }
    __syncthreads();
    return nrt;
}
struct UpSched {
    static constexpr bool GATHER = true;
    const void* A; const void* Bt; const int* tokl; Tables tb; int nrt, nN, G, c;
    __device__ __forceinline__ bool next(int i, Unit& u) const { const long L = (long)i * G + c; if (L >= (long)nrt * nN) return false; pg8::map_unit((int)L, nrt, nN, u.pm, u.pn); u.e = tb.tile_e[u.pm]; u.r0 = (u.pm - tb.tstart[u.e]) * BM; u.cnt = tb.cnt[u.e]; return true; }
    __device__ __forceinline__ const char* a_base() const { return (const char*)A; }
    __device__ __forceinline__ void a_offs(const Unit& u, const int (&R)[2], const int (&C)[2], int K, unsigned (&vo)[2][2]) const {
#pragma unroll
        for (int h = 0; h < 2; ++h)
#pragma unroll
            for (int i = 0; i < 2; ++i) { const int rl = u.r0 + h * HALF + R[i]; const int tok = rl < u.cnt ? tokl[(size_t)u.e * CAP + rl] : 0; vo[h][i] = (unsigned)tok * (unsigned)K + (unsigned)C[i] * 2u; }
    }
    __device__ __forceinline__ const char* a_tile(const Unit&, int) const { return (const char*)A; }
    __device__ __forceinline__ const char* b_tile(const Unit& u, int K) const { return (const char*)Bt + ((size_t)u.e * 2 * DFF + (size_t)u.pn * BM) * K; }
};
struct DownSched {
    static constexpr bool GATHER = false;
    const bf16_t* A; const bf16_t* Bt; Tables tb; int nrt, nN, G, c;
    __device__ __forceinline__ bool next(int i, Unit& u) const { const long L = (long)i * G + c; if (L >= (long)nrt * nN) return false; pg8::map_unit((int)L, nrt, nN, u.pm, u.pn); u.e = tb.tile_e[u.pm]; u.r0 = (u.pm - tb.tstart[u.e]) * BM; u.cnt = tb.cnt[u.e]; return true; }
    __device__ __forceinline__ const char* a_base() const { return (const char*)A; }
    __device__ __forceinline__ void a_offs(const Unit& u, const int (&R)[2], const int (&C)[2], int K, unsigned (&vo)[2][2]) const {
#pragma unroll
        for (int h = 0; h < 2; ++h)
#pragma unroll
            for (int i = 0; i < 2; ++i) vo[h][i] = (unsigned)(u.pm * BM + h * HALF + R[i]) * (unsigned)K + (unsigned)C[i] * 2u;
    }
    __device__ __forceinline__ const char* a_tile(const Unit& u, int K) const { return (const char*)A + (size_t)u.pm * BM * K; }
    __device__ __forceinline__ const char* b_tile(const Unit& u, int K) const { return (const char*)Bt + ((size_t)u.e * D + (size_t)u.pn * BM) * K; }
};
struct EpiUp {
    static constexpr bool PERM = true, I8 = true;
    bf16_t* ACT; const float* bup; const float* rsl; const float* swup;
    __device__ __forceinline__ void operator()(const i32x4 (&acc)[2][2][4][2], const Unit& u, int wr, int wc, int fr, int fq) const {
        const int oc = u.pn * HALF + wc * 32 + 8 * fq;
        const float* bg = bup + (size_t)u.e * 2 * DFF + oc; const float* bl = bg + DFF;
        const float* sg = swup + (size_t)u.e * 2 * DFF + oc; const float* sl = sg + DFF;
        const f32x4 bg0 = *(const f32x4*)bg, bg1 = *(const f32x4*)(bg + 4), bl0 = *(const f32x4*)bl, bl1 = *(const f32x4*)(bl + 4);
        const f32x4 sg0 = *(const f32x4*)sg, sg1 = *(const f32x4*)(sg + 4), sl0 = *(const f32x4*)sl, sl1 = *(const f32x4*)(sl + 4);
#pragma unroll
        for (int ai = 0; ai < 2; ++ai)
#pragma unroll
            for (int m = 0; m < 4; ++m) { const int rt = ai * HALF + wr * 64 + m * 16 + fr; const int rl = u.r0 + rt; const float rs = rl < u.cnt ? rsl[(size_t)u.e * CAP + rl] : 0.f;
                f32x4 o[2];
#pragma unroll
                for (int n = 0; n < 2; ++n) { const f32x4 ag = __builtin_convertvector(acc[ai][0][m][n], f32x4), al = __builtin_convertvector(acc[ai][1][m][n], f32x4);
                    const f32x4 g = ag * rs * (n ? sg1 : sg0) + (n ? bg1 : bg0), l = al * rs * (n ? sl1 : sl0) + (n ? bl1 : bl0);
#pragma unroll
                    for (int j = 0; j < 4; ++j) { const float gg = fminf(g[j], 7.0f), ll = fminf(fmaxf(l[j], -7.0f), 7.0f); o[n][j] = gg * sigmoidf_(1.702f * gg) * (ll + 1.0f); } }
                *(u32x4*)(ACT + (size_t)(u.pm * BM + rt) * DFF + oc) = pg8::pack8(o[0], o[1]); }
    }
};
struct EpiDown {
    static constexpr bool PERM = true, I8 = false;
    bf16_t* YS; const float* bdn; const float* gatel; const int* destl;
    __device__ __forceinline__ void operator()(const f32x4 (&acc)[2][2][4][2], const Unit& u, int wr, int wc, int fr, int fq) const {
        const int col0 = u.pn * BM + wc * 32 + 8 * fq;
        f32x4 bv[2][2];
#pragma unroll
        for (int bj = 0; bj < 2; ++bj)
#pragma unroll
            for (int n = 0; n < 2; ++n) bv[bj][n] = *(const f32x4*)(bdn + (size_t)u.e * D + col0 + bj * HALF + 4 * n);
#pragma unroll
        for (int ai = 0; ai < 2; ++ai)
#pragma unroll
            for (int m = 0; m < 4; ++m) { const int rl = u.r0 + ai * HALF + wr * 64 + m * 16 + fr;
                if (rl < u.cnt) { const float g = gatel[(size_t)u.e * CAP + rl]; const int dest = destl[(size_t)u.e * CAP + rl];
#pragma unroll
                    for (int bj = 0; bj < 2; ++bj) *(u32x4*)(YS + (size_t)dest * D + col0 + bj * HALF) = pg8::pack8((acc[ai][bj][m][0] + bv[bj][0]) * g, (acc[ai][bj][m][1] + bv[bj][1]) * g); } }
    }
};
}

__device__ __forceinline__ void ml_norm_rows(Frame& F, const Args& a) {
    const int gw = F.vcu * NWAVES + F.wave, NGW = F.G * NWAVES, lane = F.lane;
    bf16_t* HML = (bf16_t*)(F.ws + WS_HML); const bf16_t* PROJ = (const bf16_t*)(F.ws + WS_PROJ); const float* nw = a.in[6];
    for (int m = gw; m < T; m += NGW) {
        bf16_t* hr = HML + (size_t)m * D; const bf16_t* orow = PROJ + (size_t)m * NPROJ + C_MLO;
#pragma unroll
        for (int j = 0; j < 4; ++j) { const int c0 = 512 * j + 8 * lane;
            const u32x4 hw = *(const u32x4*)(hr + c0), ow = *(const u32x4*)(orow + c0); f32x4 h0, h1, o0, o1; pg8::unpack8(hw, h0, h1); pg8::unpack8(ow, o0, o1);
            float ss = (h0[0] * h0[0] + h0[1] * h0[1]) + (h0[2] * h0[2] + h0[3] * h0[3]) + (h1[0] * h1[0] + h1[1] * h1[1]) + (h1[2] * h1[2] + h1[3] * h1[3]);
#pragma unroll
            for (int o = 1; o < 32; o <<= 1) ss += __shfl_xor(ss, o);
            const float r = 1.0f / sqrtf(ss * (1.f / 256.f) + EPS);
            const f32x4 w0 = *(const f32x4*)(nw + c0), w1 = *(const f32x4*)(nw + c0 + 4);
            *(u32x4*)(hr + c0) = pg8::pack8(h0 * r * w0 * pg8::sig4(o0), h1 * r * w1 * pg8::sig4(o1)); }
    }
}

__device__ __forceinline__ void route_phase(Frame& F, const Args& a) {
    LAS unsigned char* lds = F.lds;
    LAS float* w2s = (LAS float*)(lds);
    LAS float* lg = (LAS float*)(lds + 8192);
    LAS float* rsd = (LAS float*)(lds + 8192 + 8 * 16 * 33 * 4);
    LAS float* rsd2 = rsd + 128;
    LAS int* sel_e = (LAS int*)(lds + 32768);
    LAS float* sel_g = (LAS float*)(lds + 32768 + 2048);
    LAS int* hist = (LAS int*)(lds + 32768 + 4096);
    LAS int* basep = (LAS int*)(lds + 32768 + 4096 + 128);
    const int tid = F.tid, lane = F.lane, wid = F.wave, c16 = lane & 15, kq = lane >> 4;
    const float* h1 = a.out; const float* w2 = a.in[13]; const float* br = a.in[15]; const float* wrp = (const float*)(F.ws + WS_WRP);
    signed char* XQ = (signed char*)(F.ws + WS_XN);
    int* tokl = (int*)(F.ws + WS_TOKL); float* gatel = (float*)(F.ws + WS_GATEL); int* destl = (int*)(F.ws + WS_DESTL); float* rsl = (float*)(F.ws + WS_RSL);
    unsigned* cur = F.ctl + CW_CUR;
    for (int i = tid; i < D; i += 512) w2s[i] = w2[i];
    __syncthreads();
    for (int tb = blockIdx.x; tb < T / 128; tb += F.G) {
        if (tid < NE) hist[tid] = 0;
        const int row0 = tb * 128 + wid * 16;
        const float* xr = h1 + (size_t)(row0 + c16) * D + 4 * kq; signed char* xo = XQ + (size_t)(row0 + c16) * D + 4 * kq;
        f32x4 acc0 = (f32x4){0.f, 0.f, 0.f, 0.f}, acc1 = (f32x4){0.f, 0.f, 0.f, 0.f}; float ss = 0.f, amax = 0.f;
#pragma unroll 4
        for (int s = 0; s < 128; ++s) {
            const f32x4 xv = *(const f32x4*)(xr + 16 * s); const f32x4 wv = *(const LAS f32x4*)(w2s + 16 * s + 4 * kq);
            const f32x4 b0 = *(const f32x4*)(wrp + ((size_t)s * 64 + lane) * 8), b1 = *(const f32x4*)(wrp + ((size_t)s * 64 + lane) * 8 + 4);
            ss += (xv[0] * xv[0] + xv[1] * xv[1]) + (xv[2] * xv[2] + xv[3] * xv[3]);
            const f32x4 xw = xv * wv;
            amax = fmaxf(fmaxf(amax, fmaxf(fabsf(xw[0]), fabsf(xw[1]))), fmaxf(fabsf(xw[2]), fabsf(xw[3])));
#pragma unroll
            for (int j = 0; j < 4; ++j) { acc0 = __builtin_amdgcn_mfma_f32_16x16x4f32(xw[j], b0[j], acc0, 0, 0, 0); acc1 = __builtin_amdgcn_mfma_f32_16x16x4f32(xw[j], b1[j], acc1, 0, 0, 0); }
        }
        ss += __shfl_xor(ss, 16); ss += __shfl_xor(ss, 32);
        amax = fmaxf(amax, __shfl_xor(amax, 16)); amax = fmaxf(amax, __shfl_xor(amax, 32)); amax = fmaxf(amax, 1e-30f);
        const float rstd = 1.0f / sqrtf(ss * (1.f / D) + EPS);
        if (kq == 0) { rsd[wid * 16 + c16] = rstd * amax * (1.0f / 127.0f); rsd2[wid * 16 + c16] = rstd; }
        { const float qs = 127.0f / amax;
#pragma unroll 4
          for (int s = 0; s < 128; ++s) { const f32x4 xv = *(const f32x4*)(xr + 16 * s); const f32x4 wv = *(const LAS f32x4*)(w2s + 16 * s + 4 * kq); const f32x4 xw = xv * wv * qs;
              const unsigned pk = ((unsigned)__float2int_rn(xw[0]) & 0xffu) | (((unsigned)__float2int_rn(xw[1]) & 0xffu) << 8) | (((unsigned)__float2int_rn(xw[2]) & 0xffu) << 16) | (((unsigned)__float2int_rn(xw[3]) & 0xffu) << 24);
              *(unsigned*)(xo + 16 * s) = pk; } }
        LDS_WAIT();
        { const float bb0 = br[c16], bb1 = br[c16 + 16];
#pragma unroll
          for (int r = 0; r < 4; ++r) { const float rr = rsd2[wid * 16 + 4 * kq + r]; lg[(wid * 16 + 4 * kq + r) * 33 + c16] = acc0[r] * rr + bb0; lg[(wid * 16 + 4 * kq + r) * 33 + c16 + 16] = acc1[r] * rr + bb1; } }
        LDS_WAIT();
        if (lane < 16) {
            const LAS float* lr = lg + (wid * 16 + lane) * 33; unsigned taken = 0u; float tv[4]; int te[4];
#pragma unroll
            for (int k = 0; k < 4; ++k) { float best = -INFINITY; int bi = 0;
                for (int e = 0; e < NE; ++e) { const float v = lr[e]; const bool ok = !((taken >> e) & 1u) && (v > best); best = ok ? v : best; bi = ok ? e : bi; }
                taken |= 1u << bi; tv[k] = best; te[k] = bi; }
            float ex[4], sum = 0.f;
#pragma unroll
            for (int k = 0; k < 4; ++k) { ex[k] = __expf(tv[k] - tv[0]); sum += ex[k]; }
            const float inv = 1.0f / sum;
#pragma unroll
            for (int k = 0; k < 4; ++k) { sel_e[(wid * 16 + lane) * 4 + k] = te[k]; sel_g[(wid * 16 + lane) * 4 + k] = ex[k] * inv; }
        }
        __syncthreads();
        const int prow = wid * 16 + (lane >> 2), pk = lane & 3;
        const int pe = sel_e[prow * 4 + pk]; const float pg = sel_g[prow * 4 + pk];
        const int lr_ = __hip_atomic_fetch_add(hist + pe, 1, __ATOMIC_RELAXED, __HIP_MEMORY_SCOPE_WORKGROUP);
        __syncthreads();
        if (tid < NE) basep[tid] = (int)__hip_atomic_fetch_add(cur + 64 * tid, (unsigned)hist[tid], RLX_AGENT);
        __syncthreads();
        { const int pos = basep[pe] + lr_; const int token = tb * 128 + prow; const size_t li = (size_t)pe * CAP + pos;
          tokl[li] = token; gatel[li] = pg; destl[li] = token * 4 + pk; rsl[li] = rsd[prow]; }
        __syncthreads();
    }
}

__device__ __forceinline__ void combine_rows(Frame& F, const Args& a) {
    const int gw = F.vcu * NWAVES + F.wave, NGW = F.G * NWAVES, lane = F.lane;
    float* out = a.out; const bf16_t* YS = (const bf16_t*)(F.ws + WS_YS); bf16_t* XN = (bf16_t*)(F.ws + WS_XN); const float* w3 = a.in[20];
    for (int m = gw; m < T; m += NGW) {
        float* hr = out + (size_t)m * D; f32x4 v[4][2]; float s = 0.f;
#pragma unroll
        for (int j = 0; j < 4; ++j) { const int c0 = 512 * j + 8 * lane; v[j][0] = *(const f32x4*)(hr + c0); v[j][1] = *(const f32x4*)(hr + c0 + 4);
#pragma unroll
            for (int k = 0; k < 4; ++k) { const u32x4 yw = *(const u32x4*)(YS + ((size_t)m * 4 + k) * D + c0); f32x4 y0, y1; pg8::unpack8(yw, y0, y1); v[j][0] += y0; v[j][1] += y1; }
            *(f32x4*)(hr + c0) = v[j][0]; *(f32x4*)(hr + c0 + 4) = v[j][1];
#pragma unroll
            for (int q = 0; q < 2; ++q) s += (v[j][q].x * v[j][q].x + v[j][q].y * v[j][q].y) + (v[j][q].z * v[j][q].z + v[j][q].w * v[j][q].w); }
        const float rstd = 1.0f / sqrtf(wave_sum(s) * (1.f / D) + EPS);
#pragma unroll
        for (int j = 0; j < 4; ++j) { const int c0 = 512 * j + 8 * lane; const f32x4 w0 = *(const f32x4*)(w3 + c0), w1 = *(const f32x4*)(w3 + c0 + 4);
            *(u32x4*)(XN + (size_t)m * D + c0) = pg8::pack8(v[j][0] * rstd * w0, v[j][1] * rstd * w1); }
    }
}

__device__ __forceinline__ void ph_gemm1(Frame& F, const Args& a) {
    pg8::DenseSched S{(const bf16_t*)(F.ws + WS_XN), (const bf16_t*)(F.ws + WS_WIN), T / 256, NPROJ / 256, F.G, (int)blockIdx.x}; pg8::EpiProjI8 E{(bf16_t*)(F.ws + WS_PROJ), NPROJ, (const float*)(F.ws + WS_SA1), (const float*)(F.ws + WS_SWIN)}; pg8::gemm_phase(F.lds, D, S, E); }
__device__ __forceinline__ void ph_mlstm(Frame& F, const Args& a) {
    for (int u = F.vcu; u < 256; u += F.G) ml::mlstm_unit(F.lds, (const bf16_t*)(F.ws + WS_PROJ), (bf16_t*)(F.ws + WS_HML), a.in[4], a.in[5], u >> 6, (u >> 3) & 7, u & 7); }
__device__ __forceinline__ void ph_norm_swa(Frame& F, const Args& a) {
    ml_norm_rows(F, a);
    for (int u = F.vcu; u < 1024; u += F.G) swa::swa_unit(F.lds, (const bf16_t*)(F.ws + WS_PROJ), (bf16_t*)(F.ws + WS_ASW), a.in[7], a.in[8], a.in[9], u >> 8, (u >> 2) & 63, u & 3); }
__device__ __forceinline__ void ph_ya(Frame& F, const Args& a) {
    pg8::DenseSched S{(const bf16_t*)(F.ws + WS_HML), (const bf16_t*)(F.ws + WS_WA), T / 256, D / 256, F.G, (int)blockIdx.x}; pg8::EpiGate<false> E{(bf16_t*)(F.ws + WS_YA), (const bf16_t*)(F.ws + WS_PROJ) + C_GA, NPROJ, nullptr}; pg8::gemm_phase(F.lds, D * 2, S, E); }
__device__ __forceinline__ void ph_mix(Frame& F, const Args& a) {
    pg8::DenseSched S{(const bf16_t*)(F.ws + WS_ASW), (const bf16_t*)(F.ws + WS_WB), T / 256, D / 256, F.G, (int)blockIdx.x}; pg8::EpiGate<true> E{(bf16_t*)(F.ws + WS_MIX), (const bf16_t*)(F.ws + WS_PROJ) + C_GB, NPROJ, (const bf16_t*)(F.ws + WS_YA)}; pg8::gemm_phase(F.lds, D * 2, S, E); }
__device__ __forceinline__ void ph_h1(Frame& F, const Args& a) {
    pg8::DenseSched S{(const bf16_t*)(F.ws + WS_MIX), (const bf16_t*)(F.ws + WS_WOUT), T / 256, D / 256, F.G, (int)blockIdx.x}; pg8::EpiResF32 E{a.in[0], a.out}; pg8::gemm_phase(F.lds, D * 2, S, E); }
__device__ __forceinline__ void ph_up(Frame& F, const Args& a) {
    const int nrt = moe::build_tables(F.lds + TAB_OFF, F.ctl + CW_CUR);
    moe::Tables tb{(const LAS int*)(F.lds + TAB_OFF), (const LAS int*)(F.lds + TAB_OFF + 256), (const LAS int*)(F.lds + TAB_OFF + 512)};
    moe::UpSched S{(const void*)(F.ws + WS_XN), (const void*)(F.ws + WS_WUP), (const int*)(F.ws + WS_TOKL), tb, nrt, 2 * DFF / 256, F.G, (int)blockIdx.x}; moe::EpiUp E{(bf16_t*)(F.ws + WS_ACT), a.in[17], (const float*)(F.ws + WS_RSL), (const float*)(F.ws + WS_SWUP)}; pg8::gemm_phase(F.lds, D, S, E); }
__device__ __forceinline__ void ph_down(Frame& F, const Args& a) {
    const int nrt = moe::build_tables(F.lds + TAB_OFF, F.ctl + CW_CUR);
    moe::Tables tb{(const LAS int*)(F.lds + TAB_OFF), (const LAS int*)(F.lds + TAB_OFF + 256), (const LAS int*)(F.lds + TAB_OFF + 512)};
    moe::DownSched S{(const bf16_t*)(F.ws + WS_ACT), (const bf16_t*)(F.ws + WS_WDN), tb, nrt, D / 256, F.G, (int)blockIdx.x}; moe::EpiDown E{(bf16_t*)(F.ws + WS_YS), a.in[19], (const float*)(F.ws + WS_GATEL), (const int*)(F.ws + WS_DESTL)}; pg8::gemm_phase(F.lds, DFF * 2, S, E); }
__device__ __forceinline__ void ph_combine_pp(Frame& F, const Args& a) {
    combine_rows(F, a);
    pg8::DenseSched S{(const bf16_t*)(F.ws + WS_PBF), (const bf16_t*)(F.ws + WS_WPP), T / 256, D / 256, F.G, (int)blockIdx.x}; pg8::EpiStoreBf16 E{(bf16_t*)(F.ws + WS_PP), D}; int kb = PLE * 2; asm volatile("" : "+s"(kb));
    pg8::gemm_phase(F.lds, kb, S, E); }
__device__ __forceinline__ void ph_out(Frame& F, const Args& a) {
    pg8::DenseSched S{(const bf16_t*)(F.ws + WS_XN), (const bf16_t*)(F.ws + WS_WPG), T / 256, D / 256, F.G, (int)blockIdx.x}; pg8::EpiPle E{a.out, (const bf16_t*)(F.ws + WS_PP)}; pg8::gemm_phase(F.lds, D * 2, S, E); }

constexpr int NPHASE = 12;
__global__ void __launch_bounds__(NWAVES * 64, 2) mk_fwd(Args args) {
    extern __shared__ __attribute__((aligned(16))) unsigned char lds_raw[];
    Frame F;
    F.lds = (LAS unsigned char*)lds_raw;
    F.tid = threadIdx.x; F.lane = F.tid & 63; F.wave = __builtin_amdgcn_readfirstlane(F.tid >> 6);
    F.G = gridDim.x; { const int bx = blockIdx.x; F.vcu = (F.G % 8 == 0) ? (bx % 8) * (F.G / 8) + bx / 8 : bx; }
    F.ws = args.ws; F.ctl = (unsigned*)(args.ws + WS_CTL);
    volatile LAS unsigned* MISC = (volatile LAS unsigned*)(F.lds + MISC_OFF);
    for (int u = F.tid; u < 64; u += NWAVES * 64) MISC[u] = 0u;
    __syncthreads();
    XcdBarrier bar; bar.bar = F.ctl + CW_BAR; bar.x = 0; bar.st = nullptr;
    if (MK_N_LAUNCHES == 1) bar = xcd_barrier_post(F.ctl + CW_BAR, MISC + 8);
    unsigned char* ws = args.ws;
    const int lo = args.ph_lo, hi = args.ph_hi;
#define IN(k) (lo <= (k) && (k) < hi)
#ifndef DUP_PHASE
#define DUP_PHASE -1
#endif
#define SEAM(k) do { if (IN(k) && IN((k) + 1)) xcd_barrier(bar); } while (0)

#define RUN(k, call) do { if (IN(k)) { call; if (DUP_PHASE == (k)) { xcd_barrier(bar); call; } } SEAM(k); } while (0)
    RUN(0, p0_prologue(F, args));
    RUN(1, ph_gemm1(F, args));
    RUN(2, ph_mlstm(F, args));
    RUN(3, ph_norm_swa(F, args));
    RUN(4, ph_ya(F, args));
    RUN(5, ph_mix(F, args));
    RUN(6, ph_h1(F, args));
    RUN(7, route_phase(F, args));
    RUN(8, ph_up(F, args));
    RUN(9, ph_down(F, args));
    RUN(10, ph_combine_pp(F, args));
    if (IN(11)) ph_out(F, args);
#undef RUN
#undef IN
#undef SEAM
}


#ifdef DBG_DUMP
__global__ void dbg_dump(const bf16_t* src, int ld, int coff, float* out) {
    for (size_t i = (size_t)blockIdx.x * blockDim.x + threadIdx.x; i < (size_t)T * D; i += (size_t)gridDim.x * blockDim.x) { const size_t r = i / D, c = i % D; out[i] = bf1(src[r * ld + coff + c]); }
}
#endif
extern "C" void kernel_launch(void* const* d_in, const int* in_sizes, int n_in, void* d_out, int out_size, void* d_ws, size_t ws_size, hipStream_t stream) {
    static int grid = 0;
    if (grid == 0) {
        if (n_in != 23 || in_sizes[0] != T * D || out_size != T * D || ws_size < WS_END) { fprintf(stderr, "kernel_launch: unexpected shapes (n_in %d, in0 %d, out %d, ws %zu; need ws >= %zu); nothing launched\n", n_in, n_in > 0 ? in_sizes[0] : -1, out_size, ws_size, (size_t)WS_END); grid = -1; return; }
        int dev = 0, cus = 0, per_cu = 0;
        if (hipGetDevice(&dev) != hipSuccess || hipDeviceGetAttribute(&cus, hipDeviceAttributeMultiprocessorCount, dev) != hipSuccess) { fprintf(stderr, "kernel_launch: device query failed\n"); grid = -1; return; }
        if (hipFuncSetAttribute((const void*)mk_fwd, hipFuncAttributeMaxDynamicSharedMemorySize, LDS_BYTES) != hipSuccess) { fprintf(stderr, "kernel_launch: hipFuncSetAttribute failed\n"); grid = -1; return; }
        if (hipOccupancyMaxActiveBlocksPerMultiprocessor(&per_cu, (const void*)mk_fwd, NWAVES * 64, LDS_BYTES) != hipSuccess || per_cu < 1) fprintf(stderr, "kernel_launch: occupancy query reports %d workgroups per CU\n", per_cu);
        (void)hipGetLastError();
        grid = cus;
    }
    if (grid < 0) return;
    if (hipMemsetAsync((char*)d_ws + WS_CTL, 0, CTL_ZERO_BYTES, stream) != hipSuccess) { fprintf(stderr, "kernel_launch: memset failed\n"); return; }
    Args a{};
    for (int i = 0; i < 23; ++i) a.in[i] = (const float*)d_in[i];
    a.out = (float*)d_out; a.ws = (unsigned char*)d_ws;
#ifndef DBG_LAST
#define DBG_LAST NPHASE
#endif
    for (int li = 0; li < MK_N_LAUNCHES && li < DBG_LAST; ++li) {
        a.ph_lo = (MK_N_LAUNCHES == 1) ? 0 : li; a.ph_hi = (MK_N_LAUNCHES == 1) ? NPHASE : li + 1;
        hipLaunchKernelGGL(mk_fwd, dim3(grid), dim3(NWAVES * 64), LDS_BYTES, stream, a);
        const hipError_t le = hipPeekAtLastError();
        if (le != hipSuccess) { fprintf(stderr, "kernel_launch: launch %d failed: %s\n", li, hipGetErrorName(le)); break; }
    }
#ifdef DBG_DUMP
    { const bf16_t* s = (const bf16_t*)((unsigned char*)d_ws + DBG_DUMP_OFF); hipLaunchKernelGGL(dbg_dump, dim3(2048), dim3(256), 0, stream, s, DBG_DUMP_LD, DBG_DUMP_COL, (float*)d_out); }
#endif
}
```

```cpp
#include <hip/hip_runtime.h>
#include <cstdio>
#include <cstdint>

#ifndef MK_N_LAUNCHES
#define MK_N_LAUNCHES 1
#endif

#define GAS __attribute__((address_space(1)))
#define LAS __attribute__((address_space(3)))
typedef unsigned short bf16_t;
typedef short bf16x8 __attribute__((ext_vector_type(8)));
typedef short s16x4 __attribute__((ext_vector_type(4)));
typedef float f32x2 __attribute__((ext_vector_type(2)));
typedef float f32x4 __attribute__((ext_vector_type(4)));
typedef float f32x16 __attribute__((ext_vector_type(16)));
typedef unsigned u32x2 __attribute__((ext_vector_type(2)));
typedef unsigned u32x4 __attribute__((ext_vector_type(4)));
typedef int i32x4 __attribute__((ext_vector_type(4)));

constexpr int BATCH = 4, SEQ = 8192, T = BATCH * SEQ, D = 2048;
constexpr int PLE = 256;
constexpr int NE = 32, TOPK = 4, DFF = 2048, CAP = T;
constexpr int NPROJ = 13056;
constexpr int C_MLQ = 0, C_MLK = 1024, C_MLV = 2048, C_MLO = 4096, C_SWQ = 6144, C_SWK = 8192, C_SWV = 8448, C_GA = 8704, C_GB = 10752, C_GI = 12800, C_GF = 12808;
constexpr int DIN = 12816;
constexpr float EPS = 1e-6f;
constexpr float LOG2E = 1.4426950408889634f;
constexpr int ACT_ROWS = 139264;

constexpr size_t MiB = 1u << 20;
constexpr size_t WS_CTL = 0, CTL_ZERO_BYTES = 1 * MiB;
constexpr size_t WS_WIN = 2 * MiB;
constexpr size_t WS_WA = 54 * MiB, WS_WB = 62 * MiB, WS_WOUT = 70 * MiB, WS_WPG = 78 * MiB, WS_WPP = 86 * MiB, WS_WRP = 87 * MiB, WS_SWUP = 88 * MiB, WS_SWIN = 89 * MiB, WS_SA1 = 90 * MiB;
constexpr size_t WS_WUP = 96 * MiB;
constexpr size_t WS_WDN = 608 * MiB;
constexpr size_t WS_XN = 864 * MiB;
constexpr size_t WS_PROJ = 992 * MiB;
constexpr size_t WS_HML = 1808 * MiB;
constexpr size_t WS_ASW = 1936 * MiB;
constexpr size_t WS_YA = 2064 * MiB, WS_MIX = 2192 * MiB;
constexpr size_t WS_PBF = 2320 * MiB;
constexpr size_t WS_PP = 2336 * MiB;
constexpr size_t WS_ACT = 2464 * MiB;
constexpr size_t WS_YS = 3008 * MiB;
constexpr size_t WS_TOKL = 3520 * MiB, WS_GATEL = 3524 * MiB, WS_DESTL = 3528 * MiB, WS_RSL = 3532 * MiB;
constexpr size_t WS_GATES = 3536 * MiB;
constexpr size_t WS_END = 3568 * MiB;
constexpr int CW_TMO = 0, CW_CODE = 1;
constexpr int CW_BAR = 4096;
constexpr int CW_CUR = 16384;

constexpr int RING_BYTES = 131072;
constexpr int TAB_OFF = RING_BYTES;
constexpr int MISC_OFF = RING_BYTES + 8192;
constexpr int LDS_BYTES = 147456;
constexpr int NWAVES = 8;

#define RLX_AGENT __ATOMIC_RELAXED, __HIP_MEMORY_SCOPE_AGENT
#define LDS_WAIT() asm volatile("s_waitcnt lgkmcnt(0)" ::: "memory")
#define VM_WAIT() asm volatile("s_waitcnt vmcnt(0)" ::: "memory")
#define WG_BAR() do { asm volatile("s_waitcnt lgkmcnt(0)" ::: "memory"); __builtin_amdgcn_s_barrier(); asm volatile("" ::: "memory"); } while (0)

typedef __bf16 bf16x2_t __attribute__((ext_vector_type(2)));
__device__ __forceinline__ unsigned cvt_pk_bf16(float lo, float hi) { const f32x2 v = {lo, hi}; const bf16x2_t b = __builtin_convertvector(v, bf16x2_t); return __builtin_bit_cast(unsigned, b); }
__device__ __forceinline__ float bf_lo(unsigned w) { return __uint_as_float(w << 16); }
__device__ __forceinline__ float bf_hi(unsigned w) { return __uint_as_float(w & 0xffff0000u); }
__device__ __forceinline__ float bf1(bf16_t b) { return __uint_as_float(((unsigned)b) << 16); }
__device__ __forceinline__ float sigmoidf_(float x) { return 1.0f / (1.0f + __expf(-x)); }
__device__ __forceinline__ float wave_sum(float v) {
#pragma unroll
    for (int o = 1; o < 64; o <<= 1) v += __shfl_xor(v, o);
    return v;
}

namespace pg8 {
constexpr int BM = 256, BK = 64, HALF = 128, HTB = HALF * BK * 2, STAGE_BYTES = 8 * HTB, NXCD = 8, WGM = 8;
__host__ __device__ __forceinline__ int lds_byte(int r, int c) { const int st = (r >> 4) * 2 + (c >> 5), rr = r & 15, cc = c & 31, ob = rr * 64 + cc * 2; return st * 1024 + (ob ^ (((ob >> 9) & 1) << 5)); }
__host__ __device__ __forceinline__ void stage_rc(int b, int& R, int& C) { const int st = b / 1024, sb = b % 1024, swz = sb ^ (((sb >> 9) & 1) << 5); R = (st >> 1) * 16 + swz / 64; C = (st & 1) * 32 + (swz % 64) / 2; }
__host__ __device__ __forceinline__ int perm32(int rho) { const int n = rho >> 4, i = rho & 15; return 8 * (i >> 2) + 4 * n + (i & 3); }

struct Unit { int pm, pn, e, r0, cnt; };

__device__ __forceinline__ void map_unit(int L, int nM, int nN, int& pm, int& pn) {
    const int nwg = nM * nN;
    int wgid = L; { const int q = nwg / NXCD, r = nwg % NXCD, xcd = wgid % NXCD, off = wgid / NXCD; wgid = (xcd < r ? xcd * (q + 1) : r * (q + 1) + (xcd - r) * q) + off; }
    const int nig = WGM * nN, gid = wgid / nig, fm = gid * WGM, gsz = (nM - fm) < WGM ? (nM - fm) : WGM;
    pm = fm + ((wgid % nig) % gsz); pn = (wgid % nig) / gsz;
}

struct DenseSched {
    static constexpr bool GATHER = false;
    const bf16_t* A; const bf16_t* Bt; int nM, nN, G, c;
    __device__ __forceinline__ bool next(int i, Unit& u) const { const long L = (long)i * G + c; if (L >= (long)nM * nN) return false; map_unit((int)L, nM, nN, u.pm, u.pn); u.e = 0; u.r0 = 0; u.cnt = 0; return true; }
    __device__ __forceinline__ const char* a_base() const { return (const char*)A; }
    __device__ __forceinline__ void a_offs(const Unit& u, const int (&R)[2], const int (&C)[2], int Kb, unsigned (&vo)[2][2]) const {
#pragma unroll
        for (int h = 0; h < 2; ++h)
#pragma unroll
            for (int i = 0; i < 2; ++i) vo[h][i] = (unsigned)(u.pm * BM + h * HALF + R[i]) * (unsigned)Kb + (unsigned)C[i] * 2u;
    }
    __device__ __forceinline__ const char* a_tile(const Unit& u, int Kb) const { return (const char*)A + (size_t)u.pm * BM * Kb; }
    __device__ __forceinline__ const char* b_tile(const Unit& u, int Kb) const { return (const char*)Bt + (size_t)u.pn * BM * Kb; }
};
template <bool I8> struct AccSel { typedef f32x4 type; };
template <> struct AccSel<true> { typedef i32x4 type; };

template <bool I8> __device__ __forceinline__ typename AccSel<I8>::type mma1(const bf16x8 a, const bf16x8 b, const typename AccSel<I8>::type c) {
    if constexpr (I8) return __builtin_amdgcn_mfma_i32_16x16x64_i8(__builtin_bit_cast(i32x4, a), __builtin_bit_cast(i32x4, b), c, 0, 0, 0);
    else return __builtin_amdgcn_mfma_f32_16x16x32_bf16(a, b, c, 0, 0, 0);
}
template <class Epi, class Sched>
__device__ __forceinline__ void gemm_phase(LAS unsigned char* lds, const int Kb, const Sched& S, const Epi& E) {
    constexpr bool I8 = Epi::I8;
    typedef typename AccSel<I8>::type acc_t;
    const int tid = threadIdx.x, wid = __builtin_amdgcn_readfirstlane(tid >> 6), lane = tid & 63, wr = wid >> 2, wc = wid & 3, fr = lane & 15, fq = lane >> 4;
    const int K = Kb;
    const int nt = Kb / (BK * 2);
    int Rr[2], Cc[2]; unsigned voffB[2];
#pragma unroll
    for (int i = 0; i < 2; ++i) { int R, C; stage_rc(tid * 16 + i * 8192, R, C); Rr[i] = R; Cc[i] = C; const int Rb = Epi::PERM ? ((R & ~31) + perm32(R & 31)) : R; voffB[i] = (unsigned)(Rb * Kb + C * 2); }
    const size_t kstep = (size_t)(BK * 2);
    const size_t hstep = (size_t)HALF * Kb;
    const unsigned ldsw = (unsigned)wid * 1024u;
    const int aoff = lds_byte(wr * 64 + fr, fq * 8), boff = lds_byte(wc * 32 + fr, fq * 8);
#define PG8_SA(b, h) (((b) * 2 + (h)) * HTB)
#define PG8_SB(b, h) ((4 + (b) * 2 + (h)) * HTB)
#define PG8_STAGE(bufoff, gbase, voff) do { _Pragma("unroll") for (int _i = 0; _i < 2; ++_i) \
        __builtin_amdgcn_global_load_lds((const unsigned*)((const char*)(gbase) + (voff)[_i]), (LAS unsigned*)(lds + (bufoff) + ldsw + _i * 8192), 16, 0, 0); } while (0)
#define PG8_LDA(dst, b, h) do { _Pragma("unroll") for (int m = 0; m < 4; ++m) _Pragma("unroll") for (int k = 0; k < 2; ++k) dst[m][k] = *(const LAS bf16x8*)(lds + PG8_SA(b, h) + aoff + m * 2048 + k * 1024); } while (0)
#define PG8_LDB(dst, b, h) do { _Pragma("unroll") for (int n = 0; n < 2; ++n) _Pragma("unroll") for (int k = 0; k < 2; ++k) dst[n][k] = *(const LAS bf16x8*)(lds + PG8_SB(b, h) + boff + n * 2048 + k * 1024); } while (0)
#define PG8_MMA(ai, bj, At, Bt) do { __builtin_amdgcn_s_setprio(1); _Pragma("unroll") for (int m = 0; m < 4; ++m) _Pragma("unroll") for (int n = 0; n < 2; ++n) _Pragma("unroll") for (int k = 0; k < 2; ++k) \
        acc[ai][bj][m][n] = mma1<I8>(Bt[n][k], At[m][k], acc[ai][bj][m][n]); __builtin_amdgcn_s_setprio(0); } while (0)
#define PG8_WAIT_V(n) asm volatile("s_waitcnt vmcnt(" #n ")" ::: "memory")
#define PG8_WAIT_L(n) asm volatile("s_waitcnt lgkmcnt(" #n ")" ::: "memory")
#define PG8_BAR __builtin_amdgcn_s_barrier()
#define PG8_SCHED __builtin_amdgcn_sched_barrier(0)
    Unit cur, nxt; int ui = 0;
    if (!S.next(0, cur)) return;
    acc_t acc[2][2][4][2];
#pragma unroll
    for (int a = 0; a < 2; ++a)
#pragma unroll
        for (int b = 0; b < 2; ++b)
#pragma unroll
            for (int m = 0; m < 4; ++m)
#pragma unroll
                for (int n = 0; n < 2; ++n) acc[a][b][m][n] = (acc_t){0, 0, 0, 0};
    bf16x8 At[4][2], B0[2][2], B1[2][2];
    constexpr bool GA = Sched::GATHER;
    unsigned cvo[2][2], nvo[2][2];
    if constexpr (GA) S.a_offs(cur, Rr, Cc, K, cvo);
    else {
#pragma unroll
        for (int h = 0; h < 2; ++h)
#pragma unroll
            for (int i = 0; i < 2; ++i) cvo[h][i] = (unsigned)(h * HALF + Rr[i]) * (unsigned)Kb + (unsigned)Cc[i] * 2u;
    }
    const char* cA = S.a_tile(cur, K);
    const char* cB = S.b_tile(cur, K);
    PG8_STAGE(PG8_SB(0, 0), cB, voffB); PG8_STAGE(PG8_SB(0, 1), cB + hstep, voffB); PG8_STAGE(PG8_SA(0, 0), cA, cvo[0]); PG8_STAGE(PG8_SA(0, 1), cA, cvo[1]);
    if (wr == 1) PG8_BAR;
    PG8_WAIT_V(2); PG8_BAR;
    PG8_STAGE(PG8_SB(1, 0), cB + kstep, voffB); PG8_STAGE(PG8_SA(1, 0), cA + kstep, cvo[0]); PG8_STAGE(PG8_SB(1, 1), cB + hstep + kstep, voffB);
    PG8_WAIT_V(6); PG8_BAR;
    for (;;) {
        const bool has_next = S.next(ui + 1, nxt);
        const char* nB = cB; const char* nA = cA;
        if (has_next) { if constexpr (GA) S.a_offs(nxt, Rr, Cc, K, nvo); nB = S.b_tile(nxt, K); nA = S.a_tile(nxt, K); }
        else if constexpr (GA) {
#pragma unroll
            for (int h = 0; h < 2; ++h)
#pragma unroll
                for (int i = 0; i < 2; ++i) nvo[h][i] = cvo[h][i];
        }
        for (int t = 0; t < nt; t += 2) {
            const bool last = (t == nt - 2);
            const char* a1 = cA + (size_t)(t + 1) * kstep;
            const char* a2 = last ? nA : cA + (size_t)(t + 2) * kstep; const char* b2 = last ? nB : cB + (size_t)(t + 2) * kstep;
            const char* a3 = a2 + kstep; const char* b3 = b2 + kstep;
#define PG8_O2(h) (GA ? (last ? nvo[h] : cvo[h]) : cvo[h])
            PG8_LDB(B0, 0, 0); PG8_LDB(B1, 0, 1); PG8_SCHED; PG8_LDA(At, 0, 0); PG8_STAGE(PG8_SA(1, 1), a1, cvo[1]);
            PG8_WAIT_V(8); PG8_WAIT_L(0); PG8_BAR; PG8_MMA(0, 0, At, B0); PG8_MMA(0, 1, At, B1); PG8_BAR; PG8_SCHED;
            PG8_LDA(At, 0, 1); PG8_STAGE(PG8_SB(0, 0), b2, voffB); PG8_STAGE(PG8_SB(0, 1), b2 + hstep, voffB); PG8_STAGE(PG8_SA(0, 0), a2, PG8_O2(0));
            PG8_WAIT_V(8); PG8_WAIT_L(0); PG8_BAR; PG8_MMA(1, 0, At, B0); PG8_MMA(1, 1, At, B1); PG8_BAR; PG8_SCHED;
            PG8_LDB(B0, 1, 0); PG8_LDB(B1, 1, 1); PG8_SCHED; PG8_LDA(At, 1, 0); PG8_STAGE(PG8_SA(0, 1), a2, PG8_O2(1));
            PG8_WAIT_V(8); PG8_WAIT_L(0); PG8_BAR; PG8_MMA(0, 0, At, B0); PG8_MMA(0, 1, At, B1); PG8_BAR; PG8_SCHED;
            PG8_LDA(At, 1, 1); PG8_STAGE(PG8_SB(1, 0), b3, voffB); PG8_STAGE(PG8_SB(1, 1), b3 + hstep, voffB); PG8_STAGE(PG8_SA(1, 0), a3, PG8_O2(0));
            PG8_WAIT_V(8); PG8_WAIT_L(0); PG8_BAR; PG8_MMA(1, 0, At, B0); PG8_MMA(1, 1, At, B1); PG8_BAR; PG8_SCHED;
#undef PG8_O2
        }
        if (wr == 0) PG8_BAR;
        E(acc, cur, wr, wc, fr, fq);
        if (!has_next) break;
#pragma unroll
        for (int a = 0; a < 2; ++a)
#pragma unroll
            for (int b = 0; b < 2; ++b)
#pragma unroll
                for (int m = 0; m < 4; ++m)
#pragma unroll
                    for (int n = 0; n < 2; ++n) acc[a][b][m][n] = (acc_t){0, 0, 0, 0};
        cur = nxt; cB = nB; cA = nA; ++ui;
        if constexpr (GA) {
#pragma unroll
            for (int h = 0; h < 2; ++h)
#pragma unroll
                for (int i = 0; i < 2; ++i) cvo[h][i] = nvo[h][i];
        }
        if (wr == 1) PG8_BAR;
    }
    PG8_WAIT_V(0);
    PG8_BAR;
#undef PG8_SA
#undef PG8_SB
#undef PG8_STAGE
#undef PG8_LDA
#undef PG8_LDB
#undef PG8_MMA
#undef PG8_WAIT_V
#undef PG8_WAIT_L
#undef PG8_BAR
#undef PG8_SCHED
}

__device__ __forceinline__ u32x4 pack8(const f32x4 v0, const f32x4 v1) { u32x4 w; w.x = cvt_pk_bf16(v0[0], v0[1]); w.y = cvt_pk_bf16(v0[2], v0[3]); w.z = cvt_pk_bf16(v1[0], v1[1]); w.w = cvt_pk_bf16(v1[2], v1[3]); return w; }
__device__ __forceinline__ void unpack8(const u32x4 w, f32x4& v0, f32x4& v1) { v0 = (f32x4){bf_lo(w.x), bf_hi(w.x), bf_lo(w.y), bf_hi(w.y)}; v1 = (f32x4){bf_lo(w.z), bf_hi(w.z), bf_lo(w.w), bf_hi(w.w)}; }
__device__ __forceinline__ f32x4 sig4(const f32x4 v) { return (f32x4){sigmoidf_(v[0]), sigmoidf_(v[1]), sigmoidf_(v[2]), sigmoidf_(v[3])}; }

struct EpiStoreBf16 {
    static constexpr bool PERM = true, I8 = false;
    bf16_t* O; int ldc;
    __device__ __forceinline__ void operator()(const f32x4 (&acc)[2][2][4][2], const Unit& u, int wr, int wc, int fr, int fq) const {
        const int row0 = u.pm * BM + wr * 64 + fr, col0 = u.pn * BM + wc * 32 + 8 * fq;
#pragma unroll
        for (int ai = 0; ai < 2; ++ai)
#pragma unroll
            for (int m = 0; m < 4; ++m) { bf16_t* rowp = O + (size_t)(row0 + ai * HALF + m * 16) * ldc + col0;
#pragma unroll
                for (int bj = 0; bj < 2; ++bj) *(u32x4*)(rowp + bj * HALF) = pack8(acc[ai][bj][m][0], acc[ai][bj][m][1]); }
    }
};
struct EpiProjI8 {
    static constexpr bool PERM = true, I8 = true;
    bf16_t* O; int ldc; const float* sa; const float* sw;
    __device__ __forceinline__ void operator()(const i32x4 (&acc)[2][2][4][2], const Unit& u, int wr, int wc, int fr, int fq) const {
        const int row0 = u.pm * BM + wr * 64 + fr, col0 = u.pn * BM + wc * 32 + 8 * fq;
        f32x4 sc[2][2];
#pragma unroll
        for (int bj = 0; bj < 2; ++bj)
#pragma unroll
            for (int n = 0; n < 2; ++n) sc[bj][n] = *(const f32x4*)(sw + col0 + bj * HALF + 4 * n);
#pragma unroll
        for (int ai = 0; ai < 2; ++ai)
#pragma unroll
            for (int m = 0; m < 4; ++m) { const int row = row0 + ai * HALF + m * 16; const float rs = sa[row]; bf16_t* rowp = O + (size_t)row * ldc + col0;
#pragma unroll
                for (int bj = 0; bj < 2; ++bj) *(u32x4*)(rowp + bj * HALF) = pack8(__builtin_convertvector(acc[ai][bj][m][0], f32x4) * rs * sc[bj][0], __builtin_convertvector(acc[ai][bj][m][1], f32x4) * rs * sc[bj][1]); }
    }
};
template <bool ADD> struct EpiGate {
    static constexpr bool PERM = true, I8 = false;
    bf16_t* O; const bf16_t* Gt; int ldg; const bf16_t* Y;
    __device__ __forceinline__ void operator()(const f32x4 (&acc)[2][2][4][2], const Unit& u, int wr, int wc, int fr, int fq) const {
        const int row0 = u.pm * BM + wr * 64 + fr, col0 = u.pn * BM + wc * 32 + 8 * fq;
#pragma unroll
        for (int ai = 0; ai < 2; ++ai)
#pragma unroll
            for (int m = 0; m < 4; ++m) { const size_t row = (size_t)(row0 + ai * HALF + m * 16);
#pragma unroll
                for (int bj = 0; bj < 2; ++bj) {
                    const u32x4 gw = *(const u32x4*)(Gt + row * ldg + col0 + bj * HALF); f32x4 g0, g1; unpack8(gw, g0, g1);
                    f32x4 v0 = sig4(g0) * acc[ai][bj][m][0], v1 = sig4(g1) * acc[ai][bj][m][1];
                    if (ADD) { const u32x4 yw = *(const u32x4*)(Y + row * D + col0 + bj * HALF); f32x4 y0, y1; unpack8(yw, y0, y1); v0 += y0; v1 += y1; }
                    *(u32x4*)(O + row * D + col0 + bj * HALF) = pack8(v0, v1); } }
    }
};
struct EpiResF32 {
    static constexpr bool PERM = false, I8 = false;
    const float* X; float* O;
    __device__ __forceinline__ void operator()(const f32x4 (&acc)[2][2][4][2], const Unit& u, int wr, int wc, int fr, int fq) const {
        const int row0 = u.pm * BM + wr * 64 + fr, col0 = u.pn * BM + wc * 32 + 4 * fq;
#pragma unroll
        for (int ai = 0; ai < 2; ++ai)
#pragma unroll
            for (int m = 0; m < 4; ++m) { const size_t off = (size_t)(row0 + ai * HALF + m * 16) * D + col0;
#pragma unroll
                for (int bj = 0; bj < 2; ++bj)
#pragma unroll
                    for (int n = 0; n < 2; ++n) { const f32x4 xv = *(const f32x4*)(X + off + bj * HALF + n * 16); *(f32x4*)(O + off + bj * HALF + n * 16) = xv + acc[ai][bj][m][n]; } }
    }
};
struct EpiPle {
    static constexpr bool PERM = false, I8 = false;
    float* O; const bf16_t* PP;
    __device__ __forceinline__ void operator()(const f32x4 (&acc)[2][2][4][2], const Unit& u, int wr, int wc, int fr, int fq) const {
        const int row0 = u.pm * BM + wr * 64 + fr, col0 = u.pn * BM + wc * 32 + 4 * fq;
#pragma unroll
        for (int ai = 0; ai < 2; ++ai)
#pragma unroll
            for (int m = 0; m < 4; ++m) { const size_t off = (size_t)(row0 + ai * HALF + m * 16) * D + col0;
#pragma unroll
                for (int bj = 0; bj < 2; ++bj)
#pragma unroll
                    for (int n = 0; n < 2; ++n) { const size_t o = off + bj * HALF + n * 16; const f32x4 hv = *(const f32x4*)(O + o); const u32x2 pw = *(const u32x2*)(PP + o);
                        const f32x4 pv = (f32x4){bf_lo(pw.x), bf_hi(pw.x), bf_lo(pw.y), bf_hi(pw.y)}; *(f32x4*)(O + o) = hv + sig4(acc[ai][bj][m][n]) * pv; } }
    }
};
}

#define XB_TMO      128
#define XB_XCNT(j)  (256  + 64 * (j))
#define XB_XSUB(j)  (1280 + 64 * (j))
#define XB_XGEN(j)  (2304 + 64 * (j))
#define XB_TOP      3328
#define XB_TOPGEN   3392
#define XCD_BAR_WORDS 3456
#define XB_SPIN_CAP (1u << 22)

__device__ __forceinline__ unsigned xb_ld(unsigned* p)              { return __hip_atomic_load(p, __ATOMIC_RELAXED, __HIP_MEMORY_SCOPE_AGENT); }
__device__ __forceinline__ unsigned xb_add(unsigned* p, unsigned v) { return __hip_atomic_fetch_add(p, v, __ATOMIC_RELAXED, __HIP_MEMORY_SCOPE_AGENT); }
__device__ __forceinline__ unsigned xb_xcc_id() { return (unsigned)__builtin_amdgcn_s_getreg((3 << 11) | 20) & 0xFu; }
#define XB_SPIN(cond, bar) do { unsigned _sp = 0; while (cond) { __builtin_amdgcn_s_sleep(1); \
    if ((++_sp & 255u) == 0u) { if (xb_ld(&(bar)[XB_TMO])) break; if (_sp > XB_SPIN_CAP) { atomicAdd(&(bar)[XB_TMO], 1u); break; } } } } while (0)

struct XcdBarrier { unsigned* bar; unsigned x; volatile LAS unsigned* st; };

__device__ __forceinline__ XcdBarrier xcd_barrier_post(unsigned* bar, volatile LAS unsigned* st) {
    XcdBarrier b; b.bar = bar; b.x = xb_xcc_id(); b.st = st;
    if (threadIdx.x == 0) (void)xb_add(&bar[XB_XCNT(b.x)], 1u);
    return b;
}
__device__ __forceinline__ void xcd_barrier_complete(unsigned* bar, unsigned x, unsigned& nloc, unsigned& nx) {
    const unsigned G = gridDim.x * gridDim.y * gridDim.z;
    unsigned sum, cnt, mine, sp = 0u;
    for (;;) {
        sum = 0u; cnt = 0u; mine = 0u;
#pragma unroll
        for (unsigned j = 0; j < 16; ++j) { const unsigned c = xb_ld(&bar[XB_XCNT(j)]); sum += c; cnt += (c > 0u) ? 1u : 0u; mine = (j == x) ? c : mine; }
        if (sum == G) break;
        __builtin_amdgcn_s_sleep(1);
        if ((++sp & 255u) == 0u) { if (xb_ld(&bar[XB_TMO])) break; if (sp > XB_SPIN_CAP) { atomicAdd(&bar[XB_TMO], 1u); break; } }
    }
    nloc = mine > 0u ? mine : 1u; nx = cnt > 0u ? cnt : 1u;
}
__device__ __forceinline__ void xcd_barrier(const XcdBarrier& b) {
    asm volatile("s_waitcnt vmcnt(0)" ::: "memory");
    __syncthreads();
    if (threadIdx.x == 0) {
        unsigned* bar = b.bar;
        __builtin_amdgcn_s_waitcnt(0);
        unsigned nloc = b.st[0], nx = b.st[1];
        if (nloc == 0u) { xcd_barrier_complete(bar, b.x, nloc, nx); b.st[0] = nloc; b.st[1] = nx; }
        const unsigned old = xb_add(&bar[XB_XSUB(b.x)], 1u);
        const unsigned gen = old / nloc;
        if (old + 1u == (gen + 1u) * nloc) {
            __builtin_amdgcn_fence(__ATOMIC_RELEASE, "agent");
            asm volatile("s_waitcnt vmcnt(0)" ::: "memory");
            const unsigned og = xb_add(&bar[XB_TOP], 1u);
            const unsigned tg = og / nx;
            if (og + 1u == (tg + 1u) * nx) xb_add(&bar[XB_TOPGEN], 1u);
            else XB_SPIN(xb_ld(&bar[XB_TOPGEN]) == tg, bar);
            __builtin_amdgcn_fence(__ATOMIC_ACQUIRE, "agent");
            xb_add(&bar[XB_XGEN(b.x)], 1u);
            asm volatile("s_waitcnt vmcnt(0)" ::: "memory");
        } else {
            XB_SPIN(xb_ld(&bar[XB_XGEN(b.x)]) == gen, bar);
            __builtin_amdgcn_fence(__ATOMIC_ACQUIRE, "agent");
            asm volatile("s_waitcnt vmcnt(0)" ::: "memory");
        }
    }
    __syncthreads();
}

struct Frame {
    LAS unsigned char* lds;
    unsigned* ctl;
    int tid, lane, wave, vcu, G;
    unsigned char* ws;
};
struct Args { const float* in[23]; float* out; unsigned char* ws; int ph_lo, ph_hi; };

template <class RowMap>
__device__ __forceinline__ void transpose_item(const float* W, int K, int N, bf16_t* WT, const RowMap rm, LAS float* scr, int item, int lane) {
    const int nblk = (N + 31) / 32, kb = item / nblk, nb = item % nblk, k0 = 64 * kb, n0 = 32 * nb;
    const int nc = n0 + (lane & 31); const bool ok = nc < N;
    float tv[32];
#pragma unroll
    for (int i = 0; i < 32; ++i) tv[i] = W[(size_t)(k0 + 2 * i + (lane >> 5)) * N + (ok ? nc : n0)];
#pragma unroll
    for (int i = 0; i < 32; ++i) scr[(2 * i + (lane >> 5)) * 33 + (lane & 31)] = ok ? tv[i] : 0.f;
    LDS_WAIT(); asm volatile("" ::: "memory");
    const int c = lane & 7;
#pragma unroll
    for (int j = 0; j < 4; ++j) { const int n = (lane >> 3) + 8 * j; const LAS float* s = scr + (8 * c) * 33 + n;
        u32x4 o; o.x = cvt_pk_bf16(s[0 * 33], s[1 * 33]); o.y = cvt_pk_bf16(s[2 * 33], s[3 * 33]); o.z = cvt_pk_bf16(s[4 * 33], s[5 * 33]); o.w = cvt_pk_bf16(s[6 * 33], s[7 * 33]);
        if (n0 + n < N) *(u32x4*)(WT + (size_t)rm(n0 + n) * K + k0 + 8 * c) = o; }
    LDS_WAIT(); asm volatile("" ::: "memory");
}
template <class RowMap, class ScaleMap>
__device__ __forceinline__ void quant_panel_wg(const float* W, int N, signed char* WT, float* sw, const RowMap rm, const ScaleMap sm, LAS float* scr, LAS float* wmax, int nb, int wave, int lane) {
    const int n0 = 32 * nb, nc = n0 + (lane & 31); const bool ok = nc < N;
    const float* wp = W + (size_t)(256 * wave + (lane >> 5)) * N + (ok ? nc : n0);
    float v[4][32]; float mx = 0.f;
#pragma unroll
    for (int kb = 0; kb < 4; ++kb)
#pragma unroll
        for (int i = 0; i < 32; ++i) v[kb][i] = wp[(size_t)(64 * kb + 2 * i) * N];
#pragma unroll
    for (int kb = 0; kb < 4; ++kb)
#pragma unroll
        for (int i = 0; i < 32; ++i) mx = fmaxf(mx, fabsf(v[kb][i]));
    mx = fmaxf(mx, __shfl_xor(mx, 32));
    if (lane < 32) wmax[wave * 32 + lane] = ok ? mx : 0.f;
    __syncthreads();
    float cm = 1e-30f;
#pragma unroll
    for (int w = 0; w < 8; ++w) cm = fmaxf(cm, wmax[w * 32 + (lane & 31)]);
    const float qs = 127.0f / cm;
    if (wave == 0 && lane < 32 && ok) sw[sm(nc)] = cm * (1.0f / 127.0f);
    const int n = lane >> 1, half = lane & 1; const bool okw = (n0 + n) < N;
    signed char* orow = WT + (size_t)rm(okw ? n0 + n : n0) * 2048 + 256 * wave + 32 * half;
#pragma unroll
    for (int kb = 0; kb < 4; ++kb) {
#pragma unroll
        for (int i = 0; i < 32; ++i) scr[(2 * i + (lane >> 5)) * 33 + (lane & 31)] = ok ? v[kb][i] * qs : 0.f;
        LDS_WAIT(); asm volatile("" ::: "memory");
        unsigned w[8];
#pragma unroll
        for (int q = 0; q < 8; ++q) { unsigned pk = 0u;
#pragma unroll
            for (int b = 0; b < 4; ++b) { const int iv = __float2int_rn(scr[(32 * half + 4 * q + b) * 33 + n]); pk |= ((unsigned)iv & 0xffu) << (8 * b); }
            w[q] = pk; }
        if (okw) { *(u32x4*)(orow + 64 * kb) = (u32x4){w[0], w[1], w[2], w[3]}; *(u32x4*)(orow + 64 * kb + 16) = (u32x4){w[4], w[5], w[6], w[7]}; }
        LDS_WAIT(); asm volatile("" ::: "memory");
    }
    __syncthreads();
}
struct MapId { __device__ __forceinline__ int operator()(int n) const { return n; } };
struct MapWin { __device__ __forceinline__ int operator()(int n) const { return n < 6144 ? n : (n < 6160 ? C_GI + (n - 6144) : n - 16); } };
struct MapUp { __device__ __forceinline__ int operator()(int n) const { const int c = n & 2047, lin = n >> 11; return 256 * (c >> 7) + 128 * lin + (c & 127); } };

__device__ __forceinline__ void rms_row_to_bf16(const float* xrow, const float* w, bf16_t* orow, int lane) {
    f32x4 v[4][2]; float s = 0.f;
#pragma unroll
    for (int j = 0; j < 4; ++j)
#pragma unroll
        for (int q = 0; q < 2; ++q) { v[j][q] = *(const f32x4*)(xrow + 512 * j + 8 * lane + 4 * q); s += (v[j][q].x * v[j][q].x + v[j][q].y * v[j][q].y) + (v[j][q].z * v[j][q].z + v[j][q].w * v[j][q].w); }
    const float rstd = 1.0f / sqrtf(wave_sum(s) * (1.f / D) + EPS);
#pragma unroll
    for (int j = 0; j < 4; ++j) { const f32x4 w0 = *(const f32x4*)(w + 512 * j + 8 * lane), w1 = *(const f32x4*)(w + 512 * j + 8 * lane + 4);
        *(u32x4*)(orow + 512 * j + 8 * lane) = pg8::pack8(v[j][0] * rstd * w0, v[j][1] * rstd * w1); }
}

__device__ __forceinline__ void rms_row_to_i8(const float* xrow, const float* w, signed char* orow, float* sa, int lane) {
    f32x4 v[4][2]; float s = 0.f;
#pragma unroll
    for (int j = 0; j < 4; ++j)
#pragma unroll
        for (int q = 0; q < 2; ++q) { v[j][q] = *(const f32x4*)(xrow + 512 * j + 8 * lane + 4 * q); s += (v[j][q].x * v[j][q].x + v[j][q].y * v[j][q].y) + (v[j][q].z * v[j][q].z + v[j][q].w * v[j][q].w); }
    const float rstd = 1.0f / sqrtf(wave_sum(s) * (1.f / D) + EPS);
    float amax = 0.f;
#pragma unroll
    for (int j = 0; j < 4; ++j)
#pragma unroll
        for (int q = 0; q < 2; ++q) { const f32x4 wv = *(const f32x4*)(w + 512 * j + 8 * lane + 4 * q); v[j][q] = v[j][q] * rstd * wv; amax = fmaxf(fmaxf(amax, fmaxf(fabsf(v[j][q].x), fabsf(v[j][q].y))), fmaxf(fabsf(v[j][q].z), fabsf(v[j][q].w))); }
#pragma unroll
    for (int o = 1; o < 64; o <<= 1) amax = fmaxf(amax, __shfl_xor(amax, o));
    amax = fmaxf(amax, 1e-30f); const float qs = 127.0f / amax;
    if (lane == 0) *sa = amax * (1.0f / 127.0f);
#pragma unroll
    for (int j = 0; j < 4; ++j) { u32x2 o;
#pragma unroll
        for (int q = 0; q < 2; ++q) { const f32x4 t = v[j][q] * qs; const unsigned pk = ((unsigned)__float2int_rn(t.x) & 0xffu) | (((unsigned)__float2int_rn(t.y) & 0xffu) << 8) | (((unsigned)__float2int_rn(t.z) & 0xffu) << 16) | (((unsigned)__float2int_rn(t.w) & 0xffu) << 24); if (q == 0) o.x = pk; else o.y = pk; }
        *(u32x2*)(orow + 512 * j + 8 * lane) = o; }
}
__device__ __forceinline__ void p0_prologue(Frame& F, const Args& a) {
    LAS float* scr = (LAS float*)(F.lds + F.wave * 16384);
    const int gw = F.vcu * NWAVES + F.wave, NGW = F.G * NWAVES;
    unsigned char* ws = F.ws;
    for (int m = gw; m < T; m += NGW) rms_row_to_i8(a.in[0] + (size_t)m * D, a.in[2], (signed char*)(ws + WS_XN) + (size_t)m * D, (float*)(ws + WS_SA1) + m, F.lane);
    { const float* p = a.in[1]; bf16_t* pb = (bf16_t*)(ws + WS_PBF);
      for (size_t i = ((size_t)gw * 64 + F.lane) * 8; i < (size_t)T * PLE; i += (size_t)NGW * 64 * 8) { const f32x4 v0 = *(const f32x4*)(p + i), v1 = *(const f32x4*)(p + i + 4); *(u32x4*)(pb + i) = pg8::pack8(v0, v1); } }
    { const float* wr = a.in[14]; float* wp = (float*)(ws + WS_WRP);
      for (int i = gw * 64 + F.lane; i < 128 * 64 * 8; i += NGW * 64) { const int j = i & 7, ln = (i >> 3) & 63, s = i >> 9, c = ln & 15, kq = ln >> 4; wp[i] = wr[(size_t)(16 * s + 4 * kq + (j & 3)) * NE + c + 16 * (j >> 2)]; } }
    { u32x4* z = (u32x4*)((signed char*)(ws + WS_WIN) + (size_t)12816 * D);
      for (int i = gw * 64 + F.lane; i < 240 * D / 16; i += NGW * 64) z[i] = (u32x4){0u, 0u, 0u, 0u};
      float* zs = (float*)(ws + WS_SWIN) + 12816; for (int i = gw * 64 + F.lane; i < 240; i += NGW * 64) zs[i] = 0.f; }
    constexpr int J_IN = (DIN + 31) / 32;
    constexpr int J_UP = 2 * DFF / 32;
    constexpr int I_SQ = (D / 64) * (D / 32);
    constexpr int I_PP = (PLE / 64) * (D / 32);
    constexpr int I_DN = (DFF / 64) * (D / 32);
    LAS float* wmax = (LAS float*)(F.lds + 8 * 16384);
    for (int job = F.vcu; job < J_IN + NE * J_UP; job += F.G) {
        if (job < J_IN) quant_panel_wg(a.in[3], DIN, (signed char*)(ws + WS_WIN), (float*)(ws + WS_SWIN), MapWin(), MapWin(), scr, wmax, job, F.wave, F.lane);
        else { const int r = job - J_IN, e = r / J_UP; quant_panel_wg(a.in[16] + (size_t)e * D * 2 * DFF, 2 * DFF, (signed char*)(ws + WS_WUP) + (size_t)e * 2 * DFF * D, (float*)(ws + WS_SWUP) + (size_t)e * 2 * DFF, MapUp(), MapId(), scr, wmax, r % J_UP, F.wave, F.lane); }
    }
    constexpr int NITEMS = 4 * I_SQ + I_PP + NE * I_DN;
    for (int it = gw; it < NITEMS; it += NGW) {
        int r = it;
        if (r < I_SQ) { transpose_item(a.in[10], D, D, (bf16_t*)(ws + WS_WA), MapId(), scr, r, F.lane); continue; } r -= I_SQ;
        if (r < I_SQ) { transpose_item(a.in[11], D, D, (bf16_t*)(ws + WS_WB), MapId(), scr, r, F.lane); continue; } r -= I_SQ;
        if (r < I_SQ) { transpose_item(a.in[12], D, D, (bf16_t*)(ws + WS_WOUT), MapId(), scr, r, F.lane); continue; } r -= I_SQ;
        if (r < I_SQ) { transpose_item(a.in[21], D, D, (bf16_t*)(ws + WS_WPG), MapId(), scr, r, F.lane); continue; } r -= I_SQ;
        if (r < I_PP) { transpose_item(a.in[22], PLE, D, (bf16_t*)(ws + WS_WPP), MapId(), scr, r, F.lane); continue; } r -= I_PP;
        { const int e = r / I_DN; transpose_item(a.in[18] + (size_t)e * DFF * D, DFF, D, (bf16_t*)(ws + WS_WDN) + (size_t)e * D * DFF, MapId(), scr, r % I_DN, F.lane); }
    }
}

namespace ml {
constexpr int NC = SEQ / 64;
constexpr int QS = 0, QS_SZ = 64 * 272, KS = 2 * QS_SZ, VS = KS + 64 * 272, VS_SZ = 64 * 80, SS = VS + 2 * VS_SZ, CT = SS + 64 * 144, CT_SZ = 32 * 272,
              NB = CT + 2 * CT_SZ, BB = NB + 512, AA = BB + 512, WW = AA + 512, GG = WW + 512, ML_END = GG + 32;
static_assert(ML_END <= RING_BYTES, "mLSTM LDS");
__device__ __forceinline__ f32x4 mfma16(bf16x8 a, bf16x8 b, f32x4 c) { return __builtin_amdgcn_mfma_f32_16x16x32_bf16(a, b, c, 0, 0, 0); }
typedef short v4i16_t __attribute__((ext_vector_type(4)));
__device__ __forceinline__ s16x4 vtr(const LAS unsigned char* p) { return __builtin_bit_cast(s16x4, __builtin_amdgcn_ds_read_tr16_b64_v4i16((LAS v4i16_t*)p)); }
__device__ __forceinline__ void trfrag(const LAS unsigned char* base, int stride, int kb, int col0, int fr, int fq, s16x4& lo, s16x4& hi) {
    const LAS unsigned char* p = base + (kb + 8 * fq + (fr >> 2)) * stride + (col0 + 4 * (fr & 3)) * 2;
    lo = vtr(p); hi = vtr(p + 4 * stride);
}

__device__ __forceinline__ void mlstm_unit(LAS unsigned char* lds, const bf16_t* PROJ, bf16_t* HML, float* gates, const float* igb, const float* fgb, int b, int h, int sl) {
    const int tid = threadIdx.x, lane = tid & 63, wid = __builtin_amdgcn_readfirstlane(tid >> 6), fr = lane & 15, fq = lane >> 4;
    const size_t row0 = (size_t)b * SEQ;
    const float scale = 0.08838834764831845f;
    const bf16x8 ONES = (bf16x8){0x3F80, 0x3F80, 0x3F80, 0x3F80, 0x3F80, 0x3F80, 0x3F80, 0x3F80};
    { const float ib = igb[h], fb = fgb[h];
      for (int cc = wid; cc < NC; cc += 8) { const bf16_t* base = PROJ + (row0 + (size_t)cc * 64 + lane) * NPROJ;
          const float gi = bf1(base[C_GI + h]), gf = bf1(base[C_GF + h]);
          const float li = 15.f * tanhf((gi + ib) * (1.f / 15.f)); const float fz = 15.f * tanhf((gf + fb) * (1.f / 15.f)); const float lf = fminf(fz, 0.f) - log1pf(__expf(-fabsf(fz)));
          float bsum = lf;
#pragma unroll
          for (int o = 1; o < 64; o <<= 1) { const float tv = __shfl_up(bsum, o); if (lane >= o) bsum += tv; }
          const float g = __shfl(bsum, 63); const float aj = li - bsum; float* gp = gates + (size_t)cc * 256;
          gp[lane] = bsum; gp[64 + lane] = aj; gp[128 + lane] = __expf(g + aj); if (lane == 0) gp[192] = g; } }
    const int qrow[2] = {tid >> 4, (tid + 512) >> 4}, qch = tid & 15;
    const int vrow = (tid & 255) >> 2, vch = tid & 3;
    u32x4 rq[2][2], rk[2][2], rv[2]; float rg[2] = {0.f, 0.f};
#define ML_LOAD(c, s) do { const bf16_t* base = PROJ + (row0 + (size_t)(c) * 64) * NPROJ; \
        _Pragma("unroll") for (int u = 0; u < 2; ++u) { rq[s][u] = *(const u32x4*)(base + (size_t)qrow[u] * NPROJ + C_MLQ + h * 128 + 8 * qch); rk[s][u] = *(const u32x4*)(base + (size_t)qrow[u] * NPROJ + C_MLK + h * 128 + 8 * qch); } \
        if (tid < 256) rv[s] = *(const u32x4*)(base + (size_t)vrow * NPROJ + C_MLV + h * 256 + 32 * sl + 8 * vch); \
        if (tid < 193) rg[s] = gates[(size_t)(c) * 256 + tid]; } while (0)
#define ML_STORE(p, s) do { \
        _Pragma("unroll") for (int u = 0; u < 2; ++u) { *(LAS u32x4*)(lds + QS + (p) * QS_SZ + qrow[u] * 272 + qch * 16) = rq[s][u]; *(LAS u32x4*)(lds + KS + qrow[u] * 272 + qch * 16) = rk[s][u]; } \
        if (tid < 256) *(LAS u32x4*)(lds + VS + (p) * VS_SZ + vrow * 80 + vch * 16) = rv[s]; \
        if (tid < 192) *(LAS float*)(lds + BB + (tid >> 6) * 512 + (p) * 256 + (tid & 63) * 4) = rg[s]; else if (tid == 192) *(LAS float*)(lds + GG + (p) * 16) = rg[s]; } while (0)
    f32x4 Creg[2][2], nreg[2];
#pragma unroll
    for (int a = 0; a < 2; ++a) { nreg[a] = (f32x4){0.f, 0.f, 0.f, 0.f};
#pragma unroll
        for (int c = 0; c < 2; ++c) Creg[a][c] = (f32x4){0.f, 0.f, 0.f, 0.f}; }
    for (int i = tid; i < CT_SZ / 4; i += 512) *(LAS unsigned*)(lds + CT + i * 4) = 0u;
    if (tid < 64) *(LAS unsigned*)(lds + NB + tid * 4) = 0u;
    VM_WAIT(); __syncthreads();
    ML_LOAD(0, 0); ML_STORE(0, 0); ML_LOAD(1, 1);
    WG_BAR();
    const unsigned glist = wid == 0 ? 0x0DCu : wid == 1 ? 0x4FEu : wid == 2 ? 0x098u : 0x05Au; const int gcnt = wid < 2 ? 3 : 2;
#define ML_CHUNK(c, p) do { \
        if ((c) + 2 < NC) ML_LOAD((c) + 2, p); \
          \
        if (wid < 4) { \
            for (int q = 0; q < gcnt; ++q) { const int code = (int)((glist >> (4 * q)) & 0xFu); const int it = code >> 2, jt = code & 3, i = 16 * it + fr; \
                f32x4 acc = (f32x4){0.f, 0.f, 0.f, 0.f}; \
                _Pragma("unroll") for (int ks = 0; ks < 4; ++ks) { const bf16x8 A = *(const LAS bf16x8*)(lds + KS + (16 * jt + fr) * 272 + (32 * ks + 8 * fq) * 2); const bf16x8 B = *(const LAS bf16x8*)(lds + QS + (p) * QS_SZ + (16 * it + fr) * 272 + (32 * ks + 8 * fq) * 2); acc = mfma16(A, B, acc); } \
                const float bi = *(const LAS float*)(lds + BB + (p) * 256 + i * 4); const f32x4 aj = *(const LAS f32x4*)(lds + AA + (p) * 256 + (16 * jt + 4 * fq) * 4); \
                float v[4]; _Pragma("unroll") for (int r = 0; r < 4; ++r) { const int j = 16 * jt + 4 * fq + r; v[r] = (j <= i) ? acc[r] * scale * __expf(bi + aj[r]) : 0.f; } \
                u32x2 w; w.x = cvt_pk_bf16(v[0], v[1]); w.y = cvt_pk_bf16(v[2], v[3]); *(LAS u32x2*)(lds + SS + i * 144 + (16 * jt + 4 * fq) * 2) = w; } \
            if (wid == 2) *(LAS u32x2*)(lds + SS + fr * 144 + (16 + 4 * fq) * 2) = (u32x2){0u, 0u}; \
            if (wid == 3) *(LAS u32x2*)(lds + SS + (32 + fr) * 144 + (48 + 4 * fq) * 2) = (u32x2){0u, 0u}; \
        } else { \
            const int x = wid - 4; const float eg = __expf(*(const LAS float*)(lds + GG + (p) * 16)); \
            bf16x8 Af[2][2], Bf[2][2]; \
            _Pragma("unroll") for (int ks = 0; ks < 2; ++ks) { \
                const f32x4 w0 = *(const LAS f32x4*)(lds + WW + (p) * 256 + (32 * ks + 8 * fq) * 4), w1 = *(const LAS f32x4*)(lds + WW + (p) * 256 + (32 * ks + 8 * fq + 4) * 4); \
                _Pragma("unroll") for (int dl = 0; dl < 2; ++dl) { s16x4 lo, hi; trfrag(lds + KS, 272, 32 * ks, 16 * (2 * x + dl), fr, fq, lo, hi); \
                    u32x4 sc; sc.x = cvt_pk_bf16(bf1((bf16_t)lo[0]) * w0[0], bf1((bf16_t)lo[1]) * w0[1]); sc.y = cvt_pk_bf16(bf1((bf16_t)lo[2]) * w0[2], bf1((bf16_t)lo[3]) * w0[3]); \
                    sc.z = cvt_pk_bf16(bf1((bf16_t)hi[0]) * w1[0], bf1((bf16_t)hi[1]) * w1[1]); sc.w = cvt_pk_bf16(bf1((bf16_t)hi[2]) * w1[2], bf1((bf16_t)hi[3]) * w1[3]); \
                    Af[dl][ks] = __builtin_bit_cast(bf16x8, sc); } \
                _Pragma("unroll") for (int dv = 0; dv < 2; ++dv) { s16x4 lo, hi; trfrag(lds + VS + (p) * VS_SZ, 80, 32 * ks, 16 * dv, fr, fq, lo, hi); Bf[dv][ks] = (bf16x8){lo[0], lo[1], lo[2], lo[3], hi[0], hi[1], hi[2], hi[3]}; } } \
            _Pragma("unroll") for (int dl = 0; dl < 2; ++dl) { \
                _Pragma("unroll") for (int dv = 0; dv < 2; ++dv) { f32x4 cacc = Creg[dl][dv] * eg; cacc = mfma16(Af[dl][0], Bf[dv][0], cacc); cacc = mfma16(Af[dl][1], Bf[dv][1], cacc); Creg[dl][dv] = cacc; \
                    u32x2 w; w.x = cvt_pk_bf16(cacc[0], cacc[1]); w.y = cvt_pk_bf16(cacc[2], cacc[3]); \
                    *(LAS u32x2*)(lds + CT + ((p) ^ 1) * CT_SZ + (16 * dv + fr) * 272 + (16 * (2 * x + dl) + 4 * fq) * 2) = w; } \
                f32x4 nacc = nreg[dl] * eg; nacc = mfma16(Af[dl][0], ONES, nacc); nacc = mfma16(Af[dl][1], ONES, nacc); nreg[dl] = nacc; \
                if (fr == 0) { u32x2 w; w.x = cvt_pk_bf16(nacc[0], nacc[1]); w.y = cvt_pk_bf16(nacc[2], nacc[3]); *(LAS u32x2*)(lds + NB + ((p) ^ 1) * 256 + (16 * (2 * x + dl) + 4 * fq) * 2) = w; } } \
        } \
        WG_BAR(); \
          \
        { const int it = wid >> 1, dv = wid & 1; \
          f32x4 h1 = (f32x4){0.f, 0.f, 0.f, 0.f}, h2 = h1, rs = h1, qn = h1; \
          for (int ks = 0; ks <= (it >> 1); ++ks) { const bf16x8 A = *(const LAS bf16x8*)(lds + SS + (16 * it + fr) * 144 + (32 * ks + 8 * fq) * 2); s16x4 lo, hi; trfrag(lds + VS + (p) * VS_SZ, 80, 32 * ks, 16 * dv, fr, fq, lo, hi); \
              const bf16x8 B = (bf16x8){lo[0], lo[1], lo[2], lo[3], hi[0], hi[1], hi[2], hi[3]}; h1 = mfma16(A, B, h1); rs = mfma16(A, ONES, rs); } \
          _Pragma("unroll") for (int ks = 0; ks < 4; ++ks) { const bf16x8 A = *(const LAS bf16x8*)(lds + QS + (p) * QS_SZ + (16 * it + fr) * 272 + (32 * ks + 8 * fq) * 2); const bf16x8 B = *(const LAS bf16x8*)(lds + CT + (p) * CT_SZ + (16 * dv + fr) * 272 + (32 * ks + 8 * fq) * 2); \
              const bf16x8 Bn = *(const LAS bf16x8*)(lds + NB + (p) * 256 + (32 * ks + 8 * fq) * 2); h2 = mfma16(A, B, h2); qn = mfma16(A, Bn, qn); } \
          const f32x4 bi = *(const LAS f32x4*)(lds + BB + (p) * 256 + (16 * it + 4 * fq) * 4); \
          bf16_t* orow = HML + (row0 + (size_t)(c) * 64 + 16 * it + 4 * fq) * D + h * 256 + 32 * sl + 16 * dv + fr; \
          _Pragma("unroll") for (int r = 0; r < 4; ++r) { const float eb = __expf(bi[r]) * scale; const float num = h1[r] + eb * h2[r], den = rs[r] + eb * qn[r]; const float hv = num / fmaxf(fabsf(den), 1.0f); \
              orow[(size_t)r * D] = (bf16_t)(cvt_pk_bf16(hv, 0.f) & 0xffffu); } } \
        if ((c) + 1 < NC) ML_STORE((p) ^ 1, (p) ^ 1); \
        WG_BAR(); } while (0)
    for (int c = 0; c < NC; c += 2) { ML_CHUNK(c, 0); ML_CHUNK(c + 1, 1); }
#undef ML_CHUNK
#undef ML_LOAD
#undef ML_STORE
}
}

namespace swa {
constexpr int KSO = 0, VSO = 256 * 144, WSF = 2 * 256 * 144, SWA_END = WSF + 8 * 256;
static_assert(SWA_END <= RING_BYTES, "SWA LDS");
__device__ __forceinline__ int crow(int r, int hi) { return (r & 3) + 8 * (r >> 2) + 4 * hi; }
typedef short v4i16_t __attribute__((ext_vector_type(4)));
__device__ __forceinline__ s16x4 vtr(const LAS unsigned char* p) { return __builtin_bit_cast(s16x4, __builtin_amdgcn_ds_read_tr16_b64_v4i16((LAS v4i16_t*)p)); }

__device__ __forceinline__ void swa_unit(LAS unsigned char* lds, const bf16_t* PROJ, bf16_t* ASW, const float* wq, const float* wk, const float* sinks, int b, int nb, int kvh) {
    const int tid = threadIdx.x, lane = tid & 63, wid = __builtin_amdgcn_readfirstlane(tid >> 6), r32 = lane & 31, hi = lane >> 5;
    const size_t rowbase = (size_t)b * SEQ + (size_t)nb * 128;
#pragma unroll
    for (int u = 0; u < 4; ++u) {
        const int id = tid + 512 * u, row = id >> 3, ch = id & 7; const bool valid = (nb > 0) || (row >= 128);
        u32x4 kw = (u32x4){0u, 0u, 0u, 0u}, vw = (u32x4){0u, 0u, 0u, 0u};
        if (valid) { const bf16_t* rp = PROJ + (rowbase - 128 + row) * NPROJ; kw = *(const u32x4*)(rp + C_SWK + kvh * 64 + 8 * ch); vw = *(const u32x4*)(rp + C_SWV + kvh * 64 + 8 * ch); }
        f32x4 k0, k1; pg8::unpack8(kw, k0, k1);
        float ss = (k0[0] * k0[0] + k0[1] * k0[1]) + (k0[2] * k0[2] + k0[3] * k0[3]) + (k1[0] * k1[0] + k1[1] * k1[1]) + (k1[2] * k1[2] + k1[3] * k1[3]);
        ss += __shfl_xor(ss, 1); ss += __shfl_xor(ss, 2); ss += __shfl_xor(ss, 4);
        const float r = 1.0f / sqrtf(ss * (1.f / 64.f) + EPS);
        const f32x4 w0 = *(const f32x4*)(wk + 8 * ch), w1 = *(const f32x4*)(wk + 8 * ch + 4);
        *(LAS u32x4*)(lds + KSO + row * 144 + ch * 16) = pg8::pack8(k0 * r * w0, k1 * r * w1);
        *(LAS u32x4*)(lds + VSO + row * 144 + ch * 16) = vw;
    }
    WG_BAR();
    const int hd = kvh * 8 + wid;
    const float slope = exp2f(-(float)(hd + 1) * 0.25f) * LOG2E, sinkl = sinks[hd] * LOG2E;
    LAS float* wsf = (LAS float*)(lds + WSF + wid * 256);
    for (int qt = 0; qt < 4; ++qt) {
        bf16x8 qf[4];
        { const bf16_t* qp = PROJ + (rowbase + 32 * qt + r32) * NPROJ + C_SWQ + hd * 64 + 8 * hi; f32x4 q0[4], q1[4]; float ss = 0.f;
#pragma unroll
          for (int ds = 0; ds < 4; ++ds) { const u32x4 w = *(const u32x4*)(qp + 16 * ds); pg8::unpack8(w, q0[ds], q1[ds]);
              ss += (q0[ds][0] * q0[ds][0] + q0[ds][1] * q0[ds][1]) + (q0[ds][2] * q0[ds][2] + q0[ds][3] * q0[ds][3]) + (q1[ds][0] * q1[ds][0] + q1[ds][1] * q1[ds][1]) + (q1[ds][2] * q1[ds][2] + q1[ds][3] * q1[ds][3]); }
          ss += __shfl_xor(ss, 32);
          const float r = (1.0f / sqrtf(ss * (1.f / 64.f) + EPS)) * 0.125f * LOG2E;
#pragma unroll
          for (int ds = 0; ds < 4; ++ds) { const f32x4 w0 = *(const f32x4*)(wq + 16 * ds + 8 * hi), w1 = *(const f32x4*)(wq + 16 * ds + 8 * hi + 4); qf[ds] = __builtin_bit_cast(bf16x8, pg8::pack8(q0[ds] * r * w0, q1[ds] * r * w1)); } }
        f32x16 s[5];
#pragma unroll
        for (int kk = 0; kk < 5; ++kk) { const int kt = qt + kk; f32x16 a = {};
#pragma unroll
            for (int ds = 0; ds < 4; ++ds) { const bf16x8 A = *(const LAS bf16x8*)(lds + KSO + (32 * kt + r32) * 144 + (16 * ds + 8 * hi) * 2); a = __builtin_amdgcn_mfma_f32_32x32x16_bf16(A, qf[ds], a, 0, 0, 0); }
            s[kk] = a; __builtin_amdgcn_sched_barrier(0); }
        int dbase = 128 + r32 - 4 * hi; asm volatile("" : "+v"(dbase));
        const float fbase = (float)dbase; const int jlim = ((nb > 0) ? 0 : 128) - 32 * qt - 4 * hi;
        float m = sinkl;
#pragma unroll
        for (int kk = 0; kk < 5; ++kk)
#pragma unroll
            for (int r = 0; r < 16; ++r) { const int ckr = 32 * kk + (r & 3) + 8 * (r >> 2); const int dist = dbase - ckr; const bool valid = ((unsigned)dist < 128u) && (ckr >= jlim);
                const float v = valid ? s[kk][r] - slope * (fbase - (float)ckr) : -INFINITY; s[kk][r] = v; m = fmaxf(m, v); }
        m = fmaxf(m, __shfl_xor(m, 32));
        float l = 0.f;
#pragma unroll
        for (int kk = 0; kk < 5; ++kk)
#pragma unroll
            for (int r = 0; r < 16; ++r) { const float p = exp2f(s[kk][r] - m); s[kk][r] = p; l += p; }
        l += __shfl_xor(l, 32);
        l += exp2f(sinkl - m);
        if (hi == 0) wsf[r32] = 1.0f / l;
        f32x16 o[2]; o[0] = (f32x16){}; o[1] = (f32x16){};
#pragma unroll
        for (int kk = 0; kk < 5; ++kk) { const int kt = qt + kk;
#pragma unroll
            for (int s2 = 0; s2 < 2; ++s2) {
                u32x4 pw; pw.x = cvt_pk_bf16(s[kk][8 * s2 + 0], s[kk][8 * s2 + 1]); pw.y = cvt_pk_bf16(s[kk][8 * s2 + 2], s[kk][8 * s2 + 3]); pw.z = cvt_pk_bf16(s[kk][8 * s2 + 4], s[kk][8 * s2 + 5]); pw.w = cvt_pk_bf16(s[kk][8 * s2 + 6], s[kk][8 * s2 + 7]);
                const bf16x8 pa = __builtin_bit_cast(bf16x8, pw);
                const int key = 32 * kt + 16 * s2 + 4 * hi + ((lane & 15) >> 2);
#pragma unroll
                for (int d0 = 0; d0 < 2; ++d0) { const LAS unsigned char* vp = lds + VSO + key * 144 + (32 * d0 + 16 * ((lane >> 4) & 1) + 4 * (lane & 3)) * 2;
                    const s16x4 lo = vtr(vp), hh = vtr(vp + 8 * 144);
                    const bf16x8 B = (bf16x8){lo[0], lo[1], lo[2], lo[3], hh[0], hh[1], hh[2], hh[3]};
                    o[d0] = __builtin_amdgcn_mfma_f32_32x32x16_bf16(pa, B, o[d0], 0, 0, 0); }
                __builtin_amdgcn_sched_barrier(0); } }
        LDS_WAIT();
#pragma unroll
        for (int r = 0; r < 16; ++r) { const float rl = wsf[crow(r, hi)]; bf16_t* op = ASW + (rowbase + 32 * qt + crow(r, hi)) * D + hd * 64 + r32;
            op[0] = (bf16_t)(cvt_pk_bf16(o[0][r] * rl, 0.f) & 0xffffu); op[32] = (bf16_t)(cvt_pk_bf16(o[1][r] * rl, 0.f) & 0xffffu); }
    }
    WG_BAR();
}
}

namespace moe {
using pg8::Unit; using pg8::BM; using pg8::HALF;
struct Tables { const LAS int* tstart; const LAS int* cnt; const LAS int* tile_e; };
__device__ __forceinline__ int build_tables(LAS unsigned char* tab, const unsigned* cur) {
    LAS int* tstart = (LAS int*)tab; LAS int* cnt = (LAS int*)(tab + 256); LAS int* tile_e = (LAS int*)(tab + 512);
    const int tid = threadIdx.x;
    if (tid < NE) cnt[tid] = (int)__hip_atomic_load(cur + 64 * tid, RLX_AGENT);
    __syncthreads();
    if (tid == 0) { int s = 0; for (int e = 0; e < NE; ++e) { tstart[e] = s; s += (cnt[e] + 255) >> 8; } tstart[NE] = s; }
    __syncthreads();
    const int nrt = tstart[NE];
    for (int t = tid; t < nrt; t += 512) { int e = 0; for (int k = 1; k < NE; ++k) if (tstart[k] <= t) e = k; tile_e[t] = e; }
    __syncthreads();
    return nrt;
}
struct UpSched {
    static constexpr bool GATHER = true;
    const void* A; const void* Bt; const int* tokl; Tables tb; int nrt, nN, G, c;
    __device__ __forceinline__ bool next(int i, Unit& u) const { const long L = (long)i * G + c; if (L >= (long)nrt * nN) return false; pg8::map_unit((int)L, nrt, nN, u.pm, u.pn); u.e = tb.tile_e[u.pm]; u.r0 = (u.pm - tb.tstart[u.e]) * BM; u.cnt = tb.cnt[u.e]; return true; }
    __device__ __forceinline__ const char* a_base() const { return (const char*)A; }
    __device__ __forceinline__ void a_offs(const Unit& u, const int (&R)[2], const int (&C)[2], int K, unsigned (&vo)[2][2]) const {
#pragma unroll
        for (int h = 0; h < 2; ++h)
#pragma unroll
            for (int i = 0; i < 2; ++i) { const int rl = u.r0 + h * HALF + R[i]; const int tok = rl < u.cnt ? tokl[(size_t)u.e * CAP + rl] : 0; vo[h][i] = (unsigned)tok * (unsigned)K + (unsigned)C[i] * 2u; }
    }
    __device__ __forceinline__ const char* a_tile(const Unit&, int) const { return (const char*)A; }
    __device__ __forceinline__ const char* b_tile(const Unit& u, int K) const { return (const char*)Bt + ((size_t)u.e * 2 * DFF + (size_t)u.pn * BM) * K; }
};
struct DownSched {
    static constexpr bool GATHER = false;
    const bf16_t* A; const bf16_t* Bt; Tables tb; int nrt, nN, G, c;
    __device__ __forceinline__ bool next(int i, Unit& u) const { const long L = (long)i * G + c; if (L >= (long)nrt * nN) return false; pg8::map_unit((int)L, nrt, nN, u.pm, u.pn); u.e = tb.tile_e[u.pm]; u.r0 = (u.pm - tb.tstart[u.e]) * BM; u.cnt = tb.cnt[u.e]; return true; }
    __device__ __forceinline__ const char* a_base() const { return (const char*)A; }
    __device__ __forceinline__ void a_offs(const Unit& u, const int (&R)[2], const int (&C)[2], int K, unsigned (&vo)[2][2]) const {
#pragma unroll
        for (int h = 0; h < 2; ++h)
#pragma unroll
            for (int i = 0; i < 2; ++i) vo[h][i] = (unsigned)(u.pm * BM + h * HALF + R[i]) * (unsigned)K + (unsigned)C[i] * 2u;
    }
    __device__ __forceinline__ const char* a_tile(const Unit& u, int K) const { return (const char*)A + (size_t)u.pm * BM * K; }
    __device__ __forceinline__ const char* b_tile(const Unit& u, int K) const { return (const char*)Bt + ((size_t)u.e * D + (size_t)u.pn * BM) * K; }
};
struct EpiUp {
    static constexpr bool PERM = true, I8 = true;
    bf16_t* ACT; const float* bup; const float* rsl; const float* swup;
    __device__ __forceinline__ void operator()(const i32x4 (&acc)[2][2][4][2], const Unit& u, int wr, int wc, int fr, int fq) const {
        const int oc = u.pn * HALF + wc * 32 + 8 * fq;
        const float* bg = bup + (size_t)u.e * 2 * DFF + oc; const float* bl = bg + DFF;
        const float* sg = swup + (size_t)u.e * 2 * DFF + oc; const float* sl = sg + DFF;
        const f32x4 bg0 = *(const f32x4*)bg, bg1 = *(const f32x4*)(bg + 4), bl0 = *(const f32x4*)bl, bl1 = *(const f32x4*)(bl + 4);
        const f32x4 sg0 = *(const f32x4*)sg, sg1 = *(const f32x4*)(sg + 4), sl0 = *(const f32x4*)sl, sl1 = *(const f32x4*)(sl + 4);
#pragma unroll
        for (int ai = 0; ai < 2; ++ai)
#pragma unroll
            for (int m = 0; m < 4; ++m) { const int rt = ai * HALF + wr * 64 + m * 16 + fr; const int rl = u.r0 + rt; const float rs = rl < u.cnt ? rsl[(size_t)u.e * CAP + rl] : 0.f;
                f32x4 o[2];
#pragma unroll
                for (int n = 0; n < 2; ++n) { const f32x4 ag = __builtin_convertvector(acc[ai][0][m][n], f32x4), al = __builtin_convertvector(acc[ai][1][m][n], f32x4);
                    const f32x4 g = ag * rs * (n ? sg1 : sg0) + (n ? bg1 : bg0), l = al * rs * (n ? sl1 : sl0) + (n ? bl1 : bl0);
#pragma unroll
                    for (int j = 0; j < 4; ++j) { const float gg = fminf(g[j], 7.0f), ll = fminf(fmaxf(l[j], -7.0f), 7.0f); o[n][j] = gg * sigmoidf_(1.702f * gg) * (ll + 1.0f); } }
                *(u32x4*)(ACT + (size_t)(u.pm * BM + rt) * DFF + oc) = pg8::pack8(o[0], o[1]); }
    }
};
struct EpiDown {
    static constexpr bool PERM = true, I8 = false;
    bf16_t* YS; const float* bdn; const float* gatel; const int* destl;
    __device__ __forceinline__ void operator()(const f32x4 (&acc)[2][2][4][2], const Unit& u, int wr, int wc, int fr, int fq) const {
        const int col0 = u.pn * BM + wc * 32 + 8 * fq;
        f32x4 bv[2][2];
#pragma unroll
        for (int bj = 0; bj < 2; ++bj)
#pragma unroll
            for (int n = 0; n < 2; ++n) bv[bj][n] = *(const f32x4*)(bdn + (size_t)u.e * D + col0 + bj * HALF + 4 * n);
#pragma unroll
        for (int ai = 0; ai < 2; ++ai)
#pragma unroll
            for (int m = 0; m < 4; ++m) { const int rl = u.r0 + ai * HALF + wr * 64 + m * 16 + fr;
                if (rl < u.cnt) { const float g = gatel[(size_t)u.e * CAP + rl]; const int dest = destl[(size_t)u.e * CAP + rl];
#pragma unroll
                    for (int bj = 0; bj < 2; ++bj) *(u32x4*)(YS + (size_t)dest * D + col0 + bj * HALF) = pg8::pack8((acc[ai][bj][m][0] + bv[bj][0]) * g, (acc[ai][bj][m][1] + bv[bj][1]) * g); } }
    }
};
}

__device__ __forceinline__ void ml_norm_rows(Frame& F, const Args& a) {
    const int gw = F.vcu * NWAVES + F.wave, NGW = F.G * NWAVES, lane = F.lane;
    bf16_t* HML = (bf16_t*)(F.ws + WS_HML); const bf16_t* PROJ = (const bf16_t*)(F.ws + WS_PROJ); const float* nw = a.in[6];
    for (int m = gw; m < T; m += NGW) {
        bf16_t* hr = HML + (size_t)m * D; const bf16_t* orow = PROJ + (size_t)m * NPROJ + C_MLO;
#pragma unroll
        for (int j = 0; j < 4; ++j) { const int c0 = 512 * j + 8 * lane;
            const u32x4 hw = *(const u32x4*)(hr + c0), ow = *(const u32x4*)(orow + c0); f32x4 h0, h1, o0, o1; pg8::unpack8(hw, h0, h1); pg8::unpack8(ow, o0, o1);
            float ss = (h0[0] * h0[0] + h0[1] * h0[1]) + (h0[2] * h0[2] + h0[3] * h0[3]) + (h1[0] * h1[0] + h1[1] * h1[1]) + (h1[2] * h1[2] + h1[3] * h1[3]);
#pragma unroll
            for (int o = 1; o < 32; o <<= 1) ss += __shfl_xor(ss, o);
            const float r = 1.0f / sqrtf(ss * (1.f / 256.f) + EPS);
            const f32x4 w0 = *(const f32x4*)(nw + c0), w1 = *(const f32x4*)(nw + c0 + 4);
            *(u32x4*)(hr + c0) = pg8::pack8(h0 * r * w0 * pg8::sig4(o0), h1 * r * w1 * pg8::sig4(o1)); }
    }
}

__device__ __forceinline__ void route_phase(Frame& F, const Args& a) {
    LAS unsigned char* lds = F.lds;
    LAS float* w2s = (LAS float*)(lds);
    LAS float* lg = (LAS float*)(lds + 8192);
    LAS float* rsd = (LAS float*)(lds + 8192 + 8 * 16 * 33 * 4);
    LAS float* rsd2 = rsd + 128;
    LAS int* sel_e = (LAS int*)(lds + 32768);
    LAS float* sel_g = (LAS float*)(lds + 32768 + 2048);
    LAS int* hist = (LAS int*)(lds + 32768 + 4096);
    LAS int* basep = (LAS int*)(lds + 32768 + 4096 + 128);
    const int tid = F.tid, lane = F.lane, wid = F.wave, c16 = lane & 15, kq = lane >> 4;
    const float* h1 = a.out; const float* w2 = a.in[13]; const float* br = a.in[15]; const float* wrp = (const float*)(F.ws + WS_WRP);
    signed char* XQ = (signed char*)(F.ws + WS_XN);
    int* tokl = (int*)(F.ws + WS_TOKL); float* gatel = (float*)(F.ws + WS_GATEL); int* destl = (int*)(F.ws + WS_DESTL); float* rsl = (float*)(F.ws + WS_RSL);
    unsigned* cur = F.ctl + CW_CUR;
    for (int i = tid; i < D; i += 512) w2s[i] = w2[i];
    __syncthreads();
    for (int tb = blockIdx.x; tb < T / 128; tb += F.G) {
        if (tid < NE) hist[tid] = 0;
        const int row0 = tb * 128 + wid * 16;
        const float* xr = h1 + (size_t)(row0 + c16) * D + 4 * kq; signed char* xo = XQ + (size_t)(row0 + c16) * D + 4 * kq;
        f32x4 acc0 = (f32x4){0.f, 0.f, 0.f, 0.f}, acc1 = (f32x4){0.f, 0.f, 0.f, 0.f}; float ss = 0.f, amax = 0.f;
#pragma unroll 4
        for (int s = 0; s < 128; ++s) {
            const f32x4 xv = *(const f32x4*)(xr + 16 * s); const f32x4 wv = *(const LAS f32x4*)(w2s + 16 * s + 4 * kq);
            const f32x4 b0 = *(const f32x4*)(wrp + ((size_t)s * 64 + lane) * 8), b1 = *(const f32x4*)(wrp + ((size_t)s * 64 + lane) * 8 + 4);
            ss += (xv[0] * xv[0] + xv[1] * xv[1]) + (xv[2] * xv[2] + xv[3] * xv[3]);
            const f32x4 xw = xv * wv;
            amax = fmaxf(fmaxf(amax, fmaxf(fabsf(xw[0]), fabsf(xw[1]))), fmaxf(fabsf(xw[2]), fabsf(xw[3])));
#pragma unroll
            for (int j = 0; j < 4; ++j) { acc0 = __builtin_amdgcn_mfma_f32_16x16x4f32(xw[j], b0[j], acc0, 0, 0, 0); acc1 = __builtin_amdgcn_mfma_f32_16x16x4f32(xw[j], b1[j], acc1, 0, 0, 0); }
        }
        ss += __shfl_xor(ss, 16); ss += __shfl_xor(ss, 32);
        amax = fmaxf(amax, __shfl_xor(amax, 16)); amax = fmaxf(amax, __shfl_xor(amax, 32)); amax = fmaxf(amax, 1e-30f);
        const float rstd = 1.0f / sqrtf(ss * (1.f / D) + EPS);
        if (kq == 0) { rsd[wid * 16 + c16] = rstd * amax * (1.0f / 127.0f); rsd2[wid * 16 + c16] = rstd; }
        { const float qs = 127.0f / amax;
#pragma unroll 4
          for (int s = 0; s < 128; ++s) { const f32x4 xv = *(const f32x4*)(xr + 16 * s); const f32x4 wv = *(const LAS f32x4*)(w2s + 16 * s + 4 * kq); const f32x4 xw = xv * wv * qs;
              const unsigned pk = ((unsigned)__float2int_rn(xw[0]) & 0xffu) | (((unsigned)__float2int_rn(xw[1]) & 0xffu) << 8) | (((unsigned)__float2int_rn(xw[2]) & 0xffu) << 16) | (((unsigned)__float2int_rn(xw[3]) & 0xffu) << 24);
              *(unsigned*)(xo + 16 * s) = pk; } }
        LDS_WAIT();
        { const float bb0 = br[c16], bb1 = br[c16 + 16];
#pragma unroll
          for (int r = 0; r < 4; ++r) { const float rr = rsd2[wid * 16 + 4 * kq + r]; lg[(wid * 16 + 4 * kq + r) * 33 + c16] = acc0[r] * rr + bb0; lg[(wid * 16 + 4 * kq + r) * 33 + c16 + 16] = acc1[r] * rr + bb1; } }
        LDS_WAIT();
        if (lane < 16) {
            const LAS float* lr = lg + (wid * 16 + lane) * 33; unsigned taken = 0u; float tv[4]; int te[4];
#pragma unroll
            for (int k = 0; k < 4; ++k) { float best = -INFINITY; int bi = 0;
                for (int e = 0; e < NE; ++e) { const float v = lr[e]; const bool ok = !((taken >> e) & 1u) && (v > best); best = ok ? v : best; bi = ok ? e : bi; }
                taken |= 1u << bi; tv[k] = best; te[k] = bi; }
            float ex[4], sum = 0.f;
#pragma unroll
            for (int k = 0; k < 4; ++k) { ex[k] = __expf(tv[k] - tv[0]); sum += ex[k]; }
            const float inv = 1.0f / sum;
#pragma unroll
            for (int k = 0; k < 4; ++k) { sel_e[(wid * 16 + lane) * 4 + k] = te[k]; sel_g[(wid * 16 + lane) * 4 + k] = ex[k] * inv; }
        }
        __syncthreads();
        const int prow = wid * 16 + (lane >> 2), pk = lane & 3;
        const int pe = sel_e[prow * 4 + pk]; const float pg = sel_g[prow * 4 + pk];
        const int lr_ = __hip_atomic_fetch_add(hist + pe, 1, __ATOMIC_RELAXED, __HIP_MEMORY_SCOPE_WORKGROUP);
        __syncthreads();
        if (tid < NE) basep[tid] = (int)__hip_atomic_fetch_add(cur + 64 * tid, (unsigned)hist[tid], RLX_AGENT);
        __syncthreads();
        { const int pos = basep[pe] + lr_; const int token = tb * 128 + prow; const size_t li = (size_t)pe * CAP + pos;
          tokl[li] = token; gatel[li] = pg; destl[li] = token * 4 + pk; rsl[li] = rsd[prow]; }
        __syncthreads();
    }
}

__device__ __forceinline__ void combine_rows(Frame& F, const Args& a) {
    const int gw = F.vcu * NWAVES + F.wave, NGW = F.G * NWAVES, lane = F.lane;
    float* out = a.out; const bf16_t* YS = (const bf16_t*)(F.ws + WS_YS); bf16_t* XN = (bf16_t*)(F.ws + WS_XN); const float* w3 = a.in[20];
    for (int m = gw; m < T; m += NGW) {
        float* hr = out + (size_t)m * D; f32x4 v[4][2]; float s = 0.f;
#pragma unroll
        for (int j = 0; j < 4; ++j) { const int c0 = 512 * j + 8 * lane; v[j][0] = *(const f32x4*)(hr + c0); v[j][1] = *(const f32x4*)(hr + c0 + 4);
#pragma unroll
            for (int k = 0; k < 4; ++k) { const u32x4 yw = *(const u32x4*)(YS + ((size_t)m * 4 + k) * D + c0); f32x4 y0, y1; pg8::unpack8(yw, y0, y1); v[j][0] += y0; v[j][1] += y1; }
            *(f32x4*)(hr + c0) = v[j][0]; *(f32x4*)(hr + c0 + 4) = v[j][1];
#pragma unroll
            for (int q = 0; q < 2; ++q) s += (v[j][q].x * v[j][q].x + v[j][q].y * v[j][q].y) + (v[j][q].z * v[j][q].z + v[j][q].w * v[j][q].w); }
        const float rstd = 1.0f / sqrtf(wave_sum(s) * (1.f / D) + EPS);
#pragma unroll
        for (int j = 0; j < 4; ++j) { const int c0 = 512 * j + 8 * lane; const f32x4 w0 = *(const f32x4*)(w3 + c0), w1 = *(const f32x4*)(w3 + c0 + 4);
            *(u32x4*)(XN + (size_t)m * D + c0) = pg8::pack8(v[j][0] * rstd * w0, v[j][1] * rstd * w1); }
    }
}

__device__ __forceinline__ void ph_gemm1(Frame& F, const Args& a) {
    pg8::DenseSched S{(const bf16_t*)(F.ws + WS_XN), (const bf16_t*)(F.ws + WS_WIN), T / 256, NPROJ / 256, F.G, (int)blockIdx.x}; pg8::EpiProjI8 E{(bf16_t*)(F.ws + WS_PROJ), NPROJ, (const float*)(F.ws + WS_SA1), (const float*)(F.ws + WS_SWIN)}; pg8::gemm_phase(F.lds, D, S, E); }
__device__ __forceinline__ void ph_mlstm(Frame& F, const Args& a) {
    for (int u = F.vcu; u < 256; u += F.G) ml::mlstm_unit(F.lds, (const bf16_t*)(F.ws + WS_PROJ), (bf16_t*)(F.ws + WS_HML), (float*)(F.ws + WS_GATES) + (size_t)u * ml::NC * 256, a.in[4], a.in[5], u >> 6, (u >> 3) & 7, u & 7); }
__device__ __forceinline__ void ph_norm_swa(Frame& F, const Args& a) {
    ml_norm_rows(F, a);
    for (int u = F.vcu; u < 1024; u += F.G) swa::swa_unit(F.lds, (const bf16_t*)(F.ws + WS_PROJ), (bf16_t*)(F.ws + WS_ASW), a.in[7], a.in[8], a.in[9], u >> 8, (u >> 2) & 63, u & 3); }
__device__ __forceinline__ void ph_ya(Frame& F, const Args& a) {
    pg8::DenseSched S{(const bf16_t*)(F.ws + WS_HML), (const bf16_t*)(F.ws + WS_WA), T / 256, D / 256, F.G, (int)blockIdx.x}; pg8::EpiGate<false> E{(bf16_t*)(F.ws + WS_YA), (const bf16_t*)(F.ws + WS_PROJ) + C_GA, NPROJ, nullptr}; pg8::gemm_phase(F.lds, D * 2, S, E); }
__device__ __forceinline__ void ph_mix(Frame& F, const Args& a) {
    pg8::DenseSched S{(const bf16_t*)(F.ws + WS_ASW), (const bf16_t*)(F.ws + WS_WB), T / 256, D / 256, F.G, (int)blockIdx.x}; pg8::EpiGate<true> E{(bf16_t*)(F.ws + WS_MIX), (const bf16_t*)(F.ws + WS_PROJ) + C_GB, NPROJ, (const bf16_t*)(F.ws + WS_YA)}; pg8::gemm_phase(F.lds, D * 2, S, E); }
__device__ __forceinline__ void ph_h1(Frame& F, const Args& a) {
    pg8::DenseSched S{(const bf16_t*)(F.ws + WS_MIX), (const bf16_t*)(F.ws + WS_WOUT), T / 256, D / 256, F.G, (int)blockIdx.x}; pg8::EpiResF32 E{a.in[0], a.out}; pg8::gemm_phase(F.lds, D * 2, S, E); }
__device__ __forceinline__ void ph_up(Frame& F, const Args& a) {
    const int nrt = moe::build_tables(F.lds + TAB_OFF, F.ctl + CW_CUR);
    moe::Tables tb{(const LAS int*)(F.lds + TAB_OFF), (const LAS int*)(F.lds + TAB_OFF + 256), (const LAS int*)(F.lds + TAB_OFF + 512)};
    moe::UpSched S{(const void*)(F.ws + WS_XN), (const void*)(F.ws + WS_WUP), (const int*)(F.ws + WS_TOKL), tb, nrt, 2 * DFF / 256, F.G, (int)blockIdx.x}; moe::EpiUp E{(bf16_t*)(F.ws + WS_ACT), a.in[17], (const float*)(F.ws + WS_RSL), (const float*)(F.ws + WS_SWUP)}; pg8::gemm_phase(F.lds, D, S, E); }
__device__ __forceinline__ void ph_down(Frame& F, const Args& a) {
    const int nrt = moe::build_tables(F.lds + TAB_OFF, F.ctl + CW_CUR);
    moe::Tables tb{(const LAS int*)(F.lds + TAB_OFF), (const LAS int*)(F.lds + TAB_OFF + 256), (const LAS int*)(F.lds + TAB_OFF + 512)};
    moe::DownSched S{(const bf16_t*)(F.ws + WS_ACT), (const bf16_t*)(F.ws + WS_WDN), tb, nrt, D / 256, F.G, (int)blockIdx.x}; moe::EpiDown E{(bf16_t*)(F.ws + WS_YS), a.in[19], (const float*)(F.ws + WS_GATEL), (const int*)(F.ws + WS_DESTL)}; pg8::gemm_phase(F.lds, DFF * 2, S, E); }
__device__ __forceinline__ void ph_combine_pp(Frame& F, const Args& a) {
    combine_rows(F, a);
    pg8::DenseSched S{(const bf16_t*)(F.ws + WS_PBF), (const bf16_t*)(F.ws + WS_WPP), T / 256, D / 256, F.G, (int)blockIdx.x}; pg8::EpiStoreBf16 E{(bf16_t*)(F.ws + WS_PP), D}; int kb = PLE * 2; asm volatile("" : "+s"(kb));
    pg8::gemm_phase(F.lds, kb, S, E); }
__device__ __forceinline__ void ph_out(Frame& F, const Args& a) {
    pg8::DenseSched S{(const bf16_t*)(F.ws + WS_XN), (const bf16_t*)(F.ws + WS_WPG), T / 256, D / 256, F.G, (int)blockIdx.x}; pg8::EpiPle E{a.out, (const bf16_t*)(F.ws + WS_PP)}; pg8::gemm_phase(F.lds, D * 2, S, E); }

constexpr int NPHASE = 12;
__global__ void __launch_bounds__(NWAVES * 64, 2) mk_fwd(Args args) {
    extern __shared__ __attribute__((aligned(16))) unsigned char lds_raw[];
    Frame F;
    F.lds = (LAS unsigned char*)lds_raw;
    F.tid = threadIdx.x; F.lane = F.tid & 63; F.wave = __builtin_amdgcn_readfirstlane(F.tid >> 6);
    F.G = gridDim.x; { const int bx = blockIdx.x; F.vcu = (F.G % 8 == 0) ? (bx % 8) * (F.G / 8) + bx / 8 : bx; }
    F.ws = args.ws; F.ctl = (unsigned*)(args.ws + WS_CTL);
    volatile LAS unsigned* MISC = (volatile LAS unsigned*)(F.lds + MISC_OFF);
    for (int u = F.tid; u < 64; u += NWAVES * 64) MISC[u] = 0u;
    __syncthreads();
    XcdBarrier bar; bar.bar = F.ctl + CW_BAR; bar.x = 0; bar.st = nullptr;
    if (MK_N_LAUNCHES == 1) bar = xcd_barrier_post(F.ctl + CW_BAR, MISC + 8);
    unsigned char* ws = args.ws;
    const int lo = args.ph_lo, hi = args.ph_hi;
#define IN(k) (lo <= (k) && (k) < hi)
#ifndef DUP_PHASE
#define DUP_PHASE -1
#endif
#define SEAM(k) do { if (IN(k) && IN((k) + 1)) xcd_barrier(bar); } while (0)

#define RUN(k, call) do { if (IN(k)) { call; if (DUP_PHASE == (k)) { xcd_barrier(bar); call; } } SEAM(k); } while (0)
    RUN(0, p0_prologue(F, args));
    RUN(1, ph_gemm1(F, args));
    RUN(2, ph_mlstm(F, args));
    RUN(3, ph_norm_swa(F, args));
    RUN(4, ph_ya(F, args));
    RUN(5, ph_mix(F, args));
    RUN(6, ph_h1(F, args));
    RUN(7, route_phase(F, args));
    RUN(8, ph_up(F, args));
    RUN(9, ph_down(F, args));
    RUN(10, ph_combine_pp(F, args));
    if (IN(11)) ph_out(F, args);
#undef RUN
#undef IN
#undef SEAM
}


#ifdef DBG_DUMP
__global__ void dbg_dump(const bf16_t* src, int ld, int coff, float* out) {
    for (size_t i = (size_t)blockIdx.x * blockDim.x + threadIdx.x; i < (size_t)T * D; i += (size_t)gridDim.x * blockDim.x) { const size_t r = i / D, c = i % D; out[i] = bf1(src[r * ld + coff + c]); }
}
#endif
extern "C" void kernel_launch(void* const* d_in, const int* in_sizes, int n_in, void* d_out, int out_size, void* d_ws, size_t ws_size, hipStream_t stream) {
    static int grid = 0;
    if (grid == 0) {
        if (n_in != 23 || in_sizes[0] != T * D || out_size != T * D || ws_size < WS_END) { fprintf(stderr, "kernel_launch: unexpected shapes (n_in %d, in0 %d, out %d, ws %zu; need ws >= %zu); nothing launched\n", n_in, n_in > 0 ? in_sizes[0] : -1, out_size, ws_size, (size_t)WS_END); grid = -1; return; }
        int dev = 0, cus = 0, per_cu = 0;
        if (hipGetDevice(&dev) != hipSuccess || hipDeviceGetAttribute(&cus, hipDeviceAttributeMultiprocessorCount, dev) != hipSuccess) { fprintf(stderr, "kernel_launch: device query failed\n"); grid = -1; return; }
        if (hipFuncSetAttribute((const void*)mk_fwd, hipFuncAttributeMaxDynamicSharedMemorySize, LDS_BYTES) != hipSuccess) { fprintf(stderr, "kernel_launch: hipFuncSetAttribute failed\n"); grid = -1; return; }
        if (hipOccupancyMaxActiveBlocksPerMultiprocessor(&per_cu, (const void*)mk_fwd, NWAVES * 64, LDS_BYTES) != hipSuccess || per_cu < 1) fprintf(stderr, "kernel_launch: occupancy query reports %d workgroups per CU\n", per_cu);
        (void)hipGetLastError();
        grid = cus;
    }
    if (grid < 0) return;
    if (hipMemsetAsync((char*)d_ws + WS_CTL, 0, CTL_ZERO_BYTES, stream) != hipSuccess) { fprintf(stderr, "kernel_launch: memset failed\n"); return; }
    Args a{};
    for (int i = 0; i < 23; ++i) a.in[i] = (const float*)d_in[i];
    a.out = (float*)d_out; a.ws = (unsigned char*)d_ws;
#ifndef DBG_LAST
#define DBG_LAST NPHASE
#endif
    for (int li = 0; li < MK_N_LAUNCHES && li < DBG_LAST; ++li) {
        a.ph_lo = (MK_N_LAUNCHES == 1) ? 0 : li; a.ph_hi = (MK_N_LAUNCHES == 1) ? NPHASE : li + 1;
        hipLaunchKernelGGL(mk_fwd, dim3(grid), dim3(NWAVES * 64), LDS_BYTES, stream, a);
        const hipError_t le = hipPeekAtLastError();
        if (le != hipSuccess) { fprintf(stderr, "kernel_launch: launch %d failed: %s\n", li, hipGetErrorName(le)); break; }
    }
#ifdef DBG_DUMP
    { const bf16_t* s = (const bf16_t*)((unsigned char*)d_ws + DBG_DUMP_OFF); hipLaunchKernelGGL(dbg_dump, dim3(2048), dim3(256), 0, stream, s, DBG_DUMP_LD, DBG_DUMP_COL, (float*)d_out); }
#endif
}
```

```cpp
#include <hip/hip_runtime.h>
#include <cstdio>
#include <cstdint>

#ifndef MK_N_LAUNCHES
#define MK_N_LAUNCHES 1
#endif

#define GAS __attribute__((address_space(1)))
#define LAS __attribute__((address_space(3)))
typedef unsigned short bf16_t;
typedef short bf16x8 __attribute__((ext_vector_type(8)));
typedef short s16x4 __attribute__((ext_vector_type(4)));
typedef float f32x2 __attribute__((ext_vector_type(2)));
typedef float f32x4 __attribute__((ext_vector_type(4)));
typedef float f32x16 __attribute__((ext_vector_type(16)));
typedef unsigned u32x2 __attribute__((ext_vector_type(2)));
typedef unsigned u32x4 __attribute__((ext_vector_type(4)));
typedef int i32x4 __attribute__((ext_vector_type(4)));

constexpr int BATCH = 4, SEQ = 8192, T = BATCH * SEQ, D = 2048;
constexpr int PLE = 256;
constexpr int NE = 32, TOPK = 4, DFF = 2048, CAP = T;
constexpr int NPROJ = 13056;
constexpr int C_MLQ = 0, C_MLK = 1024, C_MLV = 2048, C_MLO = 4096, C_SWQ = 6144, C_SWK = 8192, C_SWV = 8448, C_GA = 8704, C_GB = 10752, C_GI = 12800, C_GF = 12808;
constexpr int DIN = 12816;
constexpr float EPS = 1e-6f;
constexpr float LOG2E = 1.4426950408889634f;
constexpr int ACT_ROWS = 139264;

constexpr size_t MiB = 1u << 20;
constexpr size_t WS_CTL = 0, CTL_ZERO_BYTES = 1 * MiB;
constexpr size_t WS_WIN = 2 * MiB;
constexpr size_t WS_WA = 54 * MiB, WS_WB = 62 * MiB, WS_WOUT = 70 * MiB, WS_WPG = 78 * MiB, WS_WPP = 86 * MiB, WS_WRP = 87 * MiB, WS_SWUP = 88 * MiB, WS_SWIN = 89 * MiB, WS_SA1 = 90 * MiB;
constexpr size_t WS_WUP = 96 * MiB;
constexpr size_t WS_WDN = 608 * MiB;
constexpr size_t WS_XN = 864 * MiB;
constexpr size_t WS_PROJ = 992 * MiB;
constexpr size_t WS_HML = 1808 * MiB;
constexpr size_t WS_ASW = 1936 * MiB;
constexpr size_t WS_YA = 2064 * MiB, WS_MIX = 2192 * MiB;
constexpr size_t WS_PBF = 2320 * MiB;
constexpr size_t WS_PP = 2336 * MiB;
constexpr size_t WS_ACT = 2464 * MiB;
constexpr size_t WS_YS = 3008 * MiB;
constexpr size_t WS_TOKL = 3520 * MiB, WS_GATEL = 3524 * MiB, WS_DESTL = 3528 * MiB, WS_RSL = 3532 * MiB;
constexpr size_t WS_GATES = 3536 * MiB;
constexpr size_t WS_AMLQ = 3568 * MiB;
constexpr size_t WS_ACTQ = 3632 * MiB;
constexpr size_t WS_AMAX = 3904 * MiB;
constexpr size_t WS_SA3 = 3940 * MiB, WS_SAML = 3941 * MiB, WS_SAD = 3942 * MiB;
constexpr size_t WS_SWPG = 3943 * MiB, WS_SWA = WS_SWPG + 65536, WS_SWDN = WS_SWPG + 131072;
constexpr size_t WS_END = 3944 * MiB;
constexpr int CW_TMO = 0, CW_CODE = 1;
constexpr int CW_BAR = 4096;
constexpr int CW_CUR = 16384;

constexpr int RING_BYTES = 131072;
constexpr int TAB_OFF = RING_BYTES;
constexpr int MISC_OFF = RING_BYTES + 8192;
constexpr int LDS_BYTES = 147456;
constexpr int NWAVES = 8;

#define RLX_AGENT __ATOMIC_RELAXED, __HIP_MEMORY_SCOPE_AGENT
#define LDS_WAIT() asm volatile("s_waitcnt lgkmcnt(0)" ::: "memory")
#define VM_WAIT() asm volatile("s_waitcnt vmcnt(0)" ::: "memory")
#define WG_BAR() do { asm volatile("s_waitcnt lgkmcnt(0)" ::: "memory"); __builtin_amdgcn_s_barrier(); asm volatile("" ::: "memory"); } while (0)

typedef __bf16 bf16x2_t __attribute__((ext_vector_type(2)));
__device__ __forceinline__ unsigned cvt_pk_bf16(float lo, float hi) { const f32x2 v = {lo, hi}; const bf16x2_t b = __builtin_convertvector(v, bf16x2_t); return __builtin_bit_cast(unsigned, b); }
__device__ __forceinline__ float bf_lo(unsigned w) { return __uint_as_float(w << 16); }
__device__ __forceinline__ float bf_hi(unsigned w) { return __uint_as_float(w & 0xffff0000u); }
__device__ __forceinline__ float bf1(bf16_t b) { return __uint_as_float(((unsigned)b) << 16); }
__device__ __forceinline__ float sigmoidf_(float x) { return 1.0f / (1.0f + __expf(-x)); }
__device__ __forceinline__ unsigned q8x4(const f32x4 t) { return ((unsigned)__float2int_rn(t.x) & 0xffu) | (((unsigned)__float2int_rn(t.y) & 0xffu) << 8) | (((unsigned)__float2int_rn(t.z) & 0xffu) << 16) | (((unsigned)__float2int_rn(t.w) & 0xffu) << 24); }
__device__ __forceinline__ float amax4(float m, const f32x4 v) { return fmaxf(fmaxf(m, fmaxf(fabsf(v.x), fabsf(v.y))), fmaxf(fabsf(v.z), fabsf(v.w))); }
__device__ __forceinline__ float wave_max(float v) {
#pragma unroll
    for (int o = 1; o < 64; o <<= 1) v = fmaxf(v, __shfl_xor(v, o));
    return v;
}
__device__ __forceinline__ float wave_sum(float v) {
#pragma unroll
    for (int o = 1; o < 64; o <<= 1) v += __shfl_xor(v, o);
    return v;
}

namespace pg8 {
constexpr int BM = 256, BK = 64, HALF = 128, HTB = HALF * BK * 2, STAGE_BYTES = 8 * HTB, NXCD = 8, WGM = 8;
__host__ __device__ __forceinline__ int lds_byte(int r, int c) { const int st = (r >> 4) * 2 + (c >> 5), rr = r & 15, cc = c & 31, ob = rr * 64 + cc * 2; return st * 1024 + (ob ^ (((ob >> 9) & 1) << 5)); }
__host__ __device__ __forceinline__ void stage_rc(int b, int& R, int& C) { const int st = b / 1024, sb = b % 1024, swz = sb ^ (((sb >> 9) & 1) << 5); R = (st >> 1) * 16 + swz / 64; C = (st & 1) * 32 + (swz % 64) / 2; }
__host__ __device__ __forceinline__ int perm32(int rho) { const int n = rho >> 4, i = rho & 15; return 8 * (i >> 2) + 4 * n + (i & 3); }

struct Unit { int pm, pn, e, r0, cnt; };

__device__ __forceinline__ void map_unit(int L, int nM, int nN, int& pm, int& pn) {
    const int nwg = nM * nN;
    int wgid = L; { const int q = nwg / NXCD, r = nwg % NXCD, xcd = wgid % NXCD, off = wgid / NXCD; wgid = (xcd < r ? xcd * (q + 1) : r * (q + 1) + (xcd - r) * q) + off; }
    const int nig = WGM * nN, gid = wgid / nig, fm = gid * WGM, gsz = (nM - fm) < WGM ? (nM - fm) : WGM;
    pm = fm + ((wgid % nig) % gsz); pn = (wgid % nig) / gsz;
}

struct DenseSched {
    static constexpr bool GATHER = false;
    const bf16_t* A; const bf16_t* Bt; int nM, nN, G, c;
    __device__ __forceinline__ bool next(int i, Unit& u) const { const long L = (long)i * G + c; if (L >= (long)nM * nN) return false; map_unit((int)L, nM, nN, u.pm, u.pn); u.e = 0; u.r0 = 0; u.cnt = 0; return true; }
    __device__ __forceinline__ const char* a_base() const { return (const char*)A; }
    __device__ __forceinline__ void a_offs(const Unit& u, const int (&R)[2], const int (&C)[2], int Kb, unsigned (&vo)[2][2]) const {
#pragma unroll
        for (int h = 0; h < 2; ++h)
#pragma unroll
            for (int i = 0; i < 2; ++i) vo[h][i] = (unsigned)(u.pm * BM + h * HALF + R[i]) * (unsigned)Kb + (unsigned)C[i] * 2u;
    }
    __device__ __forceinline__ const char* a_tile(const Unit& u, int Kb) const { return (const char*)A + (size_t)u.pm * BM * Kb; }
    __device__ __forceinline__ const char* b_tile(const Unit& u, int Kb) const { return (const char*)Bt + (size_t)u.pn * BM * Kb; }
};
template <bool I8> struct AccSel { typedef f32x4 type; };
template <> struct AccSel<true> { typedef i32x4 type; };

template <bool I8> __device__ __forceinline__ typename AccSel<I8>::type mma1(const bf16x8 a, const bf16x8 b, const typename AccSel<I8>::type c) {
    if constexpr (I8) return __builtin_amdgcn_mfma_i32_16x16x64_i8(__builtin_bit_cast(i32x4, a), __builtin_bit_cast(i32x4, b), c, 0, 0, 0);
    else return __builtin_amdgcn_mfma_f32_16x16x32_bf16(a, b, c, 0, 0, 0);
}
template <class Epi, class Sched>
__device__ __forceinline__ void gemm_phase(LAS unsigned char* lds, const int Kb, const Sched& S, const Epi& E) {
    constexpr bool I8 = Epi::I8;
    typedef typename AccSel<I8>::type acc_t;
    const int tid = threadIdx.x, wid = __builtin_amdgcn_readfirstlane(tid >> 6), lane = tid & 63, wr = wid >> 2, wc = wid & 3, fr = lane & 15, fq = lane >> 4;
    const int K = Kb;
    const int nt = Kb / (BK * 2);
    int Rr[2], Cc[2]; unsigned voffB[2];
#pragma unroll
    for (int i = 0; i < 2; ++i) { int R, C; stage_rc(tid * 16 + i * 8192, R, C); Rr[i] = R; Cc[i] = C; const int Rb = Epi::PERM ? ((R & ~31) + perm32(R & 31)) : R; voffB[i] = (unsigned)(Rb * Kb + C * 2); }
    const size_t kstep = (size_t)(BK * 2);
    const size_t hstep = (size_t)HALF * Kb;
    const unsigned ldsw = (unsigned)wid * 1024u;
    const int aoff = lds_byte(wr * 64 + fr, fq * 8), boff = lds_byte(wc * 32 + fr, fq * 8);
#define PG8_SA(b, h) (((b) * 2 + (h)) * HTB)
#define PG8_SB(b, h) ((4 + (b) * 2 + (h)) * HTB)
#define PG8_STAGE(bufoff, gbase, voff) do { _Pragma("unroll") for (int _i = 0; _i < 2; ++_i) \
        __builtin_amdgcn_global_load_lds((const unsigned*)((const char*)(gbase) + (voff)[_i]), (LAS unsigned*)(lds + (bufoff) + ldsw + _i * 8192), 16, 0, 0); } while (0)
#define PG8_LDA(dst, b, h) do { _Pragma("unroll") for (int m = 0; m < 4; ++m) _Pragma("unroll") for (int k = 0; k < 2; ++k) dst[m][k] = *(const LAS bf16x8*)(lds + PG8_SA(b, h) + aoff + m * 2048 + k * 1024); } while (0)
#define PG8_LDB(dst, b, h) do { _Pragma("unroll") for (int n = 0; n < 2; ++n) _Pragma("unroll") for (int k = 0; k < 2; ++k) dst[n][k] = *(const LAS bf16x8*)(lds + PG8_SB(b, h) + boff + n * 2048 + k * 1024); } while (0)
#define PG8_MMA(ai, bj, At, Bt) do { __builtin_amdgcn_s_setprio(1); _Pragma("unroll") for (int m = 0; m < 4; ++m) _Pragma("unroll") for (int n = 0; n < 2; ++n) _Pragma("unroll") for (int k = 0; k < 2; ++k) \
        acc[ai][bj][m][n] = mma1<I8>(Bt[n][k], At[m][k], acc[ai][bj][m][n]); __builtin_amdgcn_s_setprio(0); } while (0)
#define PG8_WAIT_V(n) asm volatile("s_waitcnt vmcnt(" #n ")" ::: "memory")
#define PG8_WAIT_L(n) asm volatile("s_waitcnt lgkmcnt(" #n ")" ::: "memory")
#define PG8_BAR __builtin_amdgcn_s_barrier()
#define PG8_SCHED __builtin_amdgcn_sched_barrier(0)
    Unit cur, nxt; int ui = 0;
    if (!S.next(0, cur)) return;
    acc_t acc[2][2][4][2];
#pragma unroll
    for (int a = 0; a < 2; ++a)
#pragma unroll
        for (int b = 0; b < 2; ++b)
#pragma unroll
            for (int m = 0; m < 4; ++m)
#pragma unroll
                for (int n = 0; n < 2; ++n) acc[a][b][m][n] = (acc_t){0, 0, 0, 0};
    bf16x8 At[4][2], B0[2][2], B1[2][2];
    constexpr bool GA = Sched::GATHER;
    unsigned cvo[2][2], nvo[2][2];
    if constexpr (GA) S.a_offs(cur, Rr, Cc, K, cvo);
    else {
#pragma unroll
        for (int h = 0; h < 2; ++h)
#pragma unroll
            for (int i = 0; i < 2; ++i) cvo[h][i] = (unsigned)(h * HALF + Rr[i]) * (unsigned)Kb + (unsigned)Cc[i] * 2u;
    }
    const char* cA = S.a_tile(cur, K);
    const char* cB = S.b_tile(cur, K);
    PG8_STAGE(PG8_SB(0, 0), cB, voffB); PG8_STAGE(PG8_SB(0, 1), cB + hstep, voffB); PG8_STAGE(PG8_SA(0, 0), cA, cvo[0]); PG8_STAGE(PG8_SA(0, 1), cA, cvo[1]);
    if (wr == 1) PG8_BAR;
    PG8_WAIT_V(2); PG8_BAR;
    PG8_STAGE(PG8_SB(1, 0), cB + kstep, voffB); PG8_STAGE(PG8_SA(1, 0), cA + kstep, cvo[0]); PG8_STAGE(PG8_SB(1, 1), cB + hstep + kstep, voffB);
    PG8_WAIT_V(6); PG8_BAR;
    for (;;) {
        const bool has_next = S.next(ui + 1, nxt);
        const char* nB = cB; const char* nA = cA;
        if (has_next) { if constexpr (GA) S.a_offs(nxt, Rr, Cc, K, nvo); nB = S.b_tile(nxt, K); nA = S.a_tile(nxt, K); }
        else if constexpr (GA) {
#pragma unroll
            for (int h = 0; h < 2; ++h)
#pragma unroll
                for (int i = 0; i < 2; ++i) nvo[h][i] = cvo[h][i];
        }
        for (int t = 0; t < nt; t += 2) {
            const bool last = (t == nt - 2);
            const char* a1 = cA + (size_t)(t + 1) * kstep;
            const char* a2 = last ? nA : cA + (size_t)(t + 2) * kstep; const char* b2 = last ? nB : cB + (size_t)(t + 2) * kstep;
            const char* a3 = a2 + kstep; const char* b3 = b2 + kstep;
#define PG8_O2(h) (GA ? (last ? nvo[h] : cvo[h]) : cvo[h])
            PG8_LDB(B0, 0, 0); PG8_LDB(B1, 0, 1); PG8_SCHED; PG8_LDA(At, 0, 0); PG8_STAGE(PG8_SA(1, 1), a1, cvo[1]);
            PG8_WAIT_V(8); PG8_WAIT_L(0); PG8_BAR; PG8_MMA(0, 0, At, B0); PG8_MMA(0, 1, At, B1); PG8_BAR; PG8_SCHED;
            PG8_LDA(At, 0, 1); PG8_STAGE(PG8_SB(0, 0), b2, voffB); PG8_STAGE(PG8_SB(0, 1), b2 + hstep, voffB); PG8_STAGE(PG8_SA(0, 0), a2, PG8_O2(0));
            PG8_WAIT_V(8); PG8_WAIT_L(0); PG8_BAR; PG8_MMA(1, 0, At, B0); PG8_MMA(1, 1, At, B1); PG8_BAR; PG8_SCHED;
            PG8_LDB(B0, 1, 0); PG8_LDB(B1, 1, 1); PG8_SCHED; PG8_LDA(At, 1, 0); PG8_STAGE(PG8_SA(0, 1), a2, PG8_O2(1));
            PG8_WAIT_V(8); PG8_WAIT_L(0); PG8_BAR; PG8_MMA(0, 0, At, B0); PG8_MMA(0, 1, At, B1); PG8_BAR; PG8_SCHED;
            PG8_LDA(At, 1, 1); PG8_STAGE(PG8_SB(1, 0), b3, voffB); PG8_STAGE(PG8_SB(1, 1), b3 + hstep, voffB); PG8_STAGE(PG8_SA(1, 0), a3, PG8_O2(0));
            PG8_WAIT_V(8); PG8_WAIT_L(0); PG8_BAR; PG8_MMA(1, 0, At, B0); PG8_MMA(1, 1, At, B1); PG8_BAR; PG8_SCHED;
#undef PG8_O2
        }
        if (wr == 0) PG8_BAR;
        E(acc, cur, wr, wc, fr, fq);
        if (!has_next) break;
#pragma unroll
        for (int a = 0; a < 2; ++a)
#pragma unroll
            for (int b = 0; b < 2; ++b)
#pragma unroll
                for (int m = 0; m < 4; ++m)
#pragma unroll
                    for (int n = 0; n < 2; ++n) acc[a][b][m][n] = (acc_t){0, 0, 0, 0};
        cur = nxt; cB = nB; cA = nA; ++ui;
        if constexpr (GA) {
#pragma unroll
            for (int h = 0; h < 2; ++h)
#pragma unroll
                for (int i = 0; i < 2; ++i) cvo[h][i] = nvo[h][i];
        }
        if (wr == 1) PG8_BAR;
    }
    PG8_WAIT_V(0);
    PG8_BAR;
#undef PG8_SA
#undef PG8_SB
#undef PG8_STAGE
#undef PG8_LDA
#undef PG8_LDB
#undef PG8_MMA
#undef PG8_WAIT_V
#undef PG8_WAIT_L
#undef PG8_BAR
#undef PG8_SCHED
}

__device__ __forceinline__ u32x4 pack8(const f32x4 v0, const f32x4 v1) { u32x4 w; w.x = cvt_pk_bf16(v0[0], v0[1]); w.y = cvt_pk_bf16(v0[2], v0[3]); w.z = cvt_pk_bf16(v1[0], v1[1]); w.w = cvt_pk_bf16(v1[2], v1[3]); return w; }
__device__ __forceinline__ void unpack8(const u32x4 w, f32x4& v0, f32x4& v1) { v0 = (f32x4){bf_lo(w.x), bf_hi(w.x), bf_lo(w.y), bf_hi(w.y)}; v1 = (f32x4){bf_lo(w.z), bf_hi(w.z), bf_lo(w.w), bf_hi(w.w)}; }
__device__ __forceinline__ f32x4 sig4(const f32x4 v) { return (f32x4){sigmoidf_(v[0]), sigmoidf_(v[1]), sigmoidf_(v[2]), sigmoidf_(v[3])}; }

struct EpiStoreBf16 {
    static constexpr bool PERM = true, I8 = false;
    bf16_t* O; int ldc;
    __device__ __forceinline__ void operator()(const f32x4 (&acc)[2][2][4][2], const Unit& u, int wr, int wc, int fr, int fq) const {
        const int row0 = u.pm * BM + wr * 64 + fr, col0 = u.pn * BM + wc * 32 + 8 * fq;
#pragma unroll
        for (int ai = 0; ai < 2; ++ai)
#pragma unroll
            for (int m = 0; m < 4; ++m) { bf16_t* rowp = O + (size_t)(row0 + ai * HALF + m * 16) * ldc + col0;
#pragma unroll
                for (int bj = 0; bj < 2; ++bj) *(u32x4*)(rowp + bj * HALF) = pack8(acc[ai][bj][m][0], acc[ai][bj][m][1]); }
    }
};
struct EpiProjI8 {
    static constexpr bool PERM = true, I8 = true;
    bf16_t* O; int ldc; const float* sa; const float* sw;
    __device__ __forceinline__ void operator()(const i32x4 (&acc)[2][2][4][2], const Unit& u, int wr, int wc, int fr, int fq) const {
        const int row0 = u.pm * BM + wr * 64 + fr, col0 = u.pn * BM + wc * 32 + 8 * fq;
        f32x4 sc[2][2];
#pragma unroll
        for (int bj = 0; bj < 2; ++bj)
#pragma unroll
            for (int n = 0; n < 2; ++n) sc[bj][n] = *(const f32x4*)(sw + col0 + bj * HALF + 4 * n);
#pragma unroll
        for (int ai = 0; ai < 2; ++ai)
#pragma unroll
            for (int m = 0; m < 4; ++m) { const int row = row0 + ai * HALF + m * 16; const float rs = sa[row]; bf16_t* rowp = O + (size_t)row * ldc + col0;
#pragma unroll
                for (int bj = 0; bj < 2; ++bj) *(u32x4*)(rowp + bj * HALF) = pack8(__builtin_convertvector(acc[ai][bj][m][0], f32x4) * rs * sc[bj][0], __builtin_convertvector(acc[ai][bj][m][1], f32x4) * rs * sc[bj][1]); }
    }
};
template <bool ADD, bool I8_> struct EpiGate {
    static constexpr bool PERM = true, I8 = I8_;
    typedef typename AccSel<I8_>::type acc_t;
    bf16_t* O; const bf16_t* Gt; int ldg; const bf16_t* Y; const float* sa; const float* sw;
    __device__ __forceinline__ void operator()(const acc_t (&acc)[2][2][4][2], const Unit& u, int wr, int wc, int fr, int fq) const {
        const int row0 = u.pm * BM + wr * 64 + fr, col0 = u.pn * BM + wc * 32 + 8 * fq;
        f32x4 sc[2][2];
#pragma unroll
        for (int bj = 0; bj < 2; ++bj)
#pragma unroll
            for (int n = 0; n < 2; ++n) sc[bj][n] = I8_ ? *(const f32x4*)(sw + col0 + bj * HALF + 4 * n) : (f32x4){1.f, 1.f, 1.f, 1.f};
#pragma unroll
        for (int ai = 0; ai < 2; ++ai)
#pragma unroll
            for (int m = 0; m < 4; ++m) { const size_t row = (size_t)(row0 + ai * HALF + m * 16); const float rs = I8_ ? sa[row] : 1.f;
#pragma unroll
                for (int bj = 0; bj < 2; ++bj) {
                    const u32x4 gw = *(const u32x4*)(Gt + row * ldg + col0 + bj * HALF); f32x4 g0, g1; unpack8(gw, g0, g1);
                    f32x4 a0, a1; if constexpr (I8_) { a0 = __builtin_convertvector(acc[ai][bj][m][0], f32x4) * rs * sc[bj][0]; a1 = __builtin_convertvector(acc[ai][bj][m][1], f32x4) * rs * sc[bj][1]; } else { a0 = acc[ai][bj][m][0]; a1 = acc[ai][bj][m][1]; }
                    f32x4 v0 = sig4(g0) * a0, v1 = sig4(g1) * a1;
                    if (ADD) { const u32x4 yw = *(const u32x4*)(Y + row * D + col0 + bj * HALF); f32x4 y0, y1; unpack8(yw, y0, y1); v0 += y0; v1 += y1; }
                    *(u32x4*)(O + row * D + col0 + bj * HALF) = pack8(v0, v1); } }
    }
};
struct EpiResF32 {
    static constexpr bool PERM = false, I8 = false;
    const float* X; float* O;
    __device__ __forceinline__ void operator()(const f32x4 (&acc)[2][2][4][2], const Unit& u, int wr, int wc, int fr, int fq) const {
        const int row0 = u.pm * BM + wr * 64 + fr, col0 = u.pn * BM + wc * 32 + 4 * fq;
#pragma unroll
        for (int ai = 0; ai < 2; ++ai)
#pragma unroll
            for (int m = 0; m < 4; ++m) { const size_t off = (size_t)(row0 + ai * HALF + m * 16) * D + col0;
#pragma unroll
                for (int bj = 0; bj < 2; ++bj)
#pragma unroll
                    for (int n = 0; n < 2; ++n) { const f32x4 xv = *(const f32x4*)(X + off + bj * HALF + n * 16); *(f32x4*)(O + off + bj * HALF + n * 16) = xv + acc[ai][bj][m][n]; } }
    }
};
struct EpiPle {
    static constexpr bool PERM = false, I8 = true;
    float* O; const bf16_t* PP; const float* sa; const float* sw;
    __device__ __forceinline__ void operator()(const i32x4 (&acc)[2][2][4][2], const Unit& u, int wr, int wc, int fr, int fq) const {
        const int row0 = u.pm * BM + wr * 64 + fr, col0 = u.pn * BM + wc * 32 + 4 * fq;
        f32x4 sc[2][2];
#pragma unroll
        for (int bj = 0; bj < 2; ++bj)
#pragma unroll
            for (int n = 0; n < 2; ++n) sc[bj][n] = *(const f32x4*)(sw + col0 + bj * HALF + n * 16);
#pragma unroll
        for (int ai = 0; ai < 2; ++ai)
#pragma unroll
            for (int m = 0; m < 4; ++m) { const int row = row0 + ai * HALF + m * 16; const size_t off = (size_t)row * D + col0; const float rs = sa[row];
#pragma unroll
                for (int bj = 0; bj < 2; ++bj)
#pragma unroll
                    for (int n = 0; n < 2; ++n) { const size_t o = off + bj * HALF + n * 16; const f32x4 hv = *(const f32x4*)(O + o); const u32x2 pw = *(const u32x2*)(PP + o);
                        const f32x4 pv = (f32x4){bf_lo(pw.x), bf_hi(pw.x), bf_lo(pw.y), bf_hi(pw.y)}; *(f32x4*)(O + o) = hv + sig4(__builtin_convertvector(acc[ai][bj][m][n], f32x4) * rs * sc[bj][n]) * pv; } }
    }
};
}

#define XB_TMO      128
#define XB_XCNT(j)  (256  + 64 * (j))
#define XB_XSUB(j)  (1280 + 64 * (j))
#define XB_XGEN(j)  (2304 + 64 * (j))
#define XB_TOP      3328
#define XB_TOPGEN   3392
#define XCD_BAR_WORDS 3456
#define XB_SPIN_CAP (1u << 22)

__device__ __forceinline__ unsigned xb_ld(unsigned* p)              { return __hip_atomic_load(p, __ATOMIC_RELAXED, __HIP_MEMORY_SCOPE_AGENT); }
__device__ __forceinline__ unsigned xb_add(unsigned* p, unsigned v) { return __hip_atomic_fetch_add(p, v, __ATOMIC_RELAXED, __HIP_MEMORY_SCOPE_AGENT); }
__device__ __forceinline__ unsigned xb_xcc_id() { return (unsigned)__builtin_amdgcn_s_getreg((3 << 11) | 20) & 0xFu; }
#define XB_SPIN(cond, bar) do { unsigned _sp = 0; while (cond) { __builtin_amdgcn_s_sleep(1); \
    if ((++_sp & 255u) == 0u) { if (xb_ld(&(bar)[XB_TMO])) break; if (_sp > XB_SPIN_CAP) { atomicAdd(&(bar)[XB_TMO], 1u); break; } } } } while (0)

struct XcdBarrier { unsigned* bar; unsigned x; volatile LAS unsigned* st; };

__device__ __forceinline__ XcdBarrier xcd_barrier_post(unsigned* bar, volatile LAS unsigned* st) {
    XcdBarrier b; b.bar = bar; b.x = xb_xcc_id(); b.st = st;
    if (threadIdx.x == 0) (void)xb_add(&bar[XB_XCNT(b.x)], 1u);
    return b;
}
__device__ __forceinline__ void xcd_barrier_complete(unsigned* bar, unsigned x, unsigned& nloc, unsigned& nx) {
    const unsigned G = gridDim.x * gridDim.y * gridDim.z;
    unsigned sum, cnt, mine, sp = 0u;
    for (;;) {
        sum = 0u; cnt = 0u; mine = 0u;
#pragma unroll
        for (unsigned j = 0; j < 16; ++j) { const unsigned c = xb_ld(&bar[XB_XCNT(j)]); sum += c; cnt += (c > 0u) ? 1u : 0u; mine = (j == x) ? c : mine; }
        if (sum == G) break;
        __builtin_amdgcn_s_sleep(1);
        if ((++sp & 255u) == 0u) { if (xb_ld(&bar[XB_TMO])) break; if (sp > XB_SPIN_CAP) { atomicAdd(&bar[XB_TMO], 1u); break; } }
    }
    nloc = mine > 0u ? mine : 1u; nx = cnt > 0u ? cnt : 1u;
}
__device__ __forceinline__ void xcd_barrier(const XcdBarrier& b) {
    asm volatile("s_waitcnt vmcnt(0)" ::: "memory");
    __syncthreads();
    if (threadIdx.x == 0) {
        unsigned* bar = b.bar;
        __builtin_amdgcn_s_waitcnt(0);
        unsigned nloc = b.st[0], nx = b.st[1];
        if (nloc == 0u) { xcd_barrier_complete(bar, b.x, nloc, nx); b.st[0] = nloc; b.st[1] = nx; }
        const unsigned old = xb_add(&bar[XB_XSUB(b.x)], 1u);
        const unsigned gen = old / nloc;
        if (old + 1u == (gen + 1u) * nloc) {
            __builtin_amdgcn_fence(__ATOMIC_RELEASE, "agent");
            asm volatile("s_waitcnt vmcnt(0)" ::: "memory");
            const unsigned og = xb_add(&bar[XB_TOP], 1u);
            const unsigned tg = og / nx;
            if (og + 1u == (tg + 1u) * nx) xb_add(&bar[XB_TOPGEN], 1u);
            else XB_SPIN(xb_ld(&bar[XB_TOPGEN]) == tg, bar);
            __builtin_amdgcn_fence(__ATOMIC_ACQUIRE, "agent");
            xb_add(&bar[XB_XGEN(b.x)], 1u);
            asm volatile("s_waitcnt vmcnt(0)" ::: "memory");
        } else {
            XB_SPIN(xb_ld(&bar[XB_XGEN(b.x)]) == gen, bar);
            __builtin_amdgcn_fence(__ATOMIC_ACQUIRE, "agent");
            asm volatile("s_waitcnt vmcnt(0)" ::: "memory");
        }
    }
    __syncthreads();
}

struct Frame {
    LAS unsigned char* lds;
    unsigned* ctl;
    int tid, lane, wave, vcu, G;
    unsigned char* ws;
};
struct Args { const float* in[23]; float* out; unsigned char* ws; int ph_lo, ph_hi; };

template <class RowMap>
__device__ __forceinline__ void transpose_item(const float* W, int K, int N, bf16_t* WT, const RowMap rm, LAS float* scr, int item, int lane) {
    const int nblk = (N + 31) / 32, kb = item / nblk, nb = item % nblk, k0 = 64 * kb, n0 = 32 * nb;
    const int nc = n0 + (lane & 31); const bool ok = nc < N;
    float tv[32];
#pragma unroll
    for (int i = 0; i < 32; ++i) tv[i] = W[(size_t)(k0 + 2 * i + (lane >> 5)) * N + (ok ? nc : n0)];
#pragma unroll
    for (int i = 0; i < 32; ++i) scr[(2 * i + (lane >> 5)) * 33 + (lane & 31)] = ok ? tv[i] : 0.f;
    LDS_WAIT(); asm volatile("" ::: "memory");
    const int c = lane & 7;
#pragma unroll
    for (int j = 0; j < 4; ++j) { const int n = (lane >> 3) + 8 * j; const LAS float* s = scr + (8 * c) * 33 + n;
        u32x4 o; o.x = cvt_pk_bf16(s[0 * 33], s[1 * 33]); o.y = cvt_pk_bf16(s[2 * 33], s[3 * 33]); o.z = cvt_pk_bf16(s[4 * 33], s[5 * 33]); o.w = cvt_pk_bf16(s[6 * 33], s[7 * 33]);
        if (n0 + n < N) *(u32x4*)(WT + (size_t)rm(n0 + n) * K + k0 + 8 * c) = o; }
    LDS_WAIT(); asm volatile("" ::: "memory");
}
template <class RowMap, class ScaleMap>
__device__ __forceinline__ void quant_panel_wg(const float* W, int N, signed char* WT, float* sw, const RowMap rm, const ScaleMap sm, LAS float* scr, LAS float* wmax, int nb, int wave, int lane) {
    const int n0 = 32 * nb, nc = n0 + (lane & 31); const bool ok = nc < N;
    const float* wp = W + (size_t)(256 * wave + (lane >> 5)) * N + (ok ? nc : n0);
    float v[4][32]; float mx = 0.f;
#pragma unroll
    for (int kb = 0; kb < 4; ++kb)
#pragma unroll
        for (int i = 0; i < 32; ++i) v[kb][i] = wp[(size_t)(64 * kb + 2 * i) * N];
#pragma unroll
    for (int kb = 0; kb < 4; ++kb)
#pragma unroll
        for (int i = 0; i < 32; ++i) mx = fmaxf(mx, fabsf(v[kb][i]));
    mx = fmaxf(mx, __shfl_xor(mx, 32));
    if (lane < 32) wmax[wave * 32 + lane] = ok ? mx : 0.f;
    __syncthreads();
    float cm = 1e-30f;
#pragma unroll
    for (int w = 0; w < 8; ++w) cm = fmaxf(cm, wmax[w * 32 + (lane & 31)]);
    const float qs = 127.0f / cm;
    if (wave == 0 && lane < 32 && ok) sw[sm(nc)] = cm * (1.0f / 127.0f);
    const int n = lane >> 1, half = lane & 1; const bool okw = (n0 + n) < N;
    signed char* orow = WT + (size_t)rm(okw ? n0 + n : n0) * 2048 + 256 * wave + 32 * half;
#pragma unroll
    for (int kb = 0; kb < 4; ++kb) {
#pragma unroll
        for (int i = 0; i < 32; ++i) scr[(2 * i + (lane >> 5)) * 33 + (lane & 31)] = ok ? v[kb][i] * qs : 0.f;
        LDS_WAIT(); asm volatile("" ::: "memory");
        unsigned w[8];
#pragma unroll
        for (int q = 0; q < 8; ++q) { unsigned pk = 0u;
#pragma unroll
            for (int b = 0; b < 4; ++b) { const int iv = __float2int_rn(scr[(32 * half + 4 * q + b) * 33 + n]); pk |= ((unsigned)iv & 0xffu) << (8 * b); }
            w[q] = pk; }
        if (okw) { *(u32x4*)(orow + 64 * kb) = (u32x4){w[0], w[1], w[2], w[3]}; *(u32x4*)(orow + 64 * kb + 16) = (u32x4){w[4], w[5], w[6], w[7]}; }
        LDS_WAIT(); asm volatile("" ::: "memory");
    }
    __syncthreads();
}
struct MapId { __device__ __forceinline__ int operator()(int n) const { return n; } };
struct MapWin { __device__ __forceinline__ int operator()(int n) const { return n < 6144 ? n : (n < 6160 ? C_GI + (n - 6144) : n - 16); } };
struct MapUp { __device__ __forceinline__ int operator()(int n) const { const int c = n & 2047, lin = n >> 11; return 256 * (c >> 7) + 128 * lin + (c & 127); } };

__device__ __forceinline__ void rms_row_to_bf16(const float* xrow, const float* w, bf16_t* orow, int lane) {
    f32x4 v[4][2]; float s = 0.f;
#pragma unroll
    for (int j = 0; j < 4; ++j)
#pragma unroll
        for (int q = 0; q < 2; ++q) { v[j][q] = *(const f32x4*)(xrow + 512 * j + 8 * lane + 4 * q); s += (v[j][q].x * v[j][q].x + v[j][q].y * v[j][q].y) + (v[j][q].z * v[j][q].z + v[j][q].w * v[j][q].w); }
    const float rstd = 1.0f / sqrtf(wave_sum(s) * (1.f / D) + EPS);
#pragma unroll
    for (int j = 0; j < 4; ++j) { const f32x4 w0 = *(const f32x4*)(w + 512 * j + 8 * lane), w1 = *(const f32x4*)(w + 512 * j + 8 * lane + 4);
        *(u32x4*)(orow + 512 * j + 8 * lane) = pg8::pack8(v[j][0] * rstd * w0, v[j][1] * rstd * w1); }
}

__device__ __forceinline__ void rms_row_to_i8(const float* xrow, const float* w, signed char* orow, float* sa, int lane) {
    f32x4 v[4][2]; float s = 0.f;
#pragma unroll
    for (int j = 0; j < 4; ++j)
#pragma unroll
        for (int q = 0; q < 2; ++q) { v[j][q] = *(const f32x4*)(xrow + 512 * j + 8 * lane + 4 * q); s += (v[j][q].x * v[j][q].x + v[j][q].y * v[j][q].y) + (v[j][q].z * v[j][q].z + v[j][q].w * v[j][q].w); }
    const float rstd = 1.0f / sqrtf(wave_sum(s) * (1.f / D) + EPS);
    float amax = 0.f;
#pragma unroll
    for (int j = 0; j < 4; ++j)
#pragma unroll
        for (int q = 0; q < 2; ++q) { const f32x4 wv = *(const f32x4*)(w + 512 * j + 8 * lane + 4 * q); v[j][q] = v[j][q] * rstd * wv; amax = fmaxf(fmaxf(amax, fmaxf(fabsf(v[j][q].x), fabsf(v[j][q].y))), fmaxf(fabsf(v[j][q].z), fabsf(v[j][q].w))); }
#pragma unroll
    for (int o = 1; o < 64; o <<= 1) amax = fmaxf(amax, __shfl_xor(amax, o));
    amax = fmaxf(amax, 1e-30f); const float qs = 127.0f / amax;
    if (lane == 0) *sa = amax * (1.0f / 127.0f);
#pragma unroll
    for (int j = 0; j < 4; ++j) { u32x2 o;
#pragma unroll
        for (int q = 0; q < 2; ++q) { const f32x4 t = v[j][q] * qs; const unsigned pk = ((unsigned)__float2int_rn(t.x) & 0xffu) | (((unsigned)__float2int_rn(t.y) & 0xffu) << 8) | (((unsigned)__float2int_rn(t.z) & 0xffu) << 16) | (((unsigned)__float2int_rn(t.w) & 0xffu) << 24); if (q == 0) o.x = pk; else o.y = pk; }
        *(u32x2*)(orow + 512 * j + 8 * lane) = o; }
}
__device__ __forceinline__ void p0_prologue(Frame& F, const Args& a) {
    LAS float* scr = (LAS float*)(F.lds + F.wave * 16384);
    const int gw = F.vcu * NWAVES + F.wave, NGW = F.G * NWAVES;
    unsigned char* ws = F.ws;
    for (int m = gw; m < T; m += NGW) rms_row_to_i8(a.in[0] + (size_t)m * D, a.in[2], (signed char*)(ws + WS_XN) + (size_t)m * D, (float*)(ws + WS_SA1) + m, F.lane);
    { const float* p = a.in[1]; bf16_t* pb = (bf16_t*)(ws + WS_PBF);
      for (size_t i = ((size_t)gw * 64 + F.lane) * 8; i < (size_t)T * PLE; i += (size_t)NGW * 64 * 8) { const f32x4 v0 = *(const f32x4*)(p + i), v1 = *(const f32x4*)(p + i + 4); *(u32x4*)(pb + i) = pg8::pack8(v0, v1); } }
    { const float* wr = a.in[14]; float* wp = (float*)(ws + WS_WRP);
      for (int i = gw * 64 + F.lane; i < 128 * 64 * 8; i += NGW * 64) { const int j = i & 7, ln = (i >> 3) & 63, s = i >> 9, c = ln & 15, kq = ln >> 4; wp[i] = wr[(size_t)(16 * s + 4 * kq + (j & 3)) * NE + c + 16 * (j >> 2)]; } }
    { u32x4* z = (u32x4*)((signed char*)(ws + WS_WIN) + (size_t)12816 * D);
      for (int i = gw * 64 + F.lane; i < 240 * D / 16; i += NGW * 64) z[i] = (u32x4){0u, 0u, 0u, 0u};
      float* zs = (float*)(ws + WS_SWIN) + 12816; for (int i = gw * 64 + F.lane; i < 240; i += NGW * 64) zs[i] = 0.f; }
    constexpr int J_IN = (DIN + 31) / 32;
    constexpr int J_UP = 2 * DFF / 32;
    constexpr int I_SQ = (D / 64) * (D / 32);
    constexpr int I_PP = (PLE / 64) * (D / 32);
    constexpr int J_SQ = D / 32;
    constexpr int J_ALL = J_IN + 2 * J_SQ + NE * J_UP + NE * J_SQ;
    LAS float* wmax = (LAS float*)(F.lds + 8 * 16384);
    for (int job = F.vcu; job < J_ALL; job += F.G) {
        int r = job;
        if (r < J_IN) { quant_panel_wg(a.in[3], DIN, (signed char*)(ws + WS_WIN), (float*)(ws + WS_SWIN), MapWin(), MapWin(), scr, wmax, r, F.wave, F.lane); continue; } r -= J_IN;
        if (r < J_SQ) { quant_panel_wg(a.in[10], D, (signed char*)(ws + WS_WA), (float*)(ws + WS_SWA), MapId(), MapId(), scr, wmax, r, F.wave, F.lane); continue; } r -= J_SQ;
        if (r < J_SQ) { quant_panel_wg(a.in[21], D, (signed char*)(ws + WS_WPG), (float*)(ws + WS_SWPG), MapId(), MapId(), scr, wmax, r, F.wave, F.lane); continue; } r -= J_SQ;
        if (r < NE * J_UP) { const int e = r / J_UP; quant_panel_wg(a.in[16] + (size_t)e * D * 2 * DFF, 2 * DFF, (signed char*)(ws + WS_WUP) + (size_t)e * 2 * DFF * D, (float*)(ws + WS_SWUP) + (size_t)e * 2 * DFF, MapUp(), MapId(), scr, wmax, r % J_UP, F.wave, F.lane); continue; } r -= NE * J_UP;
        { const int e = r / J_SQ; quant_panel_wg(a.in[18] + (size_t)e * DFF * D, D, (signed char*)(ws + WS_WDN) + (size_t)e * D * DFF, (float*)(ws + WS_SWDN) + (size_t)e * D, MapId(), MapId(), scr, wmax, r % J_SQ, F.wave, F.lane); }
    }
    constexpr int NITEMS = 2 * I_SQ + I_PP;
    for (int it = gw; it < NITEMS; it += NGW) {
        int r = it;
        if (r < I_SQ) { transpose_item(a.in[11], D, D, (bf16_t*)(ws + WS_WB), MapId(), scr, r, F.lane); continue; } r -= I_SQ;
        if (r < I_SQ) { transpose_item(a.in[12], D, D, (bf16_t*)(ws + WS_WOUT), MapId(), scr, r, F.lane); continue; } r -= I_SQ;
        transpose_item(a.in[22], PLE, D, (bf16_t*)(ws + WS_WPP), MapId(), scr, r, F.lane);
    }
}

namespace ml {
constexpr int NC = SEQ / 64;
constexpr int QS = 0, QS_SZ = 64 * 272, KS = 2 * QS_SZ, VS = KS + 64 * 272, VS_SZ = 64 * 80, SS = VS + 2 * VS_SZ, CT = SS + 64 * 144, CT_SZ = 32 * 272,
              NB = CT + 2 * CT_SZ, BB = NB + 512, AA = BB + 512, WW = AA + 512, GG = WW + 512, ML_END = GG + 32;
static_assert(ML_END <= RING_BYTES, "mLSTM LDS");
__device__ __forceinline__ f32x4 mfma16(bf16x8 a, bf16x8 b, f32x4 c) { return __builtin_amdgcn_mfma_f32_16x16x32_bf16(a, b, c, 0, 0, 0); }
typedef short v4i16_t __attribute__((ext_vector_type(4)));
__device__ __forceinline__ s16x4 vtr(const LAS unsigned char* p) { return __builtin_bit_cast(s16x4, __builtin_amdgcn_ds_read_tr16_b64_v4i16((LAS v4i16_t*)p)); }
__device__ __forceinline__ void trfrag(const LAS unsigned char* base, int stride, int kb, int col0, int fr, int fq, s16x4& lo, s16x4& hi) {
    const LAS unsigned char* p = base + (kb + 8 * fq + (fr >> 2)) * stride + (col0 + 4 * (fr & 3)) * 2;
    lo = vtr(p); hi = vtr(p + 4 * stride);
}

__device__ __forceinline__ void mlstm_unit(LAS unsigned char* lds, const bf16_t* PROJ, bf16_t* HML, float* gates, const float* igb, const float* fgb, int b, int h, int sl) {
    const int tid = threadIdx.x, lane = tid & 63, wid = __builtin_amdgcn_readfirstlane(tid >> 6), fr = lane & 15, fq = lane >> 4;
    const size_t row0 = (size_t)b * SEQ;
    const float scale = 0.08838834764831845f;
    const bf16x8 ONES = (bf16x8){0x3F80, 0x3F80, 0x3F80, 0x3F80, 0x3F80, 0x3F80, 0x3F80, 0x3F80};
    { const float ib = igb[h], fb = fgb[h];
      for (int cc = wid; cc < NC; cc += 8) { const bf16_t* base = PROJ + (row0 + (size_t)cc * 64 + lane) * NPROJ;
          const float gi = bf1(base[C_GI + h]), gf = bf1(base[C_GF + h]);
          const float li = 15.f * tanhf((gi + ib) * (1.f / 15.f)); const float fz = 15.f * tanhf((gf + fb) * (1.f / 15.f)); const float lf = fminf(fz, 0.f) - log1pf(__expf(-fabsf(fz)));
          float bsum = lf;
#pragma unroll
          for (int o = 1; o < 64; o <<= 1) { const float tv = __shfl_up(bsum, o); if (lane >= o) bsum += tv; }
          const float g = __shfl(bsum, 63); const float aj = li - bsum; float* gp = gates + (size_t)cc * 256;
          gp[lane] = bsum; gp[64 + lane] = aj; gp[128 + lane] = __expf(g + aj); if (lane == 0) gp[192] = g; } }
    const int qrow[2] = {tid >> 4, (tid + 512) >> 4}, qch = tid & 15;
    const int vrow = (tid & 255) >> 2, vch = tid & 3;
    u32x4 rq[2][2], rk[2][2], rv[2]; float rg[2] = {0.f, 0.f};
#define ML_LOAD(c, s) do { const bf16_t* base = PROJ + (row0 + (size_t)(c) * 64) * NPROJ; \
        _Pragma("unroll") for (int u = 0; u < 2; ++u) { rq[s][u] = *(const u32x4*)(base + (size_t)qrow[u] * NPROJ + C_MLQ + h * 128 + 8 * qch); rk[s][u] = *(const u32x4*)(base + (size_t)qrow[u] * NPROJ + C_MLK + h * 128 + 8 * qch); } \
        if (tid < 256) rv[s] = *(const u32x4*)(base + (size_t)vrow * NPROJ + C_MLV + h * 256 + 32 * sl + 8 * vch); \
        if (tid < 193) rg[s] = gates[(size_t)(c) * 256 + tid]; } while (0)
#define ML_STORE(p, s) do { \
        _Pragma("unroll") for (int u = 0; u < 2; ++u) { *(LAS u32x4*)(lds + QS + (p) * QS_SZ + qrow[u] * 272 + qch * 16) = rq[s][u]; *(LAS u32x4*)(lds + KS + qrow[u] * 272 + qch * 16) = rk[s][u]; } \
        if (tid < 256) *(LAS u32x4*)(lds + VS + (p) * VS_SZ + vrow * 80 + vch * 16) = rv[s]; \
        if (tid < 192) *(LAS float*)(lds + BB + (tid >> 6) * 512 + (p) * 256 + (tid & 63) * 4) = rg[s]; else if (tid == 192) *(LAS float*)(lds + GG + (p) * 16) = rg[s]; } while (0)
    f32x4 Creg[2][2], nreg[2];
#pragma unroll
    for (int a = 0; a < 2; ++a) { nreg[a] = (f32x4){0.f, 0.f, 0.f, 0.f};
#pragma unroll
        for (int c = 0; c < 2; ++c) Creg[a][c] = (f32x4){0.f, 0.f, 0.f, 0.f}; }
    for (int i = tid; i < CT_SZ / 4; i += 512) *(LAS unsigned*)(lds + CT + i * 4) = 0u;
    if (tid < 64) *(LAS unsigned*)(lds + NB + tid * 4) = 0u;
    VM_WAIT(); __syncthreads();
    ML_LOAD(0, 0); ML_STORE(0, 0); ML_LOAD(1, 1);
    WG_BAR();
    const unsigned glist = wid == 0 ? 0x0DCu : wid == 1 ? 0x4FEu : wid == 2 ? 0x098u : 0x05Au; const int gcnt = wid < 2 ? 3 : 2;
#define ML_CHUNK(c, p) do { \
        if ((c) + 2 < NC) ML_LOAD((c) + 2, p); \
          \
        if (wid < 4) { \
            for (int q = 0; q < gcnt; ++q) { const int code = (int)((glist >> (4 * q)) & 0xFu); const int it = code >> 2, jt = code & 3, i = 16 * it + fr; \
                f32x4 acc = (f32x4){0.f, 0.f, 0.f, 0.f}; \
                _Pragma("unroll") for (int ks = 0; ks < 4; ++ks) { const bf16x8 A = *(const LAS bf16x8*)(lds + KS + (16 * jt + fr) * 272 + (32 * ks + 8 * fq) * 2); const bf16x8 B = *(const LAS bf16x8*)(lds + QS + (p) * QS_SZ + (16 * it + fr) * 272 + (32 * ks + 8 * fq) * 2); acc = mfma16(A, B, acc); } \
                const float bi = *(const LAS float*)(lds + BB + (p) * 256 + i * 4); const f32x4 aj = *(const LAS f32x4*)(lds + AA + (p) * 256 + (16 * jt + 4 * fq) * 4); \
                float v[4]; _Pragma("unroll") for (int r = 0; r < 4; ++r) { const int j = 16 * jt + 4 * fq + r; v[r] = (j <= i) ? acc[r] * scale * __expf(bi + aj[r]) : 0.f; } \
                u32x2 w; w.x = cvt_pk_bf16(v[0], v[1]); w.y = cvt_pk_bf16(v[2], v[3]); *(LAS u32x2*)(lds + SS + i * 144 + (16 * jt + 4 * fq) * 2) = w; } \
            if (wid == 2) *(LAS u32x2*)(lds + SS + fr * 144 + (16 + 4 * fq) * 2) = (u32x2){0u, 0u}; \
            if (wid == 3) *(LAS u32x2*)(lds + SS + (32 + fr) * 144 + (48 + 4 * fq) * 2) = (u32x2){0u, 0u}; \
        } else { \
            const int x = wid - 4; const float eg = __expf(*(const LAS float*)(lds + GG + (p) * 16)); \
            bf16x8 Af[2][2], Bf[2][2]; \
            _Pragma("unroll") for (int ks = 0; ks < 2; ++ks) { \
                const f32x4 w0 = *(const LAS f32x4*)(lds + WW + (p) * 256 + (32 * ks + 8 * fq) * 4), w1 = *(const LAS f32x4*)(lds + WW + (p) * 256 + (32 * ks + 8 * fq + 4) * 4); \
                _Pragma("unroll") for (int dl = 0; dl < 2; ++dl) { s16x4 lo, hi; trfrag(lds + KS, 272, 32 * ks, 16 * (2 * x + dl), fr, fq, lo, hi); \
                    u32x4 sc; sc.x = cvt_pk_bf16(bf1((bf16_t)lo[0]) * w0[0], bf1((bf16_t)lo[1]) * w0[1]); sc.y = cvt_pk_bf16(bf1((bf16_t)lo[2]) * w0[2], bf1((bf16_t)lo[3]) * w0[3]); \
                    sc.z = cvt_pk_bf16(bf1((bf16_t)hi[0]) * w1[0], bf1((bf16_t)hi[1]) * w1[1]); sc.w = cvt_pk_bf16(bf1((bf16_t)hi[2]) * w1[2], bf1((bf16_t)hi[3]) * w1[3]); \
                    Af[dl][ks] = __builtin_bit_cast(bf16x8, sc); } \
                _Pragma("unroll") for (int dv = 0; dv < 2; ++dv) { s16x4 lo, hi; trfrag(lds + VS + (p) * VS_SZ, 80, 32 * ks, 16 * dv, fr, fq, lo, hi); Bf[dv][ks] = (bf16x8){lo[0], lo[1], lo[2], lo[3], hi[0], hi[1], hi[2], hi[3]}; } } \
            _Pragma("unroll") for (int dl = 0; dl < 2; ++dl) { \
                _Pragma("unroll") for (int dv = 0; dv < 2; ++dv) { f32x4 cacc = Creg[dl][dv] * eg; cacc = mfma16(Af[dl][0], Bf[dv][0], cacc); cacc = mfma16(Af[dl][1], Bf[dv][1], cacc); Creg[dl][dv] = cacc; \
                    u32x2 w; w.x = cvt_pk_bf16(cacc[0], cacc[1]); w.y = cvt_pk_bf16(cacc[2], cacc[3]); \
                    *(LAS u32x2*)(lds + CT + ((p) ^ 1) * CT_SZ + (16 * dv + fr) * 272 + (16 * (2 * x + dl) + 4 * fq) * 2) = w; } \
                f32x4 nacc = nreg[dl] * eg; nacc = mfma16(Af[dl][0], ONES, nacc); nacc = mfma16(Af[dl][1], ONES, nacc); nreg[dl] = nacc; \
                if (fr == 0) { u32x2 w; w.x = cvt_pk_bf16(nacc[0], nacc[1]); w.y = cvt_pk_bf16(nacc[2], nacc[3]); *(LAS u32x2*)(lds + NB + ((p) ^ 1) * 256 + (16 * (2 * x + dl) + 4 * fq) * 2) = w; } } \
        } \
        WG_BAR(); \
          \
        { const int it = wid >> 1, dv = wid & 1; \
          f32x4 h1 = (f32x4){0.f, 0.f, 0.f, 0.f}, h2 = h1, rs = h1, qn = h1; \
          for (int ks = 0; ks <= (it >> 1); ++ks) { const bf16x8 A = *(const LAS bf16x8*)(lds + SS + (16 * it + fr) * 144 + (32 * ks + 8 * fq) * 2); s16x4 lo, hi; trfrag(lds + VS + (p) * VS_SZ, 80, 32 * ks, 16 * dv, fr, fq, lo, hi); \
              const bf16x8 B = (bf16x8){lo[0], lo[1], lo[2], lo[3], hi[0], hi[1], hi[2], hi[3]}; h1 = mfma16(A, B, h1); rs = mfma16(A, ONES, rs); } \
          _Pragma("unroll") for (int ks = 0; ks < 4; ++ks) { const bf16x8 A = *(const LAS bf16x8*)(lds + QS + (p) * QS_SZ + (16 * it + fr) * 272 + (32 * ks + 8 * fq) * 2); const bf16x8 B = *(const LAS bf16x8*)(lds + CT + (p) * CT_SZ + (16 * dv + fr) * 272 + (32 * ks + 8 * fq) * 2); \
              const bf16x8 Bn = *(const LAS bf16x8*)(lds + NB + (p) * 256 + (32 * ks + 8 * fq) * 2); h2 = mfma16(A, B, h2); qn = mfma16(A, Bn, qn); } \
          const f32x4 bi = *(const LAS f32x4*)(lds + BB + (p) * 256 + (16 * it + 4 * fq) * 4); \
          bf16_t* orow = HML + (row0 + (size_t)(c) * 64 + 16 * it + 4 * fq) * D + h * 256 + 32 * sl + 16 * dv + fr; \
          _Pragma("unroll") for (int r = 0; r < 4; ++r) { const float eb = __expf(bi[r]) * scale; const float num = h1[r] + eb * h2[r], den = rs[r] + eb * qn[r]; const float hv = num / fmaxf(fabsf(den), 1.0f); \
              orow[(size_t)r * D] = (bf16_t)(cvt_pk_bf16(hv, 0.f) & 0xffffu); } } \
        if ((c) + 1 < NC) ML_STORE((p) ^ 1, (p) ^ 1); \
        WG_BAR(); } while (0)
    for (int c = 0; c < NC; c += 2) { ML_CHUNK(c, 0); ML_CHUNK(c + 1, 1); }
#undef ML_CHUNK
#undef ML_LOAD
#undef ML_STORE
}
}

namespace swa {
constexpr int KSO = 0, VSO = 256 * 144, WSF = 2 * 256 * 144, SWA_END = WSF + 8 * 256;
static_assert(SWA_END <= RING_BYTES, "SWA LDS");
__device__ __forceinline__ int crow(int r, int hi) { return (r & 3) + 8 * (r >> 2) + 4 * hi; }
typedef short v4i16_t __attribute__((ext_vector_type(4)));
__device__ __forceinline__ s16x4 vtr(const LAS unsigned char* p) { return __builtin_bit_cast(s16x4, __builtin_amdgcn_ds_read_tr16_b64_v4i16((LAS v4i16_t*)p)); }

__device__ __forceinline__ void swa_unit(LAS unsigned char* lds, const bf16_t* PROJ, bf16_t* ASW, const float* wq, const float* wk, const float* sinks, int b, int nb, int kvh) {
    const int tid = threadIdx.x, lane = tid & 63, wid = __builtin_amdgcn_readfirstlane(tid >> 6), r32 = lane & 31, hi = lane >> 5;
    const size_t rowbase = (size_t)b * SEQ + (size_t)nb * 128;
#pragma unroll
    for (int u = 0; u < 4; ++u) {
        const int id = tid + 512 * u, row = id >> 3, ch = id & 7; const bool valid = (nb > 0) || (row >= 128);
        u32x4 kw = (u32x4){0u, 0u, 0u, 0u}, vw = (u32x4){0u, 0u, 0u, 0u};
        if (valid) { const bf16_t* rp = PROJ + (rowbase - 128 + row) * NPROJ; kw = *(const u32x4*)(rp + C_SWK + kvh * 64 + 8 * ch); vw = *(const u32x4*)(rp + C_SWV + kvh * 64 + 8 * ch); }
        f32x4 k0, k1; pg8::unpack8(kw, k0, k1);
        float ss = (k0[0] * k0[0] + k0[1] * k0[1]) + (k0[2] * k0[2] + k0[3] * k0[3]) + (k1[0] * k1[0] + k1[1] * k1[1]) + (k1[2] * k1[2] + k1[3] * k1[3]);
        ss += __shfl_xor(ss, 1); ss += __shfl_xor(ss, 2); ss += __shfl_xor(ss, 4);
        const float r = 1.0f / sqrtf(ss * (1.f / 64.f) + EPS);
        const f32x4 w0 = *(const f32x4*)(wk + 8 * ch), w1 = *(const f32x4*)(wk + 8 * ch + 4);
        *(LAS u32x4*)(lds + KSO + row * 144 + ch * 16) = pg8::pack8(k0 * r * w0, k1 * r * w1);
        *(LAS u32x4*)(lds + VSO + row * 144 + ch * 16) = vw;
    }
    WG_BAR();
    const int hd = kvh * 8 + wid;
    const float slope = exp2f(-(float)(hd + 1) * 0.25f) * LOG2E, sinkl = sinks[hd] * LOG2E;
    LAS float* wsf = (LAS float*)(lds + WSF + wid * 256);
    for (int qt = 0; qt < 4; ++qt) {
        bf16x8 qf[4];
        { const bf16_t* qp = PROJ + (rowbase + 32 * qt + r32) * NPROJ + C_SWQ + hd * 64 + 8 * hi; f32x4 q0[4], q1[4]; float ss = 0.f;
#pragma unroll
          for (int ds = 0; ds < 4; ++ds) { const u32x4 w = *(const u32x4*)(qp + 16 * ds); pg8::unpack8(w, q0[ds], q1[ds]);
              ss += (q0[ds][0] * q0[ds][0] + q0[ds][1] * q0[ds][1]) + (q0[ds][2] * q0[ds][2] + q0[ds][3] * q0[ds][3]) + (q1[ds][0] * q1[ds][0] + q1[ds][1] * q1[ds][1]) + (q1[ds][2] * q1[ds][2] + q1[ds][3] * q1[ds][3]); }
          ss += __shfl_xor(ss, 32);
          const float r = (1.0f / sqrtf(ss * (1.f / 64.f) + EPS)) * 0.125f * LOG2E;
#pragma unroll
          for (int ds = 0; ds < 4; ++ds) { const f32x4 w0 = *(const f32x4*)(wq + 16 * ds + 8 * hi), w1 = *(const f32x4*)(wq + 16 * ds + 8 * hi + 4); qf[ds] = __builtin_bit_cast(bf16x8, pg8::pack8(q0[ds] * r * w0, q1[ds] * r * w1)); } }
        f32x16 s[5];
#pragma unroll
        for (int kk = 0; kk < 5; ++kk) { const int kt = qt + kk; f32x16 a = {};
#pragma unroll
            for (int ds = 0; ds < 4; ++ds) { const bf16x8 A = *(const LAS bf16x8*)(lds + KSO + (32 * kt + r32) * 144 + (16 * ds + 8 * hi) * 2); a = __builtin_amdgcn_mfma_f32_32x32x16_bf16(A, qf[ds], a, 0, 0, 0); }
            s[kk] = a; __builtin_amdgcn_sched_barrier(0); }
        int dbase = 128 + r32 - 4 * hi; asm volatile("" : "+v"(dbase));
        const float fbase = (float)dbase; const int jlim = ((nb > 0) ? 0 : 128) - 32 * qt - 4 * hi;
        float m = sinkl;
#pragma unroll
        for (int kk = 0; kk < 5; ++kk)
#pragma unroll
            for (int r = 0; r < 16; ++r) { const int ckr = 32 * kk + (r & 3) + 8 * (r >> 2); const int dist = dbase - ckr; const bool valid = ((unsigned)dist < 128u) && (ckr >= jlim);
                const float v = valid ? s[kk][r] - slope * (fbase - (float)ckr) : -INFINITY; s[kk][r] = v; m = fmaxf(m, v); }
        m = fmaxf(m, __shfl_xor(m, 32));
        float l = 0.f;
#pragma unroll
        for (int kk = 0; kk < 5; ++kk)
#pragma unroll
            for (int r = 0; r < 16; ++r) { const float p = exp2f(s[kk][r] - m); s[kk][r] = p; l += p; }
        l += __shfl_xor(l, 32);
        l += exp2f(sinkl - m);
        if (hi == 0) wsf[r32] = 1.0f / l;
        f32x16 o[2]; o[0] = (f32x16){}; o[1] = (f32x16){};
#pragma unroll
        for (int kk = 0; kk < 5; ++kk) { const int kt = qt + kk;
#pragma unroll
            for (int s2 = 0; s2 < 2; ++s2) {
                u32x4 pw; pw.x = cvt_pk_bf16(s[kk][8 * s2 + 0], s[kk][8 * s2 + 1]); pw.y = cvt_pk_bf16(s[kk][8 * s2 + 2], s[kk][8 * s2 + 3]); pw.z = cvt_pk_bf16(s[kk][8 * s2 + 4], s[kk][8 * s2 + 5]); pw.w = cvt_pk_bf16(s[kk][8 * s2 + 6], s[kk][8 * s2 + 7]);
                const bf16x8 pa = __builtin_bit_cast(bf16x8, pw);
                const int key = 32 * kt + 16 * s2 + 4 * hi + ((lane & 15) >> 2);
#pragma unroll
                for (int d0 = 0; d0 < 2; ++d0) { const LAS unsigned char* vp = lds + VSO + key * 144 + (32 * d0 + 16 * ((lane >> 4) & 1) + 4 * (lane & 3)) * 2;
                    const s16x4 lo = vtr(vp), hh = vtr(vp + 8 * 144);
                    const bf16x8 B = (bf16x8){lo[0], lo[1], lo[2], lo[3], hh[0], hh[1], hh[2], hh[3]};
                    o[d0] = __builtin_amdgcn_mfma_f32_32x32x16_bf16(pa, B, o[d0], 0, 0, 0); }
                __builtin_amdgcn_sched_barrier(0); } }
        LDS_WAIT();
#pragma unroll
        for (int r = 0; r < 16; ++r) { const float rl = wsf[crow(r, hi)]; bf16_t* op = ASW + (rowbase + 32 * qt + crow(r, hi)) * D + hd * 64 + r32;
            op[0] = (bf16_t)(cvt_pk_bf16(o[0][r] * rl, 0.f) & 0xffffu); op[32] = (bf16_t)(cvt_pk_bf16(o[1][r] * rl, 0.f) & 0xffffu); }
    }
    WG_BAR();
}
}

namespace moe {
using pg8::Unit; using pg8::BM; using pg8::HALF;
struct Tables { const LAS int* tstart; const LAS int* cnt; const LAS int* tile_e; };
__device__ __forceinline__ int build_tables(LAS unsigned char* tab, const unsigned* cur) {
    LAS int* tstart = (LAS int*)tab; LAS int* cnt = (LAS int*)(tab + 256); LAS int* tile_e = (LAS int*)(tab + 512);
    const int tid = threadIdx.x;
    if (tid < NE) cnt[tid] = (int)__hip_atomic_load(cur + 64 * tid, RLX_AGENT);
    __syncthreads();
    if (tid == 0) { int s = 0; for (int e = 0; e < NE; ++e) { tstart[e] = s; s += (cnt[e] + 255) >> 8; } tstart[NE] = s; }
    __syncthreads();
    const int nrt = tstart[NE];
    for (int t = tid; t < nrt; t += 512) { int e = 0; for (int k = 1; k < NE; ++k) if (tstart[k] <= t) e = k; tile_e[t] = e; }
    __syncthreads();
    return nrt;
}
struct UpSched {
    static constexpr bool GATHER = true;
    const void* A; const void* Bt; const int* tokl; Tables tb; int nrt, nN, G, c;
    __device__ __forceinline__ bool next(int i, Unit& u) const { const long L = (long)i * G + c; if (L >= (long)nrt * nN) return false; pg8::map_unit((int)L, nrt, nN, u.pm, u.pn); u.e = tb.tile_e[u.pm]; u.r0 = (u.pm - tb.tstart[u.e]) * BM; u.cnt = tb.cnt[u.e]; return true; }
    __device__ __forceinline__ const char* a_base() const { return (const char*)A; }
    __device__ __forceinline__ void a_offs(const Unit& u, const int (&R)[2], const int (&C)[2], int K, unsigned (&vo)[2][2]) const {
#pragma unroll
        for (int h = 0; h < 2; ++h)
#pragma unroll
            for (int i = 0; i < 2; ++i) { const int rl = u.r0 + h * HALF + R[i]; const int tok = rl < u.cnt ? tokl[(size_t)u.e * CAP + rl] : 0; vo[h][i] = (unsigned)tok * (unsigned)K + (unsigned)C[i] * 2u; }
    }
    __device__ __forceinline__ const char* a_tile(const Unit&, int) const { return (const char*)A; }
    __device__ __forceinline__ const char* b_tile(const Unit& u, int K) const { return (const char*)Bt + ((size_t)u.e * 2 * DFF + (size_t)u.pn * BM) * K; }
};
struct DownSched {
    static constexpr bool GATHER = false;
    const bf16_t* A; const bf16_t* Bt; Tables tb; int nrt, nN, G, c;
    __device__ __forceinline__ bool next(int i, Unit& u) const { const long L = (long)i * G + c; if (L >= (long)nrt * nN) return false; pg8::map_unit((int)L, nrt, nN, u.pm, u.pn); u.e = tb.tile_e[u.pm]; u.r0 = (u.pm - tb.tstart[u.e]) * BM; u.cnt = tb.cnt[u.e]; return true; }
    __device__ __forceinline__ const char* a_base() const { return (const char*)A; }
    __device__ __forceinline__ void a_offs(const Unit& u, const int (&R)[2], const int (&C)[2], int K, unsigned (&vo)[2][2]) const {
#pragma unroll
        for (int h = 0; h < 2; ++h)
#pragma unroll
            for (int i = 0; i < 2; ++i) vo[h][i] = (unsigned)(u.pm * BM + h * HALF + R[i]) * (unsigned)K + (unsigned)C[i] * 2u;
    }
    __device__ __forceinline__ const char* a_tile(const Unit& u, int K) const { return (const char*)A + (size_t)u.pm * BM * K; }
    __device__ __forceinline__ const char* b_tile(const Unit& u, int K) const { return (const char*)Bt + ((size_t)u.e * D + (size_t)u.pn * BM) * K; }
};
struct EpiUp {
    static constexpr bool PERM = true, I8 = true;
    bf16_t* ACT; const float* bup; const float* rsl; const float* swup; float* amax;
    __device__ __forceinline__ void operator()(const i32x4 (&acc)[2][2][4][2], const Unit& u, int wr, int wc, int fr, int fq) const {
        const int oc = u.pn * HALF + wc * 32 + 8 * fq;
        const float* bg = bup + (size_t)u.e * 2 * DFF + oc; const float* bl = bg + DFF;
        const float* sg = swup + (size_t)u.e * 2 * DFF + oc; const float* sl = sg + DFF;
        const f32x4 bg0 = *(const f32x4*)bg, bg1 = *(const f32x4*)(bg + 4), bl0 = *(const f32x4*)bl, bl1 = *(const f32x4*)(bl + 4);
        const f32x4 sg0 = *(const f32x4*)sg, sg1 = *(const f32x4*)(sg + 4), sl0 = *(const f32x4*)sl, sl1 = *(const f32x4*)(sl + 4);
#pragma unroll
        for (int ai = 0; ai < 2; ++ai)
#pragma unroll
            for (int m = 0; m < 4; ++m) { const int rt = ai * HALF + wr * 64 + m * 16 + fr; const int rl = u.r0 + rt; const float rs = rl < u.cnt ? rsl[(size_t)u.e * CAP + rl] : 0.f;
                f32x4 o[2];
#pragma unroll
                for (int n = 0; n < 2; ++n) { const f32x4 ag = __builtin_convertvector(acc[ai][0][m][n], f32x4), al = __builtin_convertvector(acc[ai][1][m][n], f32x4);
                    const f32x4 g = ag * rs * (n ? sg1 : sg0) + (n ? bg1 : bg0), l = al * rs * (n ? sl1 : sl0) + (n ? bl1 : bl0);
#pragma unroll
                    for (int j = 0; j < 4; ++j) { const float gg = fminf(g[j], 7.0f), ll = fminf(fmaxf(l[j], -7.0f), 7.0f); o[n][j] = gg * sigmoidf_(1.702f * gg) * (ll + 1.0f); } }
                *(u32x4*)(ACT + (size_t)(u.pm * BM + rt) * DFF + oc) = pg8::pack8(o[0], o[1]);
                float mx = amax4(amax4(0.f, o[0]), o[1]); mx = fmaxf(mx, __shfl_xor(mx, 16)); mx = fmaxf(mx, __shfl_xor(mx, 32));
                if (fq == 0) amax[(size_t)(u.pm * BM + rt) * 64 + u.pn * 4 + wc] = mx; }
    }
};
struct EpiDown {
    static constexpr bool PERM = true, I8 = true;
    bf16_t* YS; const float* bdn; const float* gatel; const int* destl; const float* sad; const float* swdn;
    __device__ __forceinline__ void operator()(const i32x4 (&acc)[2][2][4][2], const Unit& u, int wr, int wc, int fr, int fq) const {
        const int col0 = u.pn * BM + wc * 32 + 8 * fq;
        f32x4 bv[2][2], sc[2][2];
#pragma unroll
        for (int bj = 0; bj < 2; ++bj)
#pragma unroll
            for (int n = 0; n < 2; ++n) { bv[bj][n] = *(const f32x4*)(bdn + (size_t)u.e * D + col0 + bj * HALF + 4 * n); sc[bj][n] = *(const f32x4*)(swdn + (size_t)u.e * D + col0 + bj * HALF + 4 * n); }
#pragma unroll
        for (int ai = 0; ai < 2; ++ai)
#pragma unroll
            for (int m = 0; m < 4; ++m) { const int rt = ai * HALF + wr * 64 + m * 16 + fr, rl = u.r0 + rt;
                if (rl < u.cnt) { const float g = gatel[(size_t)u.e * CAP + rl]; const int dest = destl[(size_t)u.e * CAP + rl]; const float rs = sad[u.pm * BM + rt];
#pragma unroll
                    for (int bj = 0; bj < 2; ++bj) *(u32x4*)(YS + (size_t)dest * D + col0 + bj * HALF) = pg8::pack8((__builtin_convertvector(acc[ai][bj][m][0], f32x4) * rs * sc[bj][0] + bv[bj][0]) * g, (__builtin_convertvector(acc[ai][bj][m][1], f32x4) * rs * sc[bj][1] + bv[bj][1]) * g); } }
    }
};
}

__device__ __forceinline__ void ml_norm_rows(Frame& F, const Args& a) {
    const int gw = F.vcu * NWAVES + F.wave, NGW = F.G * NWAVES, lane = F.lane;
    const bf16_t* HML = (const bf16_t*)(F.ws + WS_HML); const bf16_t* PROJ = (const bf16_t*)(F.ws + WS_PROJ); const float* nw = a.in[6];
    signed char* AQ = (signed char*)(F.ws + WS_AMLQ); float* sa = (float*)(F.ws + WS_SAML);
    for (int m = gw; m < T; m += NGW) {
        const bf16_t* hr = HML + (size_t)m * D; const bf16_t* orow = PROJ + (size_t)m * NPROJ + C_MLO;
        f32x4 v[4][2]; float amax = 0.f;
#pragma unroll
        for (int j = 0; j < 4; ++j) { const int c0 = 512 * j + 8 * lane;
            const u32x4 hw = *(const u32x4*)(hr + c0), ow = *(const u32x4*)(orow + c0); f32x4 h0, h1, o0, o1; pg8::unpack8(hw, h0, h1); pg8::unpack8(ow, o0, o1);
            float ss = (h0[0] * h0[0] + h0[1] * h0[1]) + (h0[2] * h0[2] + h0[3] * h0[3]) + (h1[0] * h1[0] + h1[1] * h1[1]) + (h1[2] * h1[2] + h1[3] * h1[3]);
#pragma unroll
            for (int o = 1; o < 32; o <<= 1) ss += __shfl_xor(ss, o);
            const float r = 1.0f / sqrtf(ss * (1.f / 256.f) + EPS);
            const f32x4 w0 = *(const f32x4*)(nw + c0), w1 = *(const f32x4*)(nw + c0 + 4);
            v[j][0] = h0 * r * w0 * pg8::sig4(o0); v[j][1] = h1 * r * w1 * pg8::sig4(o1); amax = amax4(amax4(amax, v[j][0]), v[j][1]); }
        amax = fmaxf(wave_max(amax), 1e-30f); const float qs = 127.0f / amax;
        if (lane == 0) sa[m] = amax * (1.0f / 127.0f);
#pragma unroll
        for (int j = 0; j < 4; ++j) { u32x2 o; o.x = q8x4(v[j][0] * qs); o.y = q8x4(v[j][1] * qs); *(u32x2*)(AQ + (size_t)m * D + 512 * j + 8 * lane) = o; }
    }
}

__device__ __forceinline__ void route_phase(Frame& F, const Args& a) {
    LAS unsigned char* lds = F.lds;
    LAS float* w2s = (LAS float*)(lds);
    LAS float* lg = (LAS float*)(lds + 8192);
    LAS float* rsd = (LAS float*)(lds + 8192 + 8 * 16 * 33 * 4);
    LAS float* rsd2 = rsd + 128;
    LAS int* sel_e = (LAS int*)(lds + 32768);
    LAS float* sel_g = (LAS float*)(lds + 32768 + 2048);
    LAS int* hist = (LAS int*)(lds + 32768 + 4096);
    LAS int* basep = (LAS int*)(lds + 32768 + 4096 + 128);
    const int tid = F.tid, lane = F.lane, wid = F.wave, c16 = lane & 15, kq = lane >> 4;
    const float* h1 = a.out; const float* w2 = a.in[13]; const float* br = a.in[15]; const float* wrp = (const float*)(F.ws + WS_WRP);
    signed char* XQ = (signed char*)(F.ws + WS_XN);
    int* tokl = (int*)(F.ws + WS_TOKL); float* gatel = (float*)(F.ws + WS_GATEL); int* destl = (int*)(F.ws + WS_DESTL); float* rsl = (float*)(F.ws + WS_RSL);
    unsigned* cur = F.ctl + CW_CUR;
    for (int i = tid; i < D; i += 512) w2s[i] = w2[i];
    __syncthreads();
    for (int tb = blockIdx.x; tb < T / 128; tb += F.G) {
        if (tid < NE) hist[tid] = 0;
        const int row0 = tb * 128 + wid * 16;
        const float* xr = h1 + (size_t)(row0 + c16) * D + 4 * kq; signed char* xo = XQ + (size_t)(row0 + c16) * D + 4 * kq;
        f32x4 acc0 = (f32x4){0.f, 0.f, 0.f, 0.f}, acc1 = (f32x4){0.f, 0.f, 0.f, 0.f}; float ss = 0.f, amax = 0.f;
#pragma unroll 4
        for (int s = 0; s < 128; ++s) {
            const f32x4 xv = *(const f32x4*)(xr + 16 * s); const f32x4 wv = *(const LAS f32x4*)(w2s + 16 * s + 4 * kq);
            const f32x4 b0 = *(const f32x4*)(wrp + ((size_t)s * 64 + lane) * 8), b1 = *(const f32x4*)(wrp + ((size_t)s * 64 + lane) * 8 + 4);
            ss += (xv[0] * xv[0] + xv[1] * xv[1]) + (xv[2] * xv[2] + xv[3] * xv[3]);
            const f32x4 xw = xv * wv;
            amax = fmaxf(fmaxf(amax, fmaxf(fabsf(xw[0]), fabsf(xw[1]))), fmaxf(fabsf(xw[2]), fabsf(xw[3])));
#pragma unroll
            for (int j = 0; j < 4; ++j) { acc0 = __builtin_amdgcn_mfma_f32_16x16x4f32(xw[j], b0[j], acc0, 0, 0, 0); acc1 = __builtin_amdgcn_mfma_f32_16x16x4f32(xw[j], b1[j], acc1, 0, 0, 0); }
        }
        ss += __shfl_xor(ss, 16); ss += __shfl_xor(ss, 32);
        amax = fmaxf(amax, __shfl_xor(amax, 16)); amax = fmaxf(amax, __shfl_xor(amax, 32)); amax = fmaxf(amax, 1e-30f);
        const float rstd = 1.0f / sqrtf(ss * (1.f / D) + EPS);
        if (kq == 0) { rsd[wid * 16 + c16] = rstd * amax * (1.0f / 127.0f); rsd2[wid * 16 + c16] = rstd; }
        { const float qs = 127.0f / amax;
#pragma unroll 4
          for (int s = 0; s < 128; ++s) { const f32x4 xv = *(const f32x4*)(xr + 16 * s); const f32x4 wv = *(const LAS f32x4*)(w2s + 16 * s + 4 * kq); const f32x4 xw = xv * wv * qs;
              const unsigned pk = ((unsigned)__float2int_rn(xw[0]) & 0xffu) | (((unsigned)__float2int_rn(xw[1]) & 0xffu) << 8) | (((unsigned)__float2int_rn(xw[2]) & 0xffu) << 16) | (((unsigned)__float2int_rn(xw[3]) & 0xffu) << 24);
              *(unsigned*)(xo + 16 * s) = pk; } }
        LDS_WAIT();
        { const float bb0 = br[c16], bb1 = br[c16 + 16];
#pragma unroll
          for (int r = 0; r < 4; ++r) { const float rr = rsd2[wid * 16 + 4 * kq + r]; lg[(wid * 16 + 4 * kq + r) * 33 + c16] = acc0[r] * rr + bb0; lg[(wid * 16 + 4 * kq + r) * 33 + c16 + 16] = acc1[r] * rr + bb1; } }
        LDS_WAIT();
        if (lane < 16) {
            const LAS float* lr = lg + (wid * 16 + lane) * 33; unsigned taken = 0u; float tv[4]; int te[4];
#pragma unroll
            for (int k = 0; k < 4; ++k) { float best = -INFINITY; int bi = 0;
                for (int e = 0; e < NE; ++e) { const float v = lr[e]; const bool ok = !((taken >> e) & 1u) && (v > best); best = ok ? v : best; bi = ok ? e : bi; }
                taken |= 1u << bi; tv[k] = best; te[k] = bi; }
            float ex[4], sum = 0.f;
#pragma unroll
            for (int k = 0; k < 4; ++k) { ex[k] = __expf(tv[k] - tv[0]); sum += ex[k]; }
            const float inv = 1.0f / sum;
#pragma unroll
            for (int k = 0; k < 4; ++k) { sel_e[(wid * 16 + lane) * 4 + k] = te[k]; sel_g[(wid * 16 + lane) * 4 + k] = ex[k] * inv; }
        }
        __syncthreads();
        const int prow = wid * 16 + (lane >> 2), pk = lane & 3;
        const int pe = sel_e[prow * 4 + pk]; const float pg = sel_g[prow * 4 + pk];
        const int lr_ = __hip_atomic_fetch_add(hist + pe, 1, __ATOMIC_RELAXED, __HIP_MEMORY_SCOPE_WORKGROUP);
        __syncthreads();
        if (tid < NE) basep[tid] = (int)__hip_atomic_fetch_add(cur + 64 * tid, (unsigned)hist[tid], RLX_AGENT);
        __syncthreads();
        { const int pos = basep[pe] + lr_; const int token = tb * 128 + prow; const size_t li = (size_t)pe * CAP + pos;
          tokl[li] = token; gatel[li] = pg; destl[li] = token * 4 + pk; rsl[li] = rsd[prow]; }
        __syncthreads();
    }
}

__device__ __forceinline__ void combine_rows(Frame& F, const Args& a) {
    const int gw = F.vcu * NWAVES + F.wave, NGW = F.G * NWAVES, lane = F.lane;
    float* out = a.out; const bf16_t* YS = (const bf16_t*)(F.ws + WS_YS); signed char* XQ = (signed char*)(F.ws + WS_XN); float* sa3 = (float*)(F.ws + WS_SA3); const float* w3 = a.in[20];
    for (int m = gw; m < T; m += NGW) {
        float* hr = out + (size_t)m * D; f32x4 v[4][2]; float s = 0.f;
#pragma unroll
        for (int j = 0; j < 4; ++j) { const int c0 = 512 * j + 8 * lane; v[j][0] = *(const f32x4*)(hr + c0); v[j][1] = *(const f32x4*)(hr + c0 + 4);
#pragma unroll
            for (int k = 0; k < 4; ++k) { const u32x4 yw = *(const u32x4*)(YS + ((size_t)m * 4 + k) * D + c0); f32x4 y0, y1; pg8::unpack8(yw, y0, y1); v[j][0] += y0; v[j][1] += y1; }
            *(f32x4*)(hr + c0) = v[j][0]; *(f32x4*)(hr + c0 + 4) = v[j][1];
#pragma unroll
            for (int q = 0; q < 2; ++q) s += (v[j][q].x * v[j][q].x + v[j][q].y * v[j][q].y) + (v[j][q].z * v[j][q].z + v[j][q].w * v[j][q].w); }
        const float rstd = 1.0f / sqrtf(wave_sum(s) * (1.f / D) + EPS); float amax = 0.f;
#pragma unroll
        for (int j = 0; j < 4; ++j) { const int c0 = 512 * j + 8 * lane; const f32x4 w0 = *(const f32x4*)(w3 + c0), w1 = *(const f32x4*)(w3 + c0 + 4);
            v[j][0] = v[j][0] * rstd * w0; v[j][1] = v[j][1] * rstd * w1; amax = amax4(amax4(amax, v[j][0]), v[j][1]); }
        amax = fmaxf(wave_max(amax), 1e-30f); const float qs = 127.0f / amax;
        if (lane == 0) sa3[m] = amax * (1.0f / 127.0f);
#pragma unroll
        for (int j = 0; j < 4; ++j) { u32x2 o; o.x = q8x4(v[j][0] * qs); o.y = q8x4(v[j][1] * qs); *(u32x2*)(XQ + (size_t)m * D + 512 * j + 8 * lane) = o; }
    }
}
__device__ __forceinline__ void act_quant_rows(Frame& F, int nrows) {
    const int gw = F.vcu * NWAVES + F.wave, NGW = F.G * NWAVES, lane = F.lane;
    const bf16_t* ACT = (const bf16_t*)(F.ws + WS_ACT); const float* am = (const float*)(F.ws + WS_AMAX); signed char* AQ = (signed char*)(F.ws + WS_ACTQ); float* sad = (float*)(F.ws + WS_SAD);
    for (int m = gw; m < nrows; m += NGW) {
        const float amax = fmaxf(wave_max(am[(size_t)m * 64 + lane]), 1e-30f); const float qs = 127.0f / amax;
        if (lane == 0) sad[m] = amax * (1.0f / 127.0f);
#pragma unroll
        for (int j = 0; j < 4; ++j) { const int c0 = 512 * j + 8 * lane; const u32x4 w = *(const u32x4*)(ACT + (size_t)m * DFF + c0); f32x4 a0, a1; pg8::unpack8(w, a0, a1);
            u32x2 o; o.x = q8x4(a0 * qs); o.y = q8x4(a1 * qs); *(u32x2*)(AQ + (size_t)m * DFF + c0) = o; }
    }
}

__device__ __forceinline__ void ph_gemm1(Frame& F, const Args& a) {
    pg8::DenseSched S{(const bf16_t*)(F.ws + WS_XN), (const bf16_t*)(F.ws + WS_WIN), T / 256, NPROJ / 256, F.G, (int)blockIdx.x}; pg8::EpiProjI8 E{(bf16_t*)(F.ws + WS_PROJ), NPROJ, (const float*)(F.ws + WS_SA1), (const float*)(F.ws + WS_SWIN)}; pg8::gemm_phase(F.lds, D, S, E); }
__device__ __forceinline__ void ph_mlstm(Frame& F, const Args& a) {
    for (int u = F.vcu; u < 256; u += F.G) ml::mlstm_unit(F.lds, (const bf16_t*)(F.ws + WS_PROJ), (bf16_t*)(F.ws + WS_HML), (float*)(F.ws + WS_GATES) + (size_t)u * ml::NC * 256, a.in[4], a.in[5], u >> 6, (u >> 3) & 7, u & 7); }
__device__ __forceinline__ void ph_norm_swa(Frame& F, const Args& a) {
    ml_norm_rows(F, a);
    for (int u = F.vcu; u < 1024; u += F.G) swa::swa_unit(F.lds, (const bf16_t*)(F.ws + WS_PROJ), (bf16_t*)(F.ws + WS_ASW), a.in[7], a.in[8], a.in[9], u >> 8, (u >> 2) & 63, u & 3); }
__device__ __forceinline__ void ph_ya(Frame& F, const Args& a) {
    pg8::DenseSched S{(const bf16_t*)(F.ws + WS_AMLQ), (const bf16_t*)(F.ws + WS_WA), T / 256, D / 256, F.G, (int)blockIdx.x};
    pg8::EpiGate<false, true> E{(bf16_t*)(F.ws + WS_YA), (const bf16_t*)(F.ws + WS_PROJ) + C_GA, NPROJ, nullptr, (const float*)(F.ws + WS_SAML), (const float*)(F.ws + WS_SWA)}; pg8::gemm_phase(F.lds, D, S, E); }
__device__ __forceinline__ void ph_mix(Frame& F, const Args& a) {
    pg8::DenseSched S{(const bf16_t*)(F.ws + WS_ASW), (const bf16_t*)(F.ws + WS_WB), T / 256, D / 256, F.G, (int)blockIdx.x};
    pg8::EpiGate<true, false> E{(bf16_t*)(F.ws + WS_MIX), (const bf16_t*)(F.ws + WS_PROJ) + C_GB, NPROJ, (const bf16_t*)(F.ws + WS_YA), nullptr, nullptr}; pg8::gemm_phase(F.lds, D * 2, S, E); }
__device__ __forceinline__ void ph_h1(Frame& F, const Args& a) {
    pg8::DenseSched S{(const bf16_t*)(F.ws + WS_MIX), (const bf16_t*)(F.ws + WS_WOUT), T / 256, D / 256, F.G, (int)blockIdx.x}; pg8::EpiResF32 E{a.in[0], a.out}; pg8::gemm_phase(F.lds, D * 2, S, E); }
__device__ __forceinline__ void ph_up(Frame& F, const Args& a) {
    const int nrt = moe::build_tables(F.lds + TAB_OFF, F.ctl + CW_CUR);
    moe::Tables tb{(const LAS int*)(F.lds + TAB_OFF), (const LAS int*)(F.lds + TAB_OFF + 256), (const LAS int*)(F.lds + TAB_OFF + 512)};
    moe::UpSched S{(const void*)(F.ws + WS_XN), (const void*)(F.ws + WS_WUP), (const int*)(F.ws + WS_TOKL), tb, nrt, 2 * DFF / 256, F.G, (int)blockIdx.x}; moe::EpiUp E{(bf16_t*)(F.ws + WS_ACT), a.in[17], (const float*)(F.ws + WS_RSL), (const float*)(F.ws + WS_SWUP), (float*)(F.ws + WS_AMAX)}; pg8::gemm_phase(F.lds, D, S, E); }
__device__ __forceinline__ void ph_actq(Frame& F, const Args& a) {
    const int nrt = moe::build_tables(F.lds + TAB_OFF, F.ctl + CW_CUR); act_quant_rows(F, nrt * 256); }
__device__ __forceinline__ void ph_down(Frame& F, const Args& a) {
    const int nrt = moe::build_tables(F.lds + TAB_OFF, F.ctl + CW_CUR);
    moe::Tables tb{(const LAS int*)(F.lds + TAB_OFF), (const LAS int*)(F.lds + TAB_OFF + 256), (const LAS int*)(F.lds + TAB_OFF + 512)};
    moe::DownSched S{(const bf16_t*)(F.ws + WS_ACTQ), (const bf16_t*)(F.ws + WS_WDN), tb, nrt, D / 256, F.G, (int)blockIdx.x};
    moe::EpiDown E{(bf16_t*)(F.ws + WS_YS), a.in[19], (const float*)(F.ws + WS_GATEL), (const int*)(F.ws + WS_DESTL), (const float*)(F.ws + WS_SAD), (const float*)(F.ws + WS_SWDN)}; pg8::gemm_phase(F.lds, DFF, S, E); }
__device__ __forceinline__ void ph_combine_pp(Frame& F, const Args& a) {
    combine_rows(F, a);
    pg8::DenseSched S{(const bf16_t*)(F.ws + WS_PBF), (const bf16_t*)(F.ws + WS_WPP), T / 256, D / 256, F.G, (int)blockIdx.x}; pg8::EpiStoreBf16 E{(bf16_t*)(F.ws + WS_PP), D}; int kb = PLE * 2; asm volatile("" : "+s"(kb));
    pg8::gemm_phase(F.lds, kb, S, E); }
__device__ __forceinline__ void ph_out(Frame& F, const Args& a) {
    pg8::DenseSched S{(const bf16_t*)(F.ws + WS_XN), (const bf16_t*)(F.ws + WS_WPG), T / 256, D / 256, F.G, (int)blockIdx.x}; pg8::EpiPle E{a.out, (const bf16_t*)(F.ws + WS_PP), (const float*)(F.ws + WS_SA3), (const float*)(F.ws + WS_SWPG)}; pg8::gemm_phase(F.lds, D, S, E); }

constexpr int NPHASE = 13;
__global__ void __launch_bounds__(NWAVES * 64, 2) mk_fwd(Args args) {
    extern __shared__ __attribute__((aligned(16))) unsigned char lds_raw[];
    Frame F;
    F.lds = (LAS unsigned char*)lds_raw;
    F.tid = threadIdx.x; F.lane = F.tid & 63; F.wave = __builtin_amdgcn_readfirstlane(F.tid >> 6);
    F.G = gridDim.x; { const int bx = blockIdx.x; F.vcu = (F.G % 8 == 0) ? (bx % 8) * (F.G / 8) + bx / 8 : bx; }
    F.ws = args.ws; F.ctl = (unsigned*)(args.ws + WS_CTL);
    volatile LAS unsigned* MISC = (volatile LAS unsigned*)(F.lds + MISC_OFF);
    for (int u = F.tid; u < 64; u += NWAVES * 64) MISC[u] = 0u;
    __syncthreads();
    XcdBarrier bar; bar.bar = F.ctl + CW_BAR; bar.x = 0; bar.st = nullptr;
    if (MK_N_LAUNCHES == 1) bar = xcd_barrier_post(F.ctl + CW_BAR, MISC + 8);
    unsigned char* ws = args.ws;
    const int lo = args.ph_lo, hi = args.ph_hi;
#define IN(k) (lo <= (k) && (k) < hi)
#ifndef DUP_PHASE
#define DUP_PHASE -1
#endif
#define SEAM(k) do { if (IN(k) && IN((k) + 1)) xcd_barrier(bar); } while (0)

#define RUN(k, call) do { if (IN(k)) { call; if (DUP_PHASE == (k)) { xcd_barrier(bar); call; } } SEAM(k); } while (0)
    RUN(0, p0_prologue(F, args));
    RUN(1, ph_gemm1(F, args));
    RUN(2, ph_mlstm(F, args));
    RUN(3, ph_norm_swa(F, args));
    RUN(4, ph_ya(F, args));
    RUN(5, ph_mix(F, args));
    RUN(6, ph_h1(F, args));
    RUN(7, route_phase(F, args));
    RUN(8, ph_up(F, args));
    RUN(9, ph_actq(F, args));
    RUN(10, ph_down(F, args));
    RUN(11, ph_combine_pp(F, args));
    if (IN(12)) ph_out(F, args);
#undef RUN
#undef IN
#undef SEAM
}


#ifdef DBG_DUMP
__global__ void dbg_dump(const bf16_t* src, int ld, int coff, float* out) {
    for (size_t i = (size_t)blockIdx.x * blockDim.x + threadIdx.x; i < (size_t)T * D; i += (size_t)gridDim.x * blockDim.x) { const size_t r = i / D, c = i % D; out[i] = bf1(src[r * ld + coff + c]); }
}
#endif
extern "C" void kernel_launch(void* const* d_in, const int* in_sizes, int n_in, void* d_out, int out_size, void* d_ws, size_t ws_size, hipStream_t stream) {
    static int grid = 0;
    if (grid == 0) {
        if (n_in != 23 || in_sizes[0] != T * D || out_size != T * D || ws_size < WS_END) { fprintf(stderr, "kernel_launch: unexpected shapes (n_in %d, in0 %d, out %d, ws %zu; need ws >= %zu); nothing launched\n", n_in, n_in > 0 ? in_sizes[0] : -1, out_size, ws_size, (size_t)WS_END); grid = -1; return; }
        int dev = 0, cus = 0, per_cu = 0;
        if (hipGetDevice(&dev) != hipSuccess || hipDeviceGetAttribute(&cus, hipDeviceAttributeMultiprocessorCount, dev) != hipSuccess) { fprintf(stderr, "kernel_launch: device query failed\n"); grid = -1; return; }
        if (hipFuncSetAttribute((const void*)mk_fwd, hipFuncAttributeMaxDynamicSharedMemorySize, LDS_BYTES) != hipSuccess) { fprintf(stderr, "kernel_launch: hipFuncSetAttribute failed\n"); grid = -1; return; }
        if (hipOccupancyMaxActiveBlocksPerMultiprocessor(&per_cu, (const void*)mk_fwd, NWAVES * 64, LDS_BYTES) != hipSuccess || per_cu < 1) fprintf(stderr, "kernel_launch: occupancy query reports %d workgroups per CU\n", per_cu);
        (void)hipGetLastError();
        grid = cus;
    }
    if (grid < 0) return;
    if (hipMemsetAsync((char*)d_ws + WS_CTL, 0, CTL_ZERO_BYTES, stream) != hipSuccess) { fprintf(stderr, "kernel_launch: memset failed\n"); return; }
    Args a{};
    for (int i = 0; i < 23; ++i) a.in[i] = (const float*)d_in[i];
    a.out = (float*)d_out; a.ws = (unsigned char*)d_ws;
#ifndef DBG_LAST
#define DBG_LAST NPHASE
#endif
    for (int li = 0; li < MK_N_LAUNCHES && li < DBG_LAST; ++li) {
        a.ph_lo = (MK_N_LAUNCHES == 1) ? 0 : li; a.ph_hi = (MK_N_LAUNCHES == 1) ? NPHASE : li + 1;
        hipLaunchKernelGGL(mk_fwd, dim3(grid), dim3(NWAVES * 64), LDS_BYTES, stream, a);
        const hipError_t le = hipPeekAtLastError();
        if (le != hipSuccess) { fprintf(stderr, "kernel_launch: launch %d failed: %s\n", li, hipGetErrorName(le)); break; }
    }
#ifdef DBG_DUMP
    { const bf16_t* s = (const bf16_t*)((unsigned char*)d_ws + DBG_DUMP_OFF); hipLaunchKernelGGL(dbg_dump, dim3(2048), dim3(256), 0, stream, s, DBG_DUMP_LD, DBG_DUMP_COL, (float*)d_out); }
#endif
}
```

```cpp
#include <hip/hip_runtime.h>
#include <cstdio>
#include <cstdint>

#ifndef MK_N_LAUNCHES
#define MK_N_LAUNCHES 1
#endif

#define GAS __attribute__((address_space(1)))
#define LAS __attribute__((address_space(3)))
typedef unsigned short bf16_t;
typedef short bf16x8 __attribute__((ext_vector_type(8)));
typedef short s16x4 __attribute__((ext_vector_type(4)));
typedef float f32x2 __attribute__((ext_vector_type(2)));
typedef float f32x4 __attribute__((ext_vector_type(4)));
typedef float f32x16 __attribute__((ext_vector_type(16)));
typedef unsigned u32x2 __attribute__((ext_vector_type(2)));
typedef unsigned u32x4 __attribute__((ext_vector_type(4)));
typedef int i32x4 __attribute__((ext_vector_type(4)));

constexpr int BATCH = 4, SEQ = 8192, T = BATCH * SEQ, D = 2048;
constexpr int PLE = 256;
constexpr int NE = 32, TOPK = 4, DFF = 2048, CAP = T;
constexpr int NPROJ = 13056;
constexpr int C_MLQ = 0, C_MLK = 1024, C_MLV = 2048, C_MLO = 4096, C_SWQ = 6144, C_SWK = 8192, C_SWV = 8448, C_GA = 8704, C_GB = 10752, C_GI = 12800, C_GF = 12808;
constexpr int DIN = 12816;
constexpr float EPS = 1e-6f;
constexpr float LOG2E = 1.4426950408889634f;
constexpr int ACT_ROWS = 139264;

constexpr size_t MiB = 1u << 20;
constexpr size_t WS_CTL = 0, CTL_ZERO_BYTES = 1 * MiB;
constexpr size_t WS_WIN = 2 * MiB;
constexpr size_t WS_WA = 54 * MiB, WS_WB = 62 * MiB, WS_WOUT = 70 * MiB, WS_WPG = 78 * MiB, WS_WPP = 86 * MiB, WS_WRP = 87 * MiB, WS_SWUP = 88 * MiB, WS_SWIN = 89 * MiB, WS_SA1 = 90 * MiB;
constexpr size_t WS_WUP = 96 * MiB;
constexpr size_t WS_WDN = 608 * MiB;
constexpr size_t WS_XN = 864 * MiB;
constexpr size_t WS_PROJ = 992 * MiB;
constexpr size_t WS_HML = 1808 * MiB;
constexpr size_t WS_ASW = 1936 * MiB;
constexpr size_t WS_YA = 2064 * MiB, WS_MIX = 2192 * MiB;
constexpr size_t WS_H = WS_YA;
constexpr size_t WS_PBF = 2320 * MiB;
constexpr size_t WS_PP = 2336 * MiB;
constexpr size_t WS_ACT = 2464 * MiB;
constexpr size_t WS_YS = 3008 * MiB;
constexpr size_t WS_TOKL = 3520 * MiB, WS_GATEL = 3524 * MiB, WS_DESTL = 3528 * MiB, WS_RSL = 3532 * MiB;
constexpr size_t WS_GATES = 3536 * MiB;
constexpr size_t WS_AMLQ = 3568 * MiB;
constexpr size_t WS_ACTQ = 3632 * MiB;
constexpr size_t WS_AMAX = 3904 * MiB;
constexpr size_t WS_SA3 = 3940 * MiB, WS_SAML = 3941 * MiB, WS_SAD = 3942 * MiB;
constexpr size_t WS_ASWQ = WS_PP;
constexpr size_t WS_ASWQ_OLD_UNUSED = WS_HML;
constexpr size_t WS_SASW = WS_SAML + 524288;
constexpr size_t WS_SWB = 3943 * MiB + 524288;
constexpr size_t WS_AMAXM = WS_MIX + 64 * MiB;
constexpr size_t WS_MIXQ = WS_HML;
constexpr size_t WS_SMIX = WS_SA3 + 524288;
constexpr size_t WS_SWOUT = 3943 * MiB + 786432;
constexpr size_t WS_SWPG = 3943 * MiB, WS_SWA = WS_SWPG + 65536, WS_SWDN = WS_SWPG + 131072;
constexpr size_t WS_END = 3944 * MiB;
constexpr int CW_TMO = 0, CW_CODE = 1;
constexpr int CW_BAR = 4096;
constexpr int CW_CUR = 16384;

constexpr int RING_BYTES = 131072;
constexpr int TAB_OFF = RING_BYTES;
constexpr int MISC_OFF = RING_BYTES + 8192;
constexpr int LDS_BYTES = 147456;
constexpr int NWAVES = 8;

#define RLX_AGENT __ATOMIC_RELAXED, __HIP_MEMORY_SCOPE_AGENT
#define LDS_WAIT() asm volatile("s_waitcnt lgkmcnt(0)" ::: "memory")
#define VM_WAIT() asm volatile("s_waitcnt vmcnt(0)" ::: "memory")
#define WG_BAR() do { asm volatile("s_waitcnt lgkmcnt(0)" ::: "memory"); __builtin_amdgcn_s_barrier(); asm volatile("" ::: "memory"); } while (0)

typedef __bf16 bf16x2_t __attribute__((ext_vector_type(2)));
__device__ __forceinline__ unsigned cvt_pk_bf16(float lo, float hi) { const f32x2 v = {lo, hi}; const bf16x2_t b = __builtin_convertvector(v, bf16x2_t); return __builtin_bit_cast(unsigned, b); }
__device__ __forceinline__ float bf_lo(unsigned w) { return __uint_as_float(w << 16); }
__device__ __forceinline__ float bf_hi(unsigned w) { return __uint_as_float(w & 0xffff0000u); }
__device__ __forceinline__ float bf1(bf16_t b) { return __uint_as_float(((unsigned)b) << 16); }
__device__ __forceinline__ float sigmoidf_(float x) { return __builtin_amdgcn_rcpf(1.0f + __expf(-x)); }
__device__ __forceinline__ unsigned q8x4m(const f32x4 v, const float qs) {
    const float M = 12582912.0f;
    const unsigned a = __float_as_uint(__builtin_fmaf(v.x, qs, M)), b = __float_as_uint(__builtin_fmaf(v.y, qs, M)), c = __float_as_uint(__builtin_fmaf(v.z, qs, M)), d = __float_as_uint(__builtin_fmaf(v.w, qs, M));
    const unsigned lo = __builtin_amdgcn_perm(b, a, 0x0c0c0400u), hi = __builtin_amdgcn_perm(d, c, 0x0c0c0400u);
    return __builtin_amdgcn_perm(hi, lo, 0x05040100u);
}
__device__ __forceinline__ unsigned q8x4(const f32x4 t) { return q8x4m(t, 1.0f); }
__device__ __forceinline__ float xmax_16_32(float m) {
    const auto r = __builtin_amdgcn_permlane16_swap(__float_as_uint(m), __float_as_uint(m), false, false); m = fmaxf(__uint_as_float(r[0]), __uint_as_float(r[1]));
    const auto s = __builtin_amdgcn_permlane32_swap(__float_as_uint(m), __float_as_uint(m), false, false); return fmaxf(__uint_as_float(s[0]), __uint_as_float(s[1]));
}
__device__ __forceinline__ float amax4(float m, const f32x4 v) { return fmaxf(fmaxf(m, fmaxf(fabsf(v.x), fabsf(v.y))), fmaxf(fabsf(v.z), fabsf(v.w))); }
__device__ __forceinline__ float wave_max(float v) {
#pragma unroll
    for (int o = 1; o < 64; o <<= 1) v = fmaxf(v, __shfl_xor(v, o));
    return v;
}
__device__ __forceinline__ float wave_sum(float v) {
#pragma unroll
    for (int o = 1; o < 64; o <<= 1) v += __shfl_xor(v, o);
    return v;
}

namespace pg8 {
constexpr int BM = 256, BK = 64, HALF = 128, HTB = HALF * BK * 2, STAGE_BYTES = 8 * HTB, NXCD = 8, WGM = 8;
__host__ __device__ __forceinline__ int lds_byte(int r, int c) { const int st = (r >> 4) * 2 + (c >> 5), rr = r & 15, cc = c & 31, ob = rr * 64 + cc * 2; return st * 1024 + (ob ^ (((ob >> 9) & 1) << 5)); }
__host__ __device__ __forceinline__ void stage_rc(int b, int& R, int& C) { const int st = b / 1024, sb = b % 1024, swz = sb ^ (((sb >> 9) & 1) << 5); R = (st >> 1) * 16 + swz / 64; C = (st & 1) * 32 + (swz % 64) / 2; }
__host__ __device__ __forceinline__ int perm32(int rho) { const int n = rho >> 4, i = rho & 15; return 8 * (i >> 2) + 4 * n + (i & 3); }

struct Unit { int pm, pn, e, r0, cnt; };

__device__ __forceinline__ void map_unit(int L, int nM, int nN, int& pm, int& pn) {
    const int nwg = nM * nN;
    int wgid = L; { const int q = nwg / NXCD, r = nwg % NXCD, xcd = wgid % NXCD, off = wgid / NXCD; wgid = (xcd < r ? xcd * (q + 1) : r * (q + 1) + (xcd - r) * q) + off; }
    const int nig = WGM * nN, gid = wgid / nig, fm = gid * WGM, gsz = (nM - fm) < WGM ? (nM - fm) : WGM;
    pm = fm + ((wgid % nig) % gsz); pn = (wgid % nig) / gsz;
}

struct DenseSched {
    static constexpr bool GATHER = false;
    const bf16_t* A; const bf16_t* Bt; int nM, nN, G, c;
    __device__ __forceinline__ bool next(int i, Unit& u) const { const long L = (long)i * G + c; if (L >= (long)nM * nN) return false; map_unit((int)L, nM, nN, u.pm, u.pn); u.e = 0; u.r0 = 0; u.cnt = 0; return true; }
    __device__ __forceinline__ const char* a_base() const { return (const char*)A; }
    __device__ __forceinline__ void a_offs(const Unit& u, const int (&R)[2], const int (&C)[2], int Kb, unsigned (&vo)[2][2]) const {
#pragma unroll
        for (int h = 0; h < 2; ++h)
#pragma unroll
            for (int i = 0; i < 2; ++i) vo[h][i] = (unsigned)(u.pm * BM + h * HALF + R[i]) * (unsigned)Kb + (unsigned)C[i] * 2u;
    }
    __device__ __forceinline__ const char* a_tile(const Unit& u, int Kb) const { return (const char*)A + (size_t)u.pm * BM * Kb; }
    __device__ __forceinline__ const char* b_tile(const Unit& u, int Kb) const { return (const char*)Bt + (size_t)u.pn * BM * Kb; }
};
template <bool I8> struct AccSel { typedef f32x4 type; };
template <> struct AccSel<true> { typedef i32x4 type; };

template <bool I8> __device__ __forceinline__ typename AccSel<I8>::type mma1(const bf16x8 a, const bf16x8 b, const typename AccSel<I8>::type c) {
    if constexpr (I8) return __builtin_amdgcn_mfma_i32_16x16x64_i8(__builtin_bit_cast(i32x4, a), __builtin_bit_cast(i32x4, b), c, 0, 0, 0);
    else return __builtin_amdgcn_mfma_f32_16x16x32_bf16(a, b, c, 0, 0, 0);
}
struct NoHook { __device__ __forceinline__ void operator()(int) const {} };
template <class Epi, class Sched, class Hook = NoHook>
__device__ __forceinline__ void gemm_phase(LAS unsigned char* lds, const int Kb, const Sched& S, const Epi& E, const Hook& H = Hook()) {
    constexpr bool I8 = Epi::I8;
    typedef typename AccSel<I8>::type acc_t;
    const int tid = threadIdx.x, wid = __builtin_amdgcn_readfirstlane(tid >> 6), lane = tid & 63, wr = wid >> 2, wc = wid & 3, fr = lane & 15, fq = lane >> 4;
    const int K = Kb;
    const int nt = Kb / (BK * 2);
    int Rr[2], Cc[2]; unsigned voffB[2];
#pragma unroll
    for (int i = 0; i < 2; ++i) { int R, C; stage_rc(tid * 16 + i * 8192, R, C); Rr[i] = R; Cc[i] = C; const int Rb = Epi::PERM ? ((R & ~31) + perm32(R & 31)) : R; voffB[i] = (unsigned)(Rb * Kb + C * 2); }
    const size_t kstep = (size_t)(BK * 2);
    const size_t hstep = (size_t)HALF * Kb;
    const unsigned ldsw = (unsigned)wid * 1024u;
    const int aoff = lds_byte(wr * 64 + fr, fq * 8), boff = lds_byte(wc * 32 + fr, fq * 8);
#define PG8_SA(b, h) (((b) * 2 + (h)) * HTB)
#define PG8_SB(b, h) ((4 + (b) * 2 + (h)) * HTB)
#define PG8_STAGE(bufoff, gbase, voff) do { _Pragma("unroll") for (int _i = 0; _i < 2; ++_i) \
        __builtin_amdgcn_global_load_lds((const unsigned*)((const char*)(gbase) + (voff)[_i]), (LAS unsigned*)(lds + (bufoff) + ldsw + _i * 8192), 16, 0, 0); } while (0)
#define PG8_LDA(dst, b, h) do { _Pragma("unroll") for (int m = 0; m < 4; ++m) _Pragma("unroll") for (int k = 0; k < 2; ++k) dst[m][k] = *(const LAS bf16x8*)(lds + PG8_SA(b, h) + aoff + m * 2048 + k * 1024); } while (0)
#define PG8_LDB(dst, b, h) do { _Pragma("unroll") for (int n = 0; n < 2; ++n) _Pragma("unroll") for (int k = 0; k < 2; ++k) dst[n][k] = *(const LAS bf16x8*)(lds + PG8_SB(b, h) + boff + n * 2048 + k * 1024); } while (0)
#define PG8_MMA(ai, bj, At, Bt) do { __builtin_amdgcn_s_setprio(1); _Pragma("unroll") for (int m = 0; m < 4; ++m) _Pragma("unroll") for (int n = 0; n < 2; ++n) _Pragma("unroll") for (int k = 0; k < 2; ++k) \
        acc[ai][bj][m][n] = mma1<I8>(Bt[n][k], At[m][k], acc[ai][bj][m][n]); __builtin_amdgcn_s_setprio(0); } while (0)
#define PG8_WAIT_V(n) asm volatile("s_waitcnt vmcnt(" #n ")" ::: "memory")
#define PG8_WAIT_L(n) asm volatile("s_waitcnt lgkmcnt(" #n ")" ::: "memory")
#define PG8_BAR __builtin_amdgcn_s_barrier()
#define PG8_SCHED __builtin_amdgcn_sched_barrier(0)
    Unit cur, nxt; int ui = 0;
    if (!S.next(0, cur)) return;
    acc_t acc[2][2][4][2];
#pragma unroll
    for (int a = 0; a < 2; ++a)
#pragma unroll
        for (int b = 0; b < 2; ++b)
#pragma unroll
            for (int m = 0; m < 4; ++m)
#pragma unroll
                for (int n = 0; n < 2; ++n) acc[a][b][m][n] = (acc_t){0, 0, 0, 0};
    bf16x8 At[4][2], B0[2][2], B1[2][2];
    constexpr bool GA = Sched::GATHER;
    unsigned cvo[2][2], nvo[2][2];
    if constexpr (GA) S.a_offs(cur, Rr, Cc, K, cvo);
    else {
#pragma unroll
        for (int h = 0; h < 2; ++h)
#pragma unroll
            for (int i = 0; i < 2; ++i) cvo[h][i] = (unsigned)(h * HALF + Rr[i]) * (unsigned)Kb + (unsigned)Cc[i] * 2u;
    }
    const char* cA = S.a_tile(cur, K);
    const char* cB = S.b_tile(cur, K);
    PG8_STAGE(PG8_SB(0, 0), cB, voffB); PG8_STAGE(PG8_SB(0, 1), cB + hstep, voffB); PG8_STAGE(PG8_SA(0, 0), cA, cvo[0]); PG8_STAGE(PG8_SA(0, 1), cA, cvo[1]);
    if (wr == 1) PG8_BAR;
    PG8_WAIT_V(2); PG8_BAR;
    PG8_STAGE(PG8_SB(1, 0), cB + kstep, voffB); PG8_STAGE(PG8_SA(1, 0), cA + kstep, cvo[0]); PG8_STAGE(PG8_SB(1, 1), cB + hstep + kstep, voffB);
    PG8_WAIT_V(6); PG8_BAR;
    for (;;) {
        const bool has_next = S.next(ui + 1, nxt);
        const char* nB = cB; const char* nA = cA;
        if (has_next) { if constexpr (GA) S.a_offs(nxt, Rr, Cc, K, nvo); nB = S.b_tile(nxt, K); nA = S.a_tile(nxt, K); }
        else if constexpr (GA) {
#pragma unroll
            for (int h = 0; h < 2; ++h)
#pragma unroll
                for (int i = 0; i < 2; ++i) nvo[h][i] = cvo[h][i];
        }
        for (int t = 0; t < nt; t += 2) {
            const bool last = (t == nt - 2);
            const char* a1 = cA + (size_t)(t + 1) * kstep;
            const char* a2 = last ? nA : cA + (size_t)(t + 2) * kstep; const char* b2 = last ? nB : cB + (size_t)(t + 2) * kstep;
            const char* a3 = a2 + kstep; const char* b3 = b2 + kstep;
#define PG8_O2(h) (GA ? (last ? nvo[h] : cvo[h]) : cvo[h])
            PG8_LDB(B0, 0, 0); PG8_LDB(B1, 0, 1); PG8_SCHED; PG8_LDA(At, 0, 0); PG8_STAGE(PG8_SA(1, 1), a1, cvo[1]);
            PG8_WAIT_V(8); PG8_WAIT_L(0); PG8_BAR; PG8_MMA(0, 0, At, B0); PG8_MMA(0, 1, At, B1); PG8_BAR; PG8_SCHED;
            PG8_LDA(At, 0, 1); PG8_STAGE(PG8_SB(0, 0), b2, voffB); PG8_STAGE(PG8_SB(0, 1), b2 + hstep, voffB); PG8_STAGE(PG8_SA(0, 0), a2, PG8_O2(0));
            PG8_WAIT_V(8); PG8_WAIT_L(0); PG8_BAR; PG8_MMA(1, 0, At, B0); PG8_MMA(1, 1, At, B1); PG8_BAR; PG8_SCHED;
            PG8_LDB(B0, 1, 0); PG8_LDB(B1, 1, 1); PG8_SCHED; PG8_LDA(At, 1, 0); PG8_STAGE(PG8_SA(0, 1), a2, PG8_O2(1));
            PG8_WAIT_V(8); PG8_WAIT_L(0); PG8_BAR; PG8_MMA(0, 0, At, B0); PG8_MMA(0, 1, At, B1); PG8_BAR; PG8_SCHED;
            PG8_LDA(At, 1, 1); PG8_STAGE(PG8_SB(1, 0), b3, voffB); PG8_STAGE(PG8_SB(1, 1), b3 + hstep, voffB); PG8_STAGE(PG8_SA(1, 0), a3, PG8_O2(0));
            PG8_WAIT_V(8); PG8_WAIT_L(0); PG8_BAR; PG8_MMA(1, 0, At, B0); PG8_MMA(1, 1, At, B1); PG8_BAR; PG8_SCHED;
#undef PG8_O2
        }
        if (wr == 0) PG8_BAR;
        E(acc, cur, wr, wc, fr, fq);
        __builtin_amdgcn_sched_barrier(0); H(ui); __builtin_amdgcn_sched_barrier(0);
        if (!has_next) break;
#pragma unroll
        for (int a = 0; a < 2; ++a)
#pragma unroll
            for (int b = 0; b < 2; ++b)
#pragma unroll
                for (int m = 0; m < 4; ++m)
#pragma unroll
                    for (int n = 0; n < 2; ++n) acc[a][b][m][n] = (acc_t){0, 0, 0, 0};
        cur = nxt; cB = nB; cA = nA; ++ui;
        if constexpr (GA) {
#pragma unroll
            for (int h = 0; h < 2; ++h)
#pragma unroll
                for (int i = 0; i < 2; ++i) cvo[h][i] = nvo[h][i];
        }
        if (wr == 1) PG8_BAR;
    }
    PG8_WAIT_V(0);
    PG8_BAR;
#undef PG8_SA
#undef PG8_SB
#undef PG8_STAGE
#undef PG8_LDA
#undef PG8_LDB
#undef PG8_MMA
#undef PG8_WAIT_V
#undef PG8_WAIT_L
#undef PG8_BAR
#undef PG8_SCHED
}

#define ROWSEL(v0, v1, ai, m, fr) __shfl((ai) ? (v1) : (v0), (m) * 16 + (fr))
__device__ __forceinline__ u32x4 pack8(const f32x4 v0, const f32x4 v1) { u32x4 w; w.x = cvt_pk_bf16(v0[0], v0[1]); w.y = cvt_pk_bf16(v0[2], v0[3]); w.z = cvt_pk_bf16(v1[0], v1[1]); w.w = cvt_pk_bf16(v1[2], v1[3]); return w; }
__device__ __forceinline__ void unpack8(const u32x4 w, f32x4& v0, f32x4& v1) { v0 = (f32x4){bf_lo(w.x), bf_hi(w.x), bf_lo(w.y), bf_hi(w.y)}; v1 = (f32x4){bf_lo(w.z), bf_hi(w.z), bf_lo(w.w), bf_hi(w.w)}; }
__device__ __forceinline__ f32x4 ub4(const unsigned w) { return (f32x4){(float)(w & 0xffu), (float)((w >> 8) & 0xffu), (float)((w >> 16) & 0xffu), (float)(w >> 24)} * (1.0f / 255.0f); }
__device__ __forceinline__ bool gate_tile(int pn) { return (pn >= C_MLO / 256 && pn < (C_MLO + 2048) / 256) || (pn >= C_GA / 256 && pn < (C_GB + 2048) / 256); }
__device__ __forceinline__ f32x4 sig4(const f32x4 v) { return (f32x4){sigmoidf_(v[0]), sigmoidf_(v[1]), sigmoidf_(v[2]), sigmoidf_(v[3])}; }

struct EpiStoreBf16 {
    static constexpr bool PERM = true, I8 = false;
    bf16_t* O; int ldc;
    __device__ __forceinline__ void operator()(const f32x4 (&acc)[2][2][4][2], const Unit& u, int wr, int wc, int fr, int fq) const {
        const int row0 = u.pm * BM + wr * 64 + fr, col0 = u.pn * BM + wc * 32 + 8 * fq;
#pragma unroll
        for (int ai = 0; ai < 2; ++ai)
#pragma unroll
            for (int m = 0; m < 4; ++m) { bf16_t* rowp = O + (size_t)(row0 + ai * HALF + m * 16) * ldc + col0;
#pragma unroll
                for (int bj = 0; bj < 2; ++bj) *(u32x4*)(rowp + bj * HALF) = pack8(acc[ai][bj][m][0], acc[ai][bj][m][1]); }
    }
};
struct EpiStoreQ8 {
    static constexpr bool PERM = true, I8 = false;
    signed char* O; float* omax;
    __device__ __forceinline__ void operator()(const f32x4 (&acc)[2][2][4][2], const Unit& u, int wr, int wc, int fr, int fq) const {
        const int row0 = u.pm * BM + wr * 64 + fr, col0 = u.pn * BM + wc * 32 + 8 * fq;
#pragma unroll
        for (int ai = 0; ai < 2; ++ai)
#pragma unroll
            for (int m = 0; m < 4; ++m) { const size_t row = (size_t)(row0 + ai * HALF + m * 16);
#pragma unroll
                for (int bj = 0; bj < 2; ++bj) { const f32x4 v0 = acc[ai][bj][m][0], v1 = acc[ai][bj][m][1];
                    const float mx = xmax_16_32(amax4(amax4(0.f, v0), v1)); const float qb = 127.0f * __builtin_amdgcn_rcpf(fmaxf(mx, 1e-30f));
                    u32x2 ov; ov.x = q8x4m(v0, qb); ov.y = q8x4m(v1, qb); *(u32x2*)(O + row * D + col0 + bj * HALF) = ov;
                    if (fq == 0) omax[row * 64 + u.pn * 8 + bj * 4 + wc] = mx; } }
    }
};
struct EpiProjI8 {
    static constexpr bool PERM = true, I8 = true;
    bf16_t* O; int ldc; const float* sa; const float* sw;
    __device__ __forceinline__ void operator()(const i32x4 (&acc)[2][2][4][2], const Unit& u, int wr, int wc, int fr, int fq) const {
        const int row0 = u.pm * BM + wr * 64 + fr, col0 = u.pn * BM + wc * 32 + 8 * fq;
        f32x4 sc[2][2];
#pragma unroll
        for (int bj = 0; bj < 2; ++bj)
#pragma unroll
            for (int n = 0; n < 2; ++n) sc[bj][n] = *(const f32x4*)(sw + col0 + bj * HALF + 4 * n);
        const int ln = fr + 16 * fq; const float rs0 = sa[u.pm * BM + wr * 64 + ln], rs1 = sa[u.pm * BM + HALF + wr * 64 + ln];
        const bool gt = gate_tile(u.pn);
#pragma unroll
        for (int ai = 0; ai < 2; ++ai)
#pragma unroll
            for (int m = 0; m < 4; ++m) { const int row = row0 + ai * HALF + m * 16; const float rs = ROWSEL(rs0, rs1, ai, m, fr); bf16_t* rowp = O + (size_t)row * ldc + col0;
                if (gt) { unsigned char* gp = (unsigned char*)(O + (size_t)row * ldc + u.pn * BM) + wc * 32 + 8 * fq;
#pragma unroll
                    for (int bj = 0; bj < 2; ++bj) { u32x2 o; o.x = q8x4m(sig4(__builtin_convertvector(acc[ai][bj][m][0], f32x4) * rs * sc[bj][0]), 255.0f); o.y = q8x4m(sig4(__builtin_convertvector(acc[ai][bj][m][1], f32x4) * rs * sc[bj][1]), 255.0f); *(u32x2*)(gp + bj * HALF) = o; } }
                else {
#pragma unroll
                for (int bj = 0; bj < 2; ++bj) *(u32x4*)(rowp + bj * HALF) = pack8(__builtin_convertvector(acc[ai][bj][m][0], f32x4) * rs * sc[bj][0], __builtin_convertvector(acc[ai][bj][m][1], f32x4) * rs * sc[bj][1]); } }
    }
};
template <bool ADD, bool I8_, bool Q8OUT = false> struct EpiGate {
    static constexpr bool PERM = true, I8 = I8_;
    typedef typename AccSel<I8_>::type acc_t;
    bf16_t* O; const bf16_t* Gt; int ldg; const bf16_t* Y; const float* sa; const float* sw; float* omax;
    __device__ __forceinline__ void operator()(const acc_t (&acc)[2][2][4][2], const Unit& u, int wr, int wc, int fr, int fq) const {
        const int row0 = u.pm * BM + wr * 64 + fr, col0 = u.pn * BM + wc * 32 + 8 * fq;
        f32x4 sc[2][2];
#pragma unroll
        for (int bj = 0; bj < 2; ++bj)
#pragma unroll
            for (int n = 0; n < 2; ++n) sc[bj][n] = I8_ ? *(const f32x4*)(sw + col0 + bj * HALF + 4 * n) : (f32x4){1.f, 1.f, 1.f, 1.f};
        const int ln = fr + 16 * fq; float rs0 = 1.f, rs1 = 1.f; if (I8_) { rs0 = sa[u.pm * BM + wr * 64 + ln]; rs1 = sa[u.pm * BM + HALF + wr * 64 + ln]; }
        u32x2 gwb[2][2][2];
#define EG_LOAD(buf, b_) do { _Pragma("unroll") for (int mm = 0; mm < 2; ++mm) _Pragma("unroll") for (int bj = 0; bj < 2; ++bj) { const size_t row = (size_t)(row0 + ((b_) >> 1) * HALF + (2 * ((b_) & 1) + mm) * 16); \
            gwb[buf][mm][bj] = *(const u32x2*)((const unsigned char*)(Gt + row * ldg + u.pn * BM) + wc * 32 + 8 * fq + bj * HALF); } } while (0)
        EG_LOAD(0, 0);
#pragma unroll
        for (int b = 0; b < 4; ++b) { const int ai = b >> 1, mp = b & 1;
                u32x4 yw[2][2];
                if (ADD) {
#pragma unroll
                    for (int mm = 0; mm < 2; ++mm)
#pragma unroll
                        for (int bj = 0; bj < 2; ++bj) { const size_t row = (size_t)(row0 + ai * HALF + (2 * mp + mm) * 16); yw[mm][bj] = *(const u32x4*)(Y + row * D + col0 + bj * HALF); } }
                if (b + 1 < 4) EG_LOAD((b + 1) & 1, b + 1);
                __builtin_amdgcn_sched_barrier(0);
                u32x2 (&gw)[2][2] = gwb[b & 1];
#pragma unroll
                for (int mm = 0; mm < 2; ++mm) { const int m = 2 * mp + mm; const size_t row = (size_t)(row0 + ai * HALF + m * 16); const float rs = I8_ ? ROWSEL(rs0, rs1, ai, m, fr) : 1.f;
#pragma unroll
                    for (int bj = 0; bj < 2; ++bj) { const f32x4 g0 = ub4(gw[mm][bj].x), g1 = ub4(gw[mm][bj].y);
                        f32x4 a0, a1; if constexpr (I8_) { a0 = __builtin_convertvector(acc[ai][bj][m][0], f32x4) * rs * sc[bj][0]; a1 = __builtin_convertvector(acc[ai][bj][m][1], f32x4) * rs * sc[bj][1]; } else { a0 = acc[ai][bj][m][0]; a1 = acc[ai][bj][m][1]; }
                        f32x4 v0 = g0 * a0, v1 = g1 * a1;
                        if (ADD) { f32x4 y0, y1; unpack8(yw[mm][bj], y0, y1); v0 += y0; v1 += y1; }
                        if constexpr (Q8OUT) { const float mx = xmax_16_32(amax4(amax4(0.f, v0), v1)); const float qb = 127.0f * __builtin_amdgcn_rcpf(fmaxf(mx, 1e-30f));
                            u32x2 ov; ov.x = q8x4m(v0, qb); ov.y = q8x4m(v1, qb); *(u32x2*)((signed char*)O + row * D + col0 + bj * HALF) = ov;
                            if (fq == 0) omax[row * 64 + u.pn * 8 + bj * 4 + wc] = mx; }
                        else *(u32x4*)(O + row * D + col0 + bj * HALF) = pack8(v0, v1); } } }
#undef EG_LOAD
    }
};
struct EpiResF32 {
    static constexpr bool PERM = true, I8 = true;
    const float* X; bf16_t* O; const float* sa; const float* sw;
    __device__ __forceinline__ void operator()(const i32x4 (&acc)[2][2][4][2], const Unit& u, int wr, int wc, int fr, int fq) const {
        const int row0 = u.pm * BM + wr * 64 + fr, col0 = u.pn * BM + wc * 32 + 8 * fq;
        f32x4 sc[2][2];
#pragma unroll
        for (int bj = 0; bj < 2; ++bj)
#pragma unroll
            for (int n = 0; n < 2; ++n) sc[bj][n] = *(const f32x4*)(sw + col0 + bj * HALF + 4 * n);
        const int ln = fr + 16 * fq; const float rs0 = sa[u.pm * BM + wr * 64 + ln], rs1 = sa[u.pm * BM + HALF + wr * 64 + ln];
#pragma unroll
        for (int ai = 0; ai < 2; ++ai)
#pragma unroll
            for (int mp = 0; mp < 2; ++mp) { f32x4 xv[2][2][2];
#pragma unroll
                for (int mm = 0; mm < 2; ++mm)
#pragma unroll
                    for (int bj = 0; bj < 2; ++bj)
#pragma unroll
                        for (int n = 0; n < 2; ++n) xv[mm][bj][n] = *(const f32x4*)(X + (size_t)(row0 + ai * HALF + (2 * mp + mm) * 16) * D + col0 + bj * HALF + n * 4);
                __builtin_amdgcn_sched_barrier(0);
#pragma unroll
                for (int mm = 0; mm < 2; ++mm) { const int m = 2 * mp + mm; const float rs = ROWSEL(rs0, rs1, ai, m, fr);
#pragma unroll
                    for (int bj = 0; bj < 2; ++bj) *(u32x4*)(O + (size_t)(row0 + ai * HALF + m * 16) * D + col0 + bj * HALF) =
                        pack8(xv[mm][bj][0] + __builtin_convertvector(acc[ai][bj][m][0], f32x4) * rs * sc[bj][0], xv[mm][bj][1] + __builtin_convertvector(acc[ai][bj][m][1], f32x4) * rs * sc[bj][1]); } }
    }
};
struct EpiPle {
    static constexpr bool PERM = true, I8 = true;
    float* O; const bf16_t* Hb; const signed char* PP; const float* ppm; const float* sa; const float* sw;
    __device__ __forceinline__ void operator()(const i32x4 (&acc)[2][2][4][2], const Unit& u, int wr, int wc, int fr, int fq) const {
        const int row0 = u.pm * BM + wr * 64 + fr, col0 = u.pn * BM + wc * 32 + 8 * fq;
        f32x4 sc[2][2];
#pragma unroll
        for (int bj = 0; bj < 2; ++bj)
#pragma unroll
            for (int n = 0; n < 2; ++n) sc[bj][n] = *(const f32x4*)(sw + col0 + bj * HALF + n * 4);
        const int ln = fr + 16 * fq; const float rs0 = sa[u.pm * BM + wr * 64 + ln], rs1 = sa[u.pm * BM + HALF + wr * 64 + ln];
#pragma unroll
        for (int ai = 0; ai < 2; ++ai)
#pragma unroll
            for (int mp = 0; mp < 2; ++mp) { u32x4 hv[2][2]; u32x2 pw[2][2]; float ps[2][2];
#pragma unroll
                for (int mm = 0; mm < 2; ++mm)
#pragma unroll
                    for (int bj = 0; bj < 2; ++bj) { const size_t rw = (size_t)(row0 + ai * HALF + (2 * mp + mm) * 16), o = rw * D + col0 + bj * HALF; hv[mm][bj] = *(const u32x4*)(Hb + o); pw[mm][bj] = *(const u32x2*)(PP + o); ps[mm][bj] = ppm[rw * 64 + u.pn * 8 + bj * 4 + wc]; }
                __builtin_amdgcn_sched_barrier(0);
#pragma unroll
                for (int mm = 0; mm < 2; ++mm) { const int m = 2 * mp + mm; const float rs = ROWSEL(rs0, rs1, ai, m, fr);
#pragma unroll
                    for (int bj = 0; bj < 2; ++bj) { const size_t o = (size_t)(row0 + ai * HALF + m * 16) * D + col0 + bj * HALF; f32x4 h0, h1; unpack8(hv[mm][bj], h0, h1); const int w0 = (int)pw[mm][bj].x, w1 = (int)pw[mm][bj].y; const float pq = ps[mm][bj] * (1.0f / 127.0f);
                        const f32x4 p0 = (f32x4){(float)((w0 << 24) >> 24), (float)((w0 << 16) >> 24), (float)((w0 << 8) >> 24), (float)(w0 >> 24)} * pq, p1 = (f32x4){(float)((w1 << 24) >> 24), (float)((w1 << 16) >> 24), (float)((w1 << 8) >> 24), (float)(w1 >> 24)} * pq;
                        *(f32x4*)(O + o) = h0 + sig4(__builtin_convertvector(acc[ai][bj][m][0], f32x4) * rs * sc[bj][0]) * p0;
                        *(f32x4*)(O + o + 4) = h1 + sig4(__builtin_convertvector(acc[ai][bj][m][1], f32x4) * rs * sc[bj][1]) * p1; } } }
    }
};
}

#define XB_TMO      128
#define XB_XCNT(j)  (256  + 64 * (j))
#define XB_XSUB(j)  (1280 + 64 * (j))
#define XB_XGEN(j)  (2304 + 64 * (j))
#define XB_TOP      3328
#define XB_TOPGEN   3392
#define XCD_BAR_WORDS 3456
#define XB_SPIN_CAP (1u << 22)

__device__ __forceinline__ unsigned xb_ld(unsigned* p)              { return __hip_atomic_load(p, __ATOMIC_RELAXED, __HIP_MEMORY_SCOPE_AGENT); }
__device__ __forceinline__ unsigned xb_add(unsigned* p, unsigned v) { return __hip_atomic_fetch_add(p, v, __ATOMIC_RELAXED, __HIP_MEMORY_SCOPE_AGENT); }
__device__ __forceinline__ unsigned xb_xcc_id() { return (unsigned)__builtin_amdgcn_s_getreg((3 << 11) | 20) & 0xFu; }
#define XB_SPIN(cond, bar) do { unsigned _sp = 0; while (cond) { __builtin_amdgcn_s_sleep(1); \
    if ((++_sp & 255u) == 0u) { if (xb_ld(&(bar)[XB_TMO])) break; if (_sp > XB_SPIN_CAP) { atomicAdd(&(bar)[XB_TMO], 1u); break; } } } } while (0)

struct XcdBarrier { unsigned* bar; unsigned x; volatile LAS unsigned* st; };

__device__ __forceinline__ XcdBarrier xcd_barrier_post(unsigned* bar, volatile LAS unsigned* st) {
    XcdBarrier b; b.bar = bar; b.x = xb_xcc_id(); b.st = st;
    if (threadIdx.x == 0) (void)xb_add(&bar[XB_XCNT(b.x)], 1u);
    return b;
}
__device__ __forceinline__ void xcd_barrier_complete(unsigned* bar, unsigned x, unsigned& nloc, unsigned& nx) {
    const unsigned G = gridDim.x * gridDim.y * gridDim.z;
    unsigned sum, cnt, mine, sp = 0u;
    for (;;) {
        sum = 0u; cnt = 0u; mine = 0u;
#pragma unroll
        for (unsigned j = 0; j < 16; ++j) { const unsigned c = xb_ld(&bar[XB_XCNT(j)]); sum += c; cnt += (c > 0u) ? 1u : 0u; mine = (j == x) ? c : mine; }
        if (sum == G) break;
        __builtin_amdgcn_s_sleep(1);
        if ((++sp & 255u) == 0u) { if (xb_ld(&bar[XB_TMO])) break; if (sp > XB_SPIN_CAP) { atomicAdd(&bar[XB_TMO], 1u); break; } }
    }
    nloc = mine > 0u ? mine : 1u; nx = cnt > 0u ? cnt : 1u;
}
__device__ __forceinline__ void xcd_barrier(const XcdBarrier& b) {
    asm volatile("s_waitcnt vmcnt(0)" ::: "memory");
    __syncthreads();
    if (threadIdx.x == 0) {
        unsigned* bar = b.bar;
        __builtin_amdgcn_s_waitcnt(0);
        unsigned nloc = b.st[0], nx = b.st[1];
        if (nloc == 0u) { xcd_barrier_complete(bar, b.x, nloc, nx); b.st[0] = nloc; b.st[1] = nx; }
        const unsigned old = xb_add(&bar[XB_XSUB(b.x)], 1u);
        const unsigned gen = old / nloc;
        if (old + 1u == (gen + 1u) * nloc) {
            __builtin_amdgcn_fence(__ATOMIC_RELEASE, "agent");
            asm volatile("s_waitcnt vmcnt(0)" ::: "memory");
            const unsigned og = xb_add(&bar[XB_TOP], 1u);
            const unsigned tg = og / nx;
            if (og + 1u == (tg + 1u) * nx) xb_add(&bar[XB_TOPGEN], 1u);
            else XB_SPIN(xb_ld(&bar[XB_TOPGEN]) == tg, bar);
            __builtin_amdgcn_fence(__ATOMIC_ACQUIRE, "agent");
            xb_add(&bar[XB_XGEN(b.x)], 1u);
            asm volatile("s_waitcnt vmcnt(0)" ::: "memory");
        } else {
            XB_SPIN(xb_ld(&bar[XB_XGEN(b.x)]) == gen, bar);
            __builtin_amdgcn_fence(__ATOMIC_ACQUIRE, "agent");
            asm volatile("s_waitcnt vmcnt(0)" ::: "memory");
        }
    }
    __syncthreads();
}

struct Frame {
    LAS unsigned char* lds;
    unsigned* ctl;
    int tid, lane, wave, vcu, G;
    unsigned char* ws;
};
struct Args { const float* in[23]; float* out; unsigned char* ws; int ph_lo, ph_hi; };

template <class RowMap>
__device__ __forceinline__ void transpose_item(const float* W, int K, int N, bf16_t* WT, const RowMap rm, LAS float* scr, int item, int lane) {
    const int nblk = (N + 31) / 32, kb = item / nblk, nb = item % nblk, k0 = 64 * kb, n0 = 32 * nb;
    const int nc = n0 + (lane & 31); const bool ok = nc < N;
    float tv[32];
#pragma unroll
    for (int i = 0; i < 32; ++i) tv[i] = W[(size_t)(k0 + 2 * i + (lane >> 5)) * N + (ok ? nc : n0)];
#pragma unroll
    for (int i = 0; i < 32; ++i) scr[(2 * i + (lane >> 5)) * 33 + (lane & 31)] = ok ? tv[i] : 0.f;
    LDS_WAIT(); asm volatile("" ::: "memory");
    const int c = lane & 7;
#pragma unroll
    for (int j = 0; j < 4; ++j) { const int n = (lane >> 3) + 8 * j; const LAS float* s = scr + (8 * c) * 33 + n;
        u32x4 o; o.x = cvt_pk_bf16(s[0 * 33], s[1 * 33]); o.y = cvt_pk_bf16(s[2 * 33], s[3 * 33]); o.z = cvt_pk_bf16(s[4 * 33], s[5 * 33]); o.w = cvt_pk_bf16(s[6 * 33], s[7 * 33]);
        if (n0 + n < N) *(u32x4*)(WT + (size_t)rm(n0 + n) * K + k0 + 8 * c) = o; }
    LDS_WAIT(); asm volatile("" ::: "memory");
}
__device__ __forceinline__ int qrow_map(int mode, int n) { if (mode == 1) { const int c = n & 2047, lin = n >> 11; return 256 * (c >> 7) + 128 * lin + (c & 127); } if (mode == 2) return n < 6144 ? n : (n < 6160 ? C_GI + (n - 6144) : n - 16); return n; }
__device__ __forceinline__ int qscale_map(int mode, int n) { return mode == 2 ? qrow_map(2, n) : n; }
__device__ __forceinline__ void quant_panel_wg(const float* W, int N, signed char* WT, float* sw, const int mode, LAS float* wmax, int nb, int wave, int lane) {
    const int n0 = 32 * nb, cq = lane & 7, rg = lane >> 3, nc = n0 + 4 * cq; const bool ok = nc < N;
    const int kbase = 256 * wave + 32 * rg;
    const float* wp = W + (size_t)kbase * N + (ok ? nc : n0);
    f32x4 v[32]; f32x4 mx = (f32x4){0.f, 0.f, 0.f, 0.f};
#pragma unroll
    for (int i = 0; i < 32; ++i) v[i] = *(const f32x4*)(wp + (size_t)i * N);
#pragma unroll
    for (int i = 0; i < 32; ++i) mx = __builtin_elementwise_max(mx, __builtin_elementwise_abs(v[i]));
#pragma unroll
    for (int o = 8; o < 64; o <<= 1) { mx.x = fmaxf(mx.x, __shfl_xor(mx.x, o)); mx.y = fmaxf(mx.y, __shfl_xor(mx.y, o)); mx.z = fmaxf(mx.z, __shfl_xor(mx.z, o)); mx.w = fmaxf(mx.w, __shfl_xor(mx.w, o)); }
    if (lane < 8) *(LAS f32x4*)(wmax + wave * 32 + 4 * cq) = ok ? mx : (f32x4){0.f, 0.f, 0.f, 0.f};
    WG_BAR();
    f32x4 cm = (f32x4){1e-30f, 1e-30f, 1e-30f, 1e-30f};
#pragma unroll
    for (int w = 0; w < 8; ++w) cm = __builtin_elementwise_max(cm, *(const LAS f32x4*)(wmax + w * 32 + 4 * cq));
    const f32x4 qs = (f32x4){127.0f / cm.x, 127.0f / cm.y, 127.0f / cm.z, 127.0f / cm.w};
    if (wave == 0 && lane < 8 && ok) { sw[qscale_map(mode, nc)] = cm.x * (1.0f / 127.0f); sw[qscale_map(mode, nc + 1)] = cm.y * (1.0f / 127.0f); sw[qscale_map(mode, nc + 2)] = cm.z * (1.0f / 127.0f); sw[qscale_map(mode, nc + 3)] = cm.w * (1.0f / 127.0f); }
    if (ok) {
#pragma unroll
        for (int c = 0; c < 4; ++c) { signed char* orow = WT + (size_t)qrow_map(mode, nc + c) * 2048 + kbase; const float q = qs[c];
#pragma unroll
            for (int j = 0; j < 2; ++j) { u32x4 o;
                o.x = q8x4m((f32x4){v[16 * j + 0][c], v[16 * j + 1][c], v[16 * j + 2][c], v[16 * j + 3][c]}, q); o.y = q8x4m((f32x4){v[16 * j + 4][c], v[16 * j + 5][c], v[16 * j + 6][c], v[16 * j + 7][c]}, q);
                o.z = q8x4m((f32x4){v[16 * j + 8][c], v[16 * j + 9][c], v[16 * j + 10][c], v[16 * j + 11][c]}, q); o.w = q8x4m((f32x4){v[16 * j + 12][c], v[16 * j + 13][c], v[16 * j + 14][c], v[16 * j + 15][c]}, q);
                *(u32x4*)(orow + 16 * j) = o; } } }
    WG_BAR();
}
struct MapId { __device__ __forceinline__ int operator()(int n) const { return n; } };
struct MapWin { __device__ __forceinline__ int operator()(int n) const { return n < 6144 ? n : (n < 6160 ? C_GI + (n - 6144) : n - 16); } };
struct MapUp { __device__ __forceinline__ int operator()(int n) const { const int c = n & 2047, lin = n >> 11; return 256 * (c >> 7) + 128 * lin + (c & 127); } };

__device__ __forceinline__ void rms_row_to_bf16(const float* xrow, const float* w, bf16_t* orow, int lane) {
    f32x4 v[4][2]; float s = 0.f;
#pragma unroll
    for (int j = 0; j < 4; ++j)
#pragma unroll
        for (int q = 0; q < 2; ++q) { v[j][q] = *(const f32x4*)(xrow + 512 * j + 8 * lane + 4 * q); s += (v[j][q].x * v[j][q].x + v[j][q].y * v[j][q].y) + (v[j][q].z * v[j][q].z + v[j][q].w * v[j][q].w); }
    const float rstd = 1.0f / sqrtf(wave_sum(s) * (1.f / D) + EPS);
#pragma unroll
    for (int j = 0; j < 4; ++j) { const f32x4 w0 = *(const f32x4*)(w + 512 * j + 8 * lane), w1 = *(const f32x4*)(w + 512 * j + 8 * lane + 4);
        *(u32x4*)(orow + 512 * j + 8 * lane) = pg8::pack8(v[j][0] * rstd * w0, v[j][1] * rstd * w1); }
}

__device__ __forceinline__ void rms_row_to_i8(const float* xrow, const float* w, signed char* orow, float* sa, int lane) {
    f32x4 v[4][2]; float s = 0.f;
#pragma unroll
    for (int j = 0; j < 4; ++j)
#pragma unroll
        for (int q = 0; q < 2; ++q) { v[j][q] = *(const f32x4*)(xrow + 512 * j + 8 * lane + 4 * q); s += (v[j][q].x * v[j][q].x + v[j][q].y * v[j][q].y) + (v[j][q].z * v[j][q].z + v[j][q].w * v[j][q].w); }
    const float rstd = 1.0f / sqrtf(wave_sum(s) * (1.f / D) + EPS);
    float amax = 0.f;
#pragma unroll
    for (int j = 0; j < 4; ++j)
#pragma unroll
        for (int q = 0; q < 2; ++q) { const f32x4 wv = *(const f32x4*)(w + 512 * j + 8 * lane + 4 * q); v[j][q] = v[j][q] * rstd * wv; amax = fmaxf(fmaxf(amax, fmaxf(fabsf(v[j][q].x), fabsf(v[j][q].y))), fmaxf(fabsf(v[j][q].z), fabsf(v[j][q].w))); }
#pragma unroll
    for (int o = 1; o < 64; o <<= 1) amax = fmaxf(amax, __shfl_xor(amax, o));
    amax = fmaxf(amax, 1e-30f); const float qs = 127.0f / amax;
    if (lane == 0) *sa = amax * (1.0f / 127.0f);
#pragma unroll
    for (int j = 0; j < 4; ++j) { u32x2 o;
#pragma unroll
        for (int q = 0; q < 2; ++q) { const f32x4 t = v[j][q] * qs; const unsigned pk = ((unsigned)__float2int_rn(t.x) & 0xffu) | (((unsigned)__float2int_rn(t.y) & 0xffu) << 8) | (((unsigned)__float2int_rn(t.z) & 0xffu) << 16) | (((unsigned)__float2int_rn(t.w) & 0xffu) << 24); if (q == 0) o.x = pk; else o.y = pk; }
        *(u32x2*)(orow + 512 * j + 8 * lane) = o; }
}
constexpr int QJ_SQ = D / 32, QJ_UP = 2 * DFF / 32, QJ_ALL = 4 * QJ_SQ + NE * QJ_UP + NE * QJ_SQ;
constexpr int QJ_P2 = 13 * 128;
constexpr int QJ_HOOK = QJ_ALL - QJ_P2;
__device__ __forceinline__ void quant_job(const Args& a, unsigned char* ws, LAS float* wmax, int job, int wave, int lane) {
    const float* W; signed char* WT; float* sw; int N = D, nb, up = 0;
    int r = job;
    if (r < 4 * QJ_SQ) { const int which = r / QJ_SQ; nb = r % QJ_SQ;
        W = which == 0 ? a.in[10] : which == 1 ? a.in[11] : which == 2 ? a.in[21] : a.in[12];
        WT = (signed char*)(ws + (which == 0 ? WS_WA : which == 1 ? WS_WB : which == 2 ? WS_WPG : WS_WOUT)); sw = (float*)(ws + (which == 0 ? WS_SWA : which == 1 ? WS_SWB : which == 2 ? WS_SWPG : WS_SWOUT)); }
    else { r -= 4 * QJ_SQ;
        if (r < NE * QJ_UP) { const int e = r / QJ_UP; nb = r % QJ_UP; N = 2 * DFF; up = 1; W = a.in[16] + (size_t)e * D * 2 * DFF; WT = (signed char*)(ws + WS_WUP) + (size_t)e * 2 * DFF * D; sw = (float*)(ws + WS_SWUP) + (size_t)e * 2 * DFF; }
        else { r -= NE * QJ_UP; const int e = r / QJ_SQ; nb = r % QJ_SQ; W = a.in[18] + (size_t)e * DFF * D; WT = (signed char*)(ws + WS_WDN) + (size_t)e * D * DFF; sw = (float*)(ws + WS_SWDN) + (size_t)e * D; } }
    quant_panel_wg(W, N, WT, sw, up, wmax, nb, wave, lane);
}
__device__ __forceinline__ void p0_prologue(Frame& F, const Args& a) {
    LAS float* scr = (LAS float*)(F.lds + F.wave * 16384);
    const int gw = F.vcu * NWAVES + F.wave, NGW = F.G * NWAVES;
    unsigned char* ws = F.ws;
    { const float* x = a.in[0]; signed char* xq = (signed char*)(ws + WS_XN); float* sa1 = (float*)(ws + WS_SA1); const int lane = F.lane;
      f32x4 wv[4][2], nx[4][2];
#pragma unroll
      for (int j = 0; j < 4; ++j)
#pragma unroll
          for (int q = 0; q < 2; ++q) { wv[j][q] = *(const f32x4*)(a.in[2] + 512 * j + 8 * lane + 4 * q); nx[j][q] = *(const f32x4*)(x + (size_t)gw * D + 512 * j + 8 * lane + 4 * q); }
      for (int m = gw; m < T; m += NGW) {
          f32x4 v[4][2]; float s = 0.f;
#pragma unroll
          for (int j = 0; j < 4; ++j)
#pragma unroll
              for (int q = 0; q < 2; ++q) { v[j][q] = nx[j][q]; s += (v[j][q].x * v[j][q].x + v[j][q].y * v[j][q].y) + (v[j][q].z * v[j][q].z + v[j][q].w * v[j][q].w); }
          if (m + NGW < T) {
#pragma unroll
              for (int j = 0; j < 4; ++j)
#pragma unroll
                  for (int q = 0; q < 2; ++q) nx[j][q] = *(const f32x4*)(x + (size_t)(m + NGW) * D + 512 * j + 8 * lane + 4 * q); }
          const float rstd = 1.0f / sqrtf(wave_sum(s) * (1.f / D) + EPS); float amax = 0.f;
#pragma unroll
          for (int j = 0; j < 4; ++j)
#pragma unroll
              for (int q = 0; q < 2; ++q) { v[j][q] = v[j][q] * rstd * wv[j][q]; amax = amax4(amax, v[j][q]); }
          amax = fmaxf(wave_max(amax), 1e-30f); const float qs = 127.0f / amax;
          if (lane == 0) sa1[m] = amax * (1.0f / 127.0f);
#pragma unroll
          for (int j = 0; j < 4; ++j) { u32x2 o; o.x = q8x4m(v[j][0], qs); o.y = q8x4m(v[j][1], qs); *(u32x2*)(xq + (size_t)m * D + 512 * j + 8 * lane) = o; } } }
    { const float* p = a.in[1]; bf16_t* pb = (bf16_t*)(ws + WS_PBF);
      const size_t stride = (size_t)NGW * 64 * 8, total = (size_t)T * PLE;
      for (size_t i0 = ((size_t)gw * 64 + F.lane) * 8; i0 < total; i0 += 8 * stride) {
          f32x4 pv[8][2];
#pragma unroll
          for (int k = 0; k < 8; ++k) { const size_t i = i0 + k * stride; if (i < total) { pv[k][0] = *(const f32x4*)(p + i); pv[k][1] = *(const f32x4*)(p + i + 4); } }
#pragma unroll
          for (int k = 0; k < 8; ++k) { const size_t i = i0 + k * stride; if (i < total) *(u32x4*)(pb + i) = pg8::pack8(pv[k][0], pv[k][1]); } } }
    { const float* wr = a.in[14]; const float* w2 = a.in[13]; bf16_t* wp = (bf16_t*)(ws + WS_WRP);
      for (int i = gw * 64 + F.lane; i < 64 * 2 * 64 * 8; i += NGW * 64) { const int j = i & 7, ln = (i >> 3) & 63, t = (i >> 9) & 1, s = i >> 10, c = ln & 15, kq = ln >> 4, k = 32 * s + 8 * kq + j;
          const float v = w2[k] * wr[(size_t)k * NE + 16 * t + c];
          const unsigned b0 = cvt_pk_bf16(v, 0.f) & 0xffffu; const float r1 = v - __uint_as_float(b0 << 16);
          const unsigned b1 = cvt_pk_bf16(r1, 0.f) & 0xffffu; const float r2 = r1 - __uint_as_float(b1 << 16);
          const unsigned b2 = cvt_pk_bf16(r2, 0.f) & 0xffffu;
          const size_t o = ((size_t)(s * 3) * 2 + t) * 512 + ln * 8 + j;
          wp[o] = (bf16_t)b0; wp[o + 1024] = (bf16_t)b1; wp[o + 2048] = (bf16_t)b2; } }
    { u32x4* z = (u32x4*)((signed char*)(ws + WS_WIN) + (size_t)12816 * D);
      for (int i = gw * 64 + F.lane; i < 240 * D / 16; i += NGW * 64) z[i] = (u32x4){0u, 0u, 0u, 0u};
      float* zs = (float*)(ws + WS_SWIN) + 12816; for (int i = gw * 64 + F.lane; i < 240; i += NGW * 64) zs[i] = 0.f; }
    constexpr int J_IN = (DIN + 31) / 32;
    constexpr int I_PP = (PLE / 64) * (D / 32);
    LAS float* wmax = (LAS float*)(F.lds + 8 * 16384);
    for (int job = F.vcu; job < J_IN; job += F.G) quant_panel_wg(a.in[3], DIN, (signed char*)(ws + WS_WIN), (float*)(ws + WS_SWIN), 2, wmax, job, F.wave, F.lane);
    for (int it = gw; it < I_PP; it += NGW) transpose_item(a.in[22], PLE, D, (bf16_t*)(ws + WS_WPP), MapId(), scr, it, F.lane);
}

namespace ml {
constexpr int NC = SEQ / 64, DVS = 64, NUNIT = BATCH * 8 * (256 / DVS);
constexpr int QS = 0, QS_SZ = 64 * 272, KS = 2 * QS_SZ, VS = KS + 64 * 272, VS_SZ = 64 * 144, SS = VS + 2 * VS_SZ, CT = SS + 64 * 144, CT_SZ = DVS * 272,
              NB = CT + 2 * CT_SZ, BB = NB + 512, AA = BB + 512, WW = AA + 512, GG = WW + 512, ML_END = GG + 32;
static_assert(ML_END <= RING_BYTES, "mLSTM LDS");
__device__ __forceinline__ f32x4 mfma16(bf16x8 a, bf16x8 b, f32x4 c) { return __builtin_amdgcn_mfma_f32_16x16x32_bf16(a, b, c, 0, 0, 0); }
__device__ __forceinline__ float tanh_fast(float x) { const float E = __expf(2.0f * fminf(fmaxf(x, -15.f), 15.f)); return (E - 1.0f) * __builtin_amdgcn_rcpf(E + 1.0f); }
typedef short v4i16_t __attribute__((ext_vector_type(4)));
__device__ __forceinline__ s16x4 vtr(const LAS unsigned char* p) { return __builtin_bit_cast(s16x4, __builtin_amdgcn_ds_read_tr16_b64_v4i16((LAS v4i16_t*)p)); }
__device__ __forceinline__ bf16x8 trfrag8(const LAS unsigned char* base, int stride, int kb, int col0, int fr, int fq) {
    const LAS unsigned char* p = base + (kb + 8 * fq + (fr >> 2)) * stride + (col0 + 4 * (fr & 3)) * 2;
    const s16x4 lo = vtr(p), hi = vtr(p + 4 * stride);
    return (bf16x8){lo[0], lo[1], lo[2], lo[3], hi[0], hi[1], hi[2], hi[3]};
}

__device__ __forceinline__ void mlstm_unit(LAS unsigned char* lds, const bf16_t* PROJ, bf16_t* HML, float* gates, const float* igb, const float* fgb, int b, int h, int sl) {
    const int tid = threadIdx.x, lane = tid & 63, wid = __builtin_amdgcn_readfirstlane(tid >> 6), fr = lane & 15, fq = lane >> 4;
    const size_t row0 = (size_t)b * SEQ;
    const float scale = 0.08838834764831845f;
    const bf16x8 ONES = (bf16x8){0x3F80, 0x3F80, 0x3F80, 0x3F80, 0x3F80, 0x3F80, 0x3F80, 0x3F80};
    { const float ib = igb[h], fb = fgb[h];
      bf16_t gir[NC / 8], gfr[NC / 8];
#pragma unroll
      for (int q = 0; q < NC / 8; ++q) { const bf16_t* base = PROJ + (row0 + (size_t)(wid + 8 * q) * 64 + lane) * NPROJ; gir[q] = base[C_GI + h]; gfr[q] = base[C_GF + h]; }
#pragma unroll
      for (int q = 0; q < NC / 8; ++q) { const int cc = wid + 8 * q;
          const float gi = bf1(gir[q]), gf = bf1(gfr[q]);
          const float li = 15.f * tanh_fast((gi + ib) * (1.f / 15.f)); const float fz = 15.f * tanh_fast((gf + fb) * (1.f / 15.f)); const float lf = fminf(fz, 0.f) - __logf(1.0f + __expf(-fabsf(fz)));
          float bsum = lf;
#pragma unroll
          for (int o = 1; o < 64; o <<= 1) { const float tv = __shfl_up(bsum, o); if (lane >= o) bsum += tv; }
          const float g = __shfl(bsum, 63); const float aj = li - bsum; float* gp = gates + (size_t)cc * 256;
          gp[lane] = bsum; gp[64 + lane] = aj; gp[128 + lane] = __expf(g + aj); if (lane == 0) gp[192] = g; } }
    const int qrow[2] = {tid >> 4, (tid + 512) >> 4}, qch = tid & 15;
    const int vrow = tid >> 3, vch = tid & 7;
    u32x4 rq[2][2], rk[2][2], rv[2]; float rg[2] = {0.f, 0.f};
#define ML_LOAD(c, s) do { const bf16_t* base = PROJ + (row0 + (size_t)(c) * 64) * NPROJ; \
        _Pragma("unroll") for (int u = 0; u < 2; ++u) { rq[s][u] = *(const u32x4*)(base + (size_t)qrow[u] * NPROJ + C_MLQ + h * 128 + 8 * qch); rk[s][u] = *(const u32x4*)(base + (size_t)qrow[u] * NPROJ + C_MLK + h * 128 + 8 * qch); } \
        rv[s] = *(const u32x4*)(base + (size_t)vrow * NPROJ + C_MLV + h * 256 + DVS * sl + 8 * vch); \
        if (tid < 193) rg[s] = gates[(size_t)(c) * 256 + tid]; } while (0)
#define ML_STORE(p, s) do { \
        _Pragma("unroll") for (int u = 0; u < 2; ++u) { *(LAS u32x4*)(lds + QS + (p) * QS_SZ + qrow[u] * 272 + qch * 16) = rq[s][u]; *(LAS u32x4*)(lds + KS + qrow[u] * 272 + qch * 16) = rk[s][u]; } \
        *(LAS u32x4*)(lds + VS + (p) * VS_SZ + vrow * 144 + vch * 16) = rv[s]; \
        if (tid < 192) *(LAS float*)(lds + BB + (tid >> 6) * 512 + (p) * 256 + (tid & 63) * 4) = rg[s]; else if (tid == 192) *(LAS float*)(lds + GG + (p) * 16) = rg[s]; } while (0)
    f32x4 Creg[2][4], nreg[2];
#pragma unroll
    for (int a = 0; a < 2; ++a) { nreg[a] = (f32x4){0.f, 0.f, 0.f, 0.f};
#pragma unroll
        for (int c = 0; c < 4; ++c) Creg[a][c] = (f32x4){0.f, 0.f, 0.f, 0.f}; }
    for (int i = tid; i < CT_SZ / 4; i += 512) *(LAS unsigned*)(lds + CT + i * 4) = 0u;
    if (tid < 64) *(LAS unsigned*)(lds + NB + tid * 4) = 0u;
    VM_WAIT(); __syncthreads();
    ML_LOAD(0, 0); ML_STORE(0, 0); ML_LOAD(1, 1);
    WG_BAR();
    const unsigned glist = wid == 0 ? 0x0DCu : wid == 1 ? 0x4FEu : wid == 2 ? 0x098u : 0x05Au; const int gcnt = wid < 2 ? 3 : 2;
#define ML_CHUNK(c, p) do { \
        if ((c) + 2 < NC) ML_LOAD((c) + 2, p); \
          \
        if (wid < 4) { \
            for (int q = 0; q < gcnt; ++q) { const int code = (int)((glist >> (4 * q)) & 0xFu); const int it = code >> 2, jt = code & 3, i = 16 * it + fr; \
                f32x4 acc = (f32x4){0.f, 0.f, 0.f, 0.f}; \
                _Pragma("unroll") for (int ks = 0; ks < 4; ++ks) { const bf16x8 A = *(const LAS bf16x8*)(lds + KS + (16 * jt + fr) * 272 + (32 * ks + 8 * fq) * 2); const bf16x8 B = *(const LAS bf16x8*)(lds + QS + (p) * QS_SZ + (16 * it + fr) * 272 + (32 * ks + 8 * fq) * 2); acc = mfma16(A, B, acc); } \
                const float bi = *(const LAS float*)(lds + BB + (p) * 256 + i * 4); const f32x4 aj = *(const LAS f32x4*)(lds + AA + (p) * 256 + (16 * jt + 4 * fq) * 4); \
                float v[4]; _Pragma("unroll") for (int r = 0; r < 4; ++r) { const int j = 16 * jt + 4 * fq + r; v[r] = (j <= i) ? acc[r] * scale * __expf(bi + aj[r]) : 0.f; } \
                u32x2 w; w.x = cvt_pk_bf16(v[0], v[1]); w.y = cvt_pk_bf16(v[2], v[3]); *(LAS u32x2*)(lds + SS + i * 144 + (16 * jt + 4 * fq) * 2) = w; } \
            if (wid == 2) *(LAS u32x2*)(lds + SS + fr * 144 + (16 + 4 * fq) * 2) = (u32x2){0u, 0u}; \
            if (wid == 3) *(LAS u32x2*)(lds + SS + (32 + fr) * 144 + (48 + 4 * fq) * 2) = (u32x2){0u, 0u}; \
        } else { \
            const int x = wid - 4; const float eg = __expf(*(const LAS float*)(lds + GG + (p) * 16)); \
            bf16x8 Af[2][2]; \
            _Pragma("unroll") for (int ks = 0; ks < 2; ++ks) { \
                const f32x4 w0 = *(const LAS f32x4*)(lds + WW + (p) * 256 + (32 * ks + 8 * fq) * 4), w1 = *(const LAS f32x4*)(lds + WW + (p) * 256 + (32 * ks + 8 * fq + 4) * 4); \
                _Pragma("unroll") for (int dl = 0; dl < 2; ++dl) { const bf16x8 kf = trfrag8(lds + KS, 272, 32 * ks, 16 * (2 * x + dl), fr, fq); \
                    u32x4 sc; sc.x = cvt_pk_bf16(bf1((bf16_t)kf[0]) * w0[0], bf1((bf16_t)kf[1]) * w0[1]); sc.y = cvt_pk_bf16(bf1((bf16_t)kf[2]) * w0[2], bf1((bf16_t)kf[3]) * w0[3]); \
                    sc.z = cvt_pk_bf16(bf1((bf16_t)kf[4]) * w1[0], bf1((bf16_t)kf[5]) * w1[1]); sc.w = cvt_pk_bf16(bf1((bf16_t)kf[6]) * w1[2], bf1((bf16_t)kf[7]) * w1[3]); \
                    Af[dl][ks] = __builtin_bit_cast(bf16x8, sc); } } \
            _Pragma("unroll") for (int dv = 0; dv < 4; ++dv) { \
                const bf16x8 B0 = trfrag8(lds + VS + (p) * VS_SZ, 144, 0, 16 * dv, fr, fq), B1 = trfrag8(lds + VS + (p) * VS_SZ, 144, 32, 16 * dv, fr, fq); \
                _Pragma("unroll") for (int dl = 0; dl < 2; ++dl) { f32x4 cacc = Creg[dl][dv] * eg; cacc = mfma16(Af[dl][0], B0, cacc); cacc = mfma16(Af[dl][1], B1, cacc); Creg[dl][dv] = cacc; \
                    u32x2 w; w.x = cvt_pk_bf16(cacc[0], cacc[1]); w.y = cvt_pk_bf16(cacc[2], cacc[3]); \
                    *(LAS u32x2*)(lds + CT + ((p) ^ 1) * CT_SZ + (16 * dv + fr) * 272 + (16 * (2 * x + dl) + 4 * fq) * 2) = w; } } \
            _Pragma("unroll") for (int dl = 0; dl < 2; ++dl) { \
                f32x4 nacc = nreg[dl] * eg; nacc = mfma16(Af[dl][0], ONES, nacc); nacc = mfma16(Af[dl][1], ONES, nacc); nreg[dl] = nacc; \
                if (fr == 0) { u32x2 w; w.x = cvt_pk_bf16(nacc[0], nacc[1]); w.y = cvt_pk_bf16(nacc[2], nacc[3]); *(LAS u32x2*)(lds + NB + ((p) ^ 1) * 256 + (16 * (2 * x + dl) + 4 * fq) * 2) = w; } } \
        } \
        WG_BAR(); \
          \
        { const int it = wid >> 1, dvb = 2 * (wid & 1); \
          f32x4 h1[2], h2[2], rs = (f32x4){0.f, 0.f, 0.f, 0.f}, qn = rs; h1[0] = rs; h1[1] = rs; h2[0] = rs; h2[1] = rs; \
          for (int ks = 0; ks <= (it >> 1); ++ks) { const bf16x8 A = *(const LAS bf16x8*)(lds + SS + (16 * it + fr) * 144 + (32 * ks + 8 * fq) * 2); rs = mfma16(A, ONES, rs); \
              _Pragma("unroll") for (int e = 0; e < 2; ++e) { const bf16x8 B = trfrag8(lds + VS + (p) * VS_SZ, 144, 32 * ks, 16 * (dvb + e), fr, fq); h1[e] = mfma16(A, B, h1[e]); } } \
          _Pragma("unroll") for (int ks = 0; ks < 4; ++ks) { const bf16x8 A = *(const LAS bf16x8*)(lds + QS + (p) * QS_SZ + (16 * it + fr) * 272 + (32 * ks + 8 * fq) * 2); \
              const bf16x8 Bn = *(const LAS bf16x8*)(lds + NB + (p) * 256 + (32 * ks + 8 * fq) * 2); qn = mfma16(A, Bn, qn); \
              _Pragma("unroll") for (int e = 0; e < 2; ++e) { const bf16x8 B = *(const LAS bf16x8*)(lds + CT + (p) * CT_SZ + (16 * (dvb + e) + fr) * 272 + (32 * ks + 8 * fq) * 2); h2[e] = mfma16(A, B, h2[e]); } } \
          const f32x4 bi = *(const LAS f32x4*)(lds + BB + (p) * 256 + (16 * it + 4 * fq) * 4); \
          bf16_t* orow = HML + (row0 + (size_t)(c) * 64 + 16 * it + 4 * fq) * D + h * 256 + DVS * sl + 16 * dvb + fr; \
          _Pragma("unroll") for (int r = 0; r < 4; ++r) { const float eb = __expf(bi[r]) * scale; const float rden = __builtin_amdgcn_rcpf(fmaxf(fabsf(rs[r] + eb * qn[r]), 1.0f)); \
              _Pragma("unroll") for (int e = 0; e < 2; ++e) orow[(size_t)r * D + 16 * e] = (bf16_t)(cvt_pk_bf16((h1[e][r] + eb * h2[e][r]) * rden, 0.f) & 0xffffu); } } \
        if ((c) + 1 < NC) ML_STORE((p) ^ 1, (p) ^ 1); \
        WG_BAR(); } while (0)
    for (int c = 0; c < NC; c += 2) { ML_CHUNK(c, 0); ML_CHUNK(c + 1, 1); }
#undef ML_CHUNK
#undef ML_LOAD
#undef ML_STORE
}
}

namespace swa {
constexpr int KSO = 0, VSO = 256 * 144, WSF = 2 * 256 * 144, SWA_END = WSF + 8 * 256;
static_assert(SWA_END <= RING_BYTES, "SWA LDS");
__device__ __forceinline__ int crow(int r, int hi) { return (r & 3) + 8 * (r >> 2) + 4 * hi; }
typedef short v4i16_t __attribute__((ext_vector_type(4)));
__device__ __forceinline__ s16x4 vtr(const LAS unsigned char* p) { return __builtin_bit_cast(s16x4, __builtin_amdgcn_ds_read_tr16_b64_v4i16((LAS v4i16_t*)p)); }

__device__ __forceinline__ void swa_unit(LAS unsigned char* lds, const bf16_t* PROJ, bf16_t* ASW, const float* wq, const float* wk, const float* sinks, int b, int nb, int kvh) {
    const int tid = threadIdx.x, lane = tid & 63, wid = __builtin_amdgcn_readfirstlane(tid >> 6), r32 = lane & 31, hi = lane >> 5;
    const size_t rowbase = (size_t)b * SEQ + (size_t)nb * 128;
#pragma unroll
    for (int u = 0; u < 4; ++u) {
        const int id = tid + 512 * u, row = id >> 3, ch = id & 7; const bool valid = (nb > 0) || (row >= 128);
        u32x4 kw = (u32x4){0u, 0u, 0u, 0u}, vw = (u32x4){0u, 0u, 0u, 0u};
        if (valid) { const bf16_t* rp = PROJ + (rowbase - 128 + row) * NPROJ; kw = *(const u32x4*)(rp + C_SWK + kvh * 64 + 8 * ch); vw = *(const u32x4*)(rp + C_SWV + kvh * 64 + 8 * ch); }
        f32x4 k0, k1; pg8::unpack8(kw, k0, k1);
        float ss = (k0[0] * k0[0] + k0[1] * k0[1]) + (k0[2] * k0[2] + k0[3] * k0[3]) + (k1[0] * k1[0] + k1[1] * k1[1]) + (k1[2] * k1[2] + k1[3] * k1[3]);
        ss += __shfl_xor(ss, 1); ss += __shfl_xor(ss, 2); ss += __shfl_xor(ss, 4);
        const float r = 1.0f / sqrtf(ss * (1.f / 64.f) + EPS);
        const f32x4 w0 = *(const f32x4*)(wk + 8 * ch), w1 = *(const f32x4*)(wk + 8 * ch + 4);
        *(LAS u32x4*)(lds + KSO + row * 144 + ch * 16) = pg8::pack8(k0 * r * w0, k1 * r * w1);
        *(LAS u32x4*)(lds + VSO + row * 144 + ch * 16) = vw;
    }
    WG_BAR();
    const int hd = kvh * 8 + wid;
    const float slope = exp2f(-(float)(hd + 1) * 0.25f) * LOG2E, sinkl = sinks[hd] * LOG2E;
    LAS float* wsf = (LAS float*)(lds + WSF + wid * 256);
    for (int qt = 0; qt < 4; ++qt) {
        bf16x8 qf[4];
        { const bf16_t* qp = PROJ + (rowbase + 32 * qt + r32) * NPROJ + C_SWQ + hd * 64 + 8 * hi; f32x4 q0[4], q1[4]; float ss = 0.f;
#pragma unroll
          for (int ds = 0; ds < 4; ++ds) { const u32x4 w = *(const u32x4*)(qp + 16 * ds); pg8::unpack8(w, q0[ds], q1[ds]);
              ss += (q0[ds][0] * q0[ds][0] + q0[ds][1] * q0[ds][1]) + (q0[ds][2] * q0[ds][2] + q0[ds][3] * q0[ds][3]) + (q1[ds][0] * q1[ds][0] + q1[ds][1] * q1[ds][1]) + (q1[ds][2] * q1[ds][2] + q1[ds][3] * q1[ds][3]); }
          ss += __shfl_xor(ss, 32);
          const float r = (1.0f / sqrtf(ss * (1.f / 64.f) + EPS)) * 0.125f * LOG2E;
#pragma unroll
          for (int ds = 0; ds < 4; ++ds) { const f32x4 w0 = *(const f32x4*)(wq + 16 * ds + 8 * hi), w1 = *(const f32x4*)(wq + 16 * ds + 8 * hi + 4); qf[ds] = __builtin_bit_cast(bf16x8, pg8::pack8(q0[ds] * r * w0, q1[ds] * r * w1)); } }
        f32x16 s[5];
#pragma unroll
        for (int kk = 0; kk < 5; ++kk) { const int kt = qt + kk; f32x16 a = {};
#pragma unroll
            for (int ds = 0; ds < 4; ++ds) { const bf16x8 A = *(const LAS bf16x8*)(lds + KSO + (32 * kt + r32) * 144 + (16 * ds + 8 * hi) * 2); a = __builtin_amdgcn_mfma_f32_32x32x16_bf16(A, qf[ds], a, 0, 0, 0); }
            s[kk] = a; __builtin_amdgcn_sched_barrier(0); }
        int dbase = 128 + r32 - 4 * hi; asm volatile("" : "+v"(dbase));
        const float fbase = (float)dbase; const int jlim = ((nb > 0) ? 0 : 128) - 32 * qt - 4 * hi;
        float m = sinkl;
#pragma unroll
        for (int kk = 0; kk < 5; ++kk)
#pragma unroll
            for (int r = 0; r < 16; ++r) { const int ckr = 32 * kk + (r & 3) + 8 * (r >> 2); const int dist = dbase - ckr; const bool valid = ((unsigned)dist < 128u) && (ckr >= jlim);
                const float v = valid ? s[kk][r] - slope * (fbase - (float)ckr) : -INFINITY; s[kk][r] = v; m = fmaxf(m, v); }
        m = fmaxf(m, __shfl_xor(m, 32));
        float l = 0.f;
#pragma unroll
        for (int kk = 0; kk < 5; ++kk)
#pragma unroll
            for (int r = 0; r < 16; ++r) { const float p = __builtin_amdgcn_exp2f(s[kk][r] - m); s[kk][r] = p; l += p; }
        l += __shfl_xor(l, 32);
        l += __builtin_amdgcn_exp2f(sinkl - m);
        if (hi == 0) wsf[r32] = __builtin_amdgcn_rcpf(l);
        f32x16 o[2]; o[0] = (f32x16){}; o[1] = (f32x16){};
#pragma unroll
        for (int kk = 0; kk < 5; ++kk) { const int kt = qt + kk;
#pragma unroll
            for (int s2 = 0; s2 < 2; ++s2) {
                u32x4 pw; pw.x = cvt_pk_bf16(s[kk][8 * s2 + 0], s[kk][8 * s2 + 1]); pw.y = cvt_pk_bf16(s[kk][8 * s2 + 2], s[kk][8 * s2 + 3]); pw.z = cvt_pk_bf16(s[kk][8 * s2 + 4], s[kk][8 * s2 + 5]); pw.w = cvt_pk_bf16(s[kk][8 * s2 + 6], s[kk][8 * s2 + 7]);
                const bf16x8 pa = __builtin_bit_cast(bf16x8, pw);
                const int key = 32 * kt + 16 * s2 + 4 * hi + ((lane & 15) >> 2);
#pragma unroll
                for (int d0 = 0; d0 < 2; ++d0) { const LAS unsigned char* vp = lds + VSO + key * 144 + (32 * d0 + 16 * ((lane >> 4) & 1) + 4 * (lane & 3)) * 2;
                    const s16x4 lo = vtr(vp), hh = vtr(vp + 8 * 144);
                    const bf16x8 B = (bf16x8){lo[0], lo[1], lo[2], lo[3], hh[0], hh[1], hh[2], hh[3]};
                    o[d0] = __builtin_amdgcn_mfma_f32_32x32x16_bf16(pa, B, o[d0], 0, 0, 0); }
                __builtin_amdgcn_sched_barrier(0); } }
        LDS_WAIT();
#pragma unroll
        for (int r = 0; r < 16; ++r) { const float rl = wsf[crow(r, hi)]; bf16_t* op = ASW + (rowbase + 32 * qt + crow(r, hi)) * D + hd * 64 + r32;
            op[0] = (bf16_t)(cvt_pk_bf16(o[0][r] * rl, 0.f) & 0xffffu); op[32] = (bf16_t)(cvt_pk_bf16(o[1][r] * rl, 0.f) & 0xffffu); }
    }
    WG_BAR();
}
}

namespace moe {
using pg8::Unit; using pg8::BM; using pg8::HALF;
struct Tables { const LAS int* tstart; const LAS int* cnt; const LAS int* tile_e; };
__device__ __forceinline__ int build_tables(LAS unsigned char* tab, const unsigned* cur) {
    LAS int* tstart = (LAS int*)tab; LAS int* cnt = (LAS int*)(tab + 256); LAS int* tile_e = (LAS int*)(tab + 512);
    const int tid = threadIdx.x;
    if (tid < NE) cnt[tid] = (int)__hip_atomic_load(cur + 64 * tid, RLX_AGENT);
    __syncthreads();
    if (tid == 0) { int s = 0; for (int e = 0; e < NE; ++e) { tstart[e] = s; s += (cnt[e] + 255) >> 8; } tstart[NE] = s; }
    __syncthreads();
    const int nrt = tstart[NE];
    for (int t = tid; t < nrt; t += 512) { int e = 0; for (int k = 1; k < NE; ++k) if (tstart[k] <= t) e = k; tile_e[t] = e; }
    __syncthreads();
    return nrt;
}
struct UpSched {
    static constexpr bool GATHER = true;
    const void* A; const void* Bt; const int* tokl; Tables tb; int nrt, nN, G, c;
    __device__ __forceinline__ bool next(int i, Unit& u) const { const long L = (long)i * G + c; if (L >= (long)nrt * nN) return false; pg8::map_unit((int)L, nrt, nN, u.pm, u.pn); u.e = tb.tile_e[u.pm]; u.r0 = (u.pm - tb.tstart[u.e]) * BM; u.cnt = tb.cnt[u.e]; return true; }
    __device__ __forceinline__ const char* a_base() const { return (const char*)A; }
    __device__ __forceinline__ void a_offs(const Unit& u, const int (&R)[2], const int (&C)[2], int K, unsigned (&vo)[2][2]) const {
#pragma unroll
        for (int h = 0; h < 2; ++h)
#pragma unroll
            for (int i = 0; i < 2; ++i) { const int rl = u.r0 + h * HALF + R[i]; const int tok = rl < u.cnt ? tokl[(size_t)u.e * CAP + rl] : 0; vo[h][i] = (unsigned)tok * (unsigned)K + (unsigned)C[i] * 2u; }
    }
    __device__ __forceinline__ const char* a_tile(const Unit&, int) const { return (const char*)A; }
    __device__ __forceinline__ const char* b_tile(const Unit& u, int K) const { return (const char*)Bt + ((size_t)u.e * 2 * DFF + (size_t)u.pn * BM) * K; }
};
struct DownSched {
    static constexpr bool GATHER = false;
    const bf16_t* A; const bf16_t* Bt; Tables tb; int nrt, nN, G, c;
    __device__ __forceinline__ bool next(int i, Unit& u) const { const long L = (long)i * G + c; if (L >= (long)nrt * nN) return false; pg8::map_unit((int)L, nrt, nN, u.pm, u.pn); u.e = tb.tile_e[u.pm]; u.r0 = (u.pm - tb.tstart[u.e]) * BM; u.cnt = tb.cnt[u.e]; return true; }
    __device__ __forceinline__ const char* a_base() const { return (const char*)A; }
    __device__ __forceinline__ void a_offs(const Unit& u, const int (&R)[2], const int (&C)[2], int K, unsigned (&vo)[2][2]) const {
#pragma unroll
        for (int h = 0; h < 2; ++h)
#pragma unroll
            for (int i = 0; i < 2; ++i) vo[h][i] = (unsigned)(u.pm * BM + h * HALF + R[i]) * (unsigned)K + (unsigned)C[i] * 2u;
    }
    __device__ __forceinline__ const char* a_tile(const Unit& u, int K) const { return (const char*)A + (size_t)u.pm * BM * K; }
    __device__ __forceinline__ const char* b_tile(const Unit& u, int K) const { return (const char*)Bt + ((size_t)u.e * D + (size_t)u.pn * BM) * K; }
};
struct EpiUp {
    static constexpr bool PERM = true, I8 = true;
    signed char* ACT; const float* bup; const float* rsl; const float* swup; float* amax;
    __device__ __forceinline__ void operator()(const i32x4 (&acc)[2][2][4][2], const Unit& u, int wr, int wc, int fr, int fq) const {
        const int oc = u.pn * HALF + wc * 32 + 8 * fq;
        const float* bg = bup + (size_t)u.e * 2 * DFF + oc; const float* bl = bg + DFF;
        const float* sg = swup + (size_t)u.e * 2 * DFF + oc; const float* sl = sg + DFF;
        const f32x4 bg0 = *(const f32x4*)bg, bg1 = *(const f32x4*)(bg + 4), bl0 = *(const f32x4*)bl + 1.0f, bl1 = *(const f32x4*)(bl + 4) + 1.0f;
        const f32x4 sg0 = *(const f32x4*)sg, sg1 = *(const f32x4*)(sg + 4), sl0 = *(const f32x4*)sl, sl1 = *(const f32x4*)(sl + 4);
        const int ln = fr + 16 * fq; const int rl0 = u.r0 + wr * 64 + ln, rl1 = rl0 + HALF;
        const float rs0 = rl0 < u.cnt ? rsl[(size_t)u.e * CAP + rl0] : 0.f, rs1 = rl1 < u.cnt ? rsl[(size_t)u.e * CAP + rl1] : 0.f;
#pragma unroll
        for (int ai = 0; ai < 2; ++ai)
#pragma unroll
            for (int m = 0; m < 4; ++m) { const int rt = ai * HALF + wr * 64 + m * 16 + fr; const float rs = ROWSEL(rs0, rs1, ai, m, fr);
                f32x4 o[2];
#pragma unroll
                for (int n = 0; n < 2; ++n) { const f32x4 ag = __builtin_convertvector(acc[ai][0][m][n], f32x4), al = __builtin_convertvector(acc[ai][1][m][n], f32x4);
                    const f32x4 g = ag * rs * (n ? sg1 : sg0) + (n ? bg1 : bg0), l = al * rs * (n ? sl1 : sl0) + (n ? bl1 : bl0);
#pragma unroll
                    for (int j = 0; j < 4; ++j) { const float gg = fminf(g[j], 7.0f), l1 = fminf(fmaxf(l[j], -6.0f), 8.0f); o[n][j] = gg * __builtin_amdgcn_rcpf(1.0f + __builtin_amdgcn_exp2f(gg * (-1.702f * 1.44269504f))) * l1; } }
                const float mx = xmax_16_32(amax4(amax4(0.f, o[0]), o[1]));
                const float qb = 127.0f * __builtin_amdgcn_rcpf(fmaxf(mx, 1e-30f));
                u32x2 ov; ov.x = q8x4m(o[0], qb); ov.y = q8x4m(o[1], qb); *(u32x2*)(ACT + (size_t)(u.pm * BM + rt) * DFF + oc) = ov;
                if (fq == 0) amax[(size_t)(u.pm * BM + rt) * 64 + u.pn * 4 + wc] = mx; }
    }
};
struct EpiDown {
    static constexpr bool PERM = true, I8 = true;
    signed char* YS; float* ysm; const float* bdn; const float* gatel; const int* destl; const float* sad; const float* swdn;
    __device__ __forceinline__ void operator()(const i32x4 (&acc)[2][2][4][2], const Unit& u, int wr, int wc, int fr, int fq) const {
        const int col0 = u.pn * BM + wc * 32 + 8 * fq;
        f32x4 bv[2][2], sc[2][2];
#pragma unroll
        for (int bj = 0; bj < 2; ++bj)
#pragma unroll
            for (int n = 0; n < 2; ++n) { bv[bj][n] = *(const f32x4*)(bdn + (size_t)u.e * D + col0 + bj * HALF + 4 * n); sc[bj][n] = *(const f32x4*)(swdn + (size_t)u.e * D + col0 + bj * HALF + 4 * n); }
        const int ln = fr + 16 * fq; const int rl0 = u.r0 + wr * 64 + ln, rl1 = rl0 + HALF; const bool ok0 = rl0 < u.cnt, ok1 = rl1 < u.cnt;
        const float g0 = ok0 ? gatel[(size_t)u.e * CAP + rl0] : 0.f, g1 = ok1 ? gatel[(size_t)u.e * CAP + rl1] : 0.f;
        const int d0 = ok0 ? destl[(size_t)u.e * CAP + rl0] : 0, d1 = ok1 ? destl[(size_t)u.e * CAP + rl1] : 0;
        const float s0 = sad[u.pm * BM + wr * 64 + ln], s1 = sad[u.pm * BM + HALF + wr * 64 + ln];
#pragma unroll
        for (int ai = 0; ai < 2; ++ai)
#pragma unroll
            for (int m = 0; m < 4; ++m) { const int rt = ai * HALF + wr * 64 + m * 16 + fr, rl = u.r0 + rt;
                const float g = ROWSEL(g0, g1, ai, m, fr); const int dest = ROWSEL(d0, d1, ai, m, fr); const float rs = ROWSEL(s0, s1, ai, m, fr);
#pragma unroll
                for (int bj = 0; bj < 2; ++bj) { const f32x4 v0 = (__builtin_convertvector(acc[ai][bj][m][0], f32x4) * rs * sc[bj][0] + bv[bj][0]) * g, v1 = (__builtin_convertvector(acc[ai][bj][m][1], f32x4) * rs * sc[bj][1] + bv[bj][1]) * g;
                    const float mx = xmax_16_32(amax4(amax4(0.f, v0), v1));
                    const float qb = 127.0f * __builtin_amdgcn_rcpf(fmaxf(mx, 1e-30f));
                    u32x2 ov; ov.x = q8x4m(v0, qb); ov.y = q8x4m(v1, qb);
                    if (rl < u.cnt) { *(u32x2*)(YS + (size_t)dest * D + col0 + bj * HALF) = ov; if (fq == 0) ysm[(size_t)dest * 64 + u.pn * 8 + bj * 4 + wc] = mx; } } }
    }
};
}

__device__ __forceinline__ void ml_norm_rows(Frame& F, const Args& a) {
    const int gw = F.vcu * NWAVES + F.wave, NGW = F.G * NWAVES, lane = F.lane;
    const bf16_t* HML = (const bf16_t*)(F.ws + WS_HML); const bf16_t* PROJ = (const bf16_t*)(F.ws + WS_PROJ); const float* nw = a.in[6];
    signed char* AQ = (signed char*)(F.ws + WS_AMLQ); float* sa = (float*)(F.ws + WS_SAML);
    for (int mb = gw * 2; mb < T; mb += NGW * 2) {
      u32x4 hw2[2][4], ow2[2][4];
#pragma unroll
      for (int r = 0; r < 2; ++r)
#pragma unroll
        for (int j = 0; j < 4; ++j) { hw2[r][j] = *(const u32x4*)(HML + (size_t)(mb + r) * D + 512 * j + 8 * lane); { const int c = 512 * j + 8 * lane; const u32x2 g = *(const u32x2*)((const unsigned char*)(PROJ + (size_t)(mb + r) * NPROJ + C_MLO + (c & ~255)) + (c & 255)); ow2[r][j] = (u32x4){g.x, g.y, 0u, 0u}; } }
#pragma unroll
      for (int r = 0; r < 2; ++r) { const int m = mb + r;
        f32x4 v[4][2]; float amax = 0.f;
#pragma unroll
        for (int j = 0; j < 4; ++j) { const int c0 = 512 * j + 8 * lane;
            const u32x4 hw = hw2[r][j], ow = ow2[r][j]; f32x4 h0, h1; pg8::unpack8(hw, h0, h1); const f32x4 o0 = pg8::ub4(ow.x), o1 = pg8::ub4(ow.y);
            float ss = (h0[0] * h0[0] + h0[1] * h0[1]) + (h0[2] * h0[2] + h0[3] * h0[3]) + (h1[0] * h1[0] + h1[1] * h1[1]) + (h1[2] * h1[2] + h1[3] * h1[3]);
#pragma unroll
            for (int o = 1; o < 32; o <<= 1) ss += __shfl_xor(ss, o);
            const float r = 1.0f / sqrtf(ss * (1.f / 256.f) + EPS);
            const f32x4 w0 = *(const f32x4*)(nw + c0), w1 = *(const f32x4*)(nw + c0 + 4);
            v[j][0] = h0 * r * w0 * o0; v[j][1] = h1 * r * w1 * o1; amax = amax4(amax4(amax, v[j][0]), v[j][1]); }
        amax = fmaxf(wave_max(amax), 1e-30f); const float qs = 127.0f / amax;
        if (lane == 0) sa[m] = amax * (1.0f / 127.0f);
#pragma unroll
        for (int j = 0; j < 4; ++j) { u32x2 o; o.x = q8x4(v[j][0] * qs); o.y = q8x4(v[j][1] * qs); *(u32x2*)(AQ + (size_t)m * D + 512 * j + 8 * lane) = o; }
      }
    }
}

__device__ __forceinline__ void asw_quant_rows(Frame& F) {
    const int gw = F.vcu * NWAVES + F.wave, NGW = F.G * NWAVES, lane = F.lane;
    const bf16_t* ASW = (const bf16_t*)(F.ws + WS_ASW); signed char* AQ = (signed char*)(F.ws + WS_ASWQ); float* sa = (float*)(F.ws + WS_SASW);
    constexpr int R = 4;
    for (int m0 = gw * R; m0 < T; m0 += NGW * R) {
        u32x4 w[R][4];
#pragma unroll
        for (int r = 0; r < R; ++r)
#pragma unroll
            for (int j = 0; j < 4; ++j) w[r][j] = *(const u32x4*)(ASW + (size_t)(m0 + r) * D + 512 * j + 8 * lane);
#pragma unroll
        for (int r = 0; r < R; ++r) { f32x4 v[4][2]; float amax = 0.f;
#pragma unroll
            for (int j = 0; j < 4; ++j) { pg8::unpack8(w[r][j], v[j][0], v[j][1]); amax = amax4(amax4(amax, v[j][0]), v[j][1]); }
            amax = fmaxf(wave_max(amax), 1e-30f); const float qs = 127.0f / amax;
            if (lane == 0) sa[m0 + r] = amax * (1.0f / 127.0f);
#pragma unroll
            for (int j = 0; j < 4; ++j) { u32x2 o; o.x = q8x4(v[j][0] * qs); o.y = q8x4(v[j][1] * qs); *(u32x2*)(AQ + (size_t)(m0 + r) * D + 512 * j + 8 * lane) = o; } }
    }
}

__device__ __forceinline__ void route_phase(Frame& F, const Args& a) {
    LAS unsigned char* lds = F.lds;
    LAS float* w2s = (LAS float*)(lds);
    LAS float* lg = (LAS float*)(lds + 8192);
    LAS float* rsd = (LAS float*)(lds + 8192 + 8 * 16 * 33 * 4);
    LAS float* rsd2 = rsd + 128;
    LAS int* sel_e = (LAS int*)(lds + 32768);
    LAS float* sel_g = (LAS float*)(lds + 32768 + 2048);
    LAS int* hist = (LAS int*)(lds + 32768 + 4096);
    LAS int* basep = (LAS int*)(lds + 32768 + 4096 + 128);
    const int tid = F.tid, lane = F.lane, wid = F.wave, c16 = lane & 15, kq = lane >> 4;
    const bf16_t* h1 = (const bf16_t*)(F.ws + WS_H); const float* w2 = a.in[13]; const float* br = a.in[15]; const bf16_t* wrp = (const bf16_t*)(F.ws + WS_WRP);
    signed char* XQ = (signed char*)(F.ws + WS_XN);
    int* tokl = (int*)(F.ws + WS_TOKL); float* gatel = (float*)(F.ws + WS_GATEL); int* destl = (int*)(F.ws + WS_DESTL); float* rsl = (float*)(F.ws + WS_RSL);
    unsigned* cur = F.ctl + CW_CUR;
    for (int i = tid; i < D; i += 512) w2s[i] = w2[i];
    __syncthreads();
    for (int tb = blockIdx.x; tb < T / 128; tb += F.G) {
        if (tid < NE) hist[tid] = 0;
        const int row0 = tb * 128 + wid * 16;
        const bf16_t* xr = h1 + (size_t)(row0 + c16) * D + 8 * kq;
        f32x4 acc0 = (f32x4){0.f, 0.f, 0.f, 0.f}, acc1 = (f32x4){0.f, 0.f, 0.f, 0.f}; float ss = 0.f, amax = 0.f;
        for (int ch = 0; ch < 4; ++ch) {
            u32x4 xa[16], bt[12];
#pragma unroll
            for (int i = 0; i < 16; ++i) xa[i] = *(const u32x4*)(xr + 32 * (16 * ch + i));
#pragma unroll
            for (int i = 0; i < 12; ++i) bt[i] = *(const u32x4*)((const char*)wrp + (size_t)ch * 98304 + (size_t)(tid + 512 * i) * 16);
            if (ch) WG_BAR();
#pragma unroll
            for (int i = 0; i < 12; ++i) *(LAS u32x4*)(lds + 40960 + (tid + 512 * i) * 16) = bt[i];
            WG_BAR();
#pragma unroll
            for (int i = 0; i < 16; ++i) { const int s = 16 * ch + i;
                const u32x4 xb = xa[i]; f32x4 x0, x1; pg8::unpack8(xb, x0, x1);
                const f32x4 w0 = *(const LAS f32x4*)(w2s + 32 * s + 8 * kq), w1 = *(const LAS f32x4*)(w2s + 32 * s + 8 * kq + 4);
                ss += ((x0[0] * x0[0] + x0[1] * x0[1]) + (x0[2] * x0[2] + x0[3] * x0[3])) + ((x1[0] * x1[0] + x1[1] * x1[1]) + (x1[2] * x1[2] + x1[3] * x1[3]));
                amax = amax4(amax4(amax, x0 * w0), x1 * w1);
                const bf16x8 A = __builtin_bit_cast(bf16x8, xb); const LAS unsigned char* bp = lds + 40960 + i * 6144 + lane * 16;
#pragma unroll
                for (int p = 0; p < 3; ++p) { const bf16x8 B0 = *(const LAS bf16x8*)(bp + (p * 2) * 1024), B1 = *(const LAS bf16x8*)(bp + (p * 2 + 1) * 1024);
                    acc0 = __builtin_amdgcn_mfma_f32_16x16x32_bf16(A, B0, acc0, 0, 0, 0); acc1 = __builtin_amdgcn_mfma_f32_16x16x32_bf16(A, B1, acc1, 0, 0, 0); } }
        }
        ss += __shfl_xor(ss, 16); ss += __shfl_xor(ss, 32);
        amax = fmaxf(amax, __shfl_xor(amax, 16)); amax = fmaxf(amax, __shfl_xor(amax, 32)); amax = fmaxf(amax, 1e-30f);
        const float rstd = 1.0f / sqrtf(ss * (1.f / D) + EPS);
        if (kq == 0) { rsd[wid * 16 + c16] = rstd * amax * (1.0f / 127.0f); rsd2[wid * 16 + c16] = rstd; }
        { const float qsl = 127.0f / amax;
          f32x4 wv[4][2];
#pragma unroll
          for (int j = 0; j < 4; ++j) { wv[j][0] = *(const LAS f32x4*)(w2s + 512 * j + 8 * lane); wv[j][1] = *(const LAS f32x4*)(w2s + 512 * j + 8 * lane + 4); }
          for (int r0 = 0; r0 < 16; r0 += 4) { u32x4 xb[4][4];
#pragma unroll
              for (int rr = 0; rr < 4; ++rr)
#pragma unroll
                  for (int j = 0; j < 4; ++j) xb[rr][j] = *(const u32x4*)(h1 + (size_t)(row0 + r0 + rr) * D + 512 * j + 8 * lane);
#pragma unroll
              for (int rr = 0; rr < 4; ++rr) { const float qs = __shfl(qsl, r0 + rr);
#pragma unroll
                  for (int j = 0; j < 4; ++j) { f32x4 x0, x1; pg8::unpack8(xb[rr][j], x0, x1); u32x2 o; o.x = q8x4(x0 * wv[j][0] * qs); o.y = q8x4(x1 * wv[j][1] * qs);
                      *(u32x2*)(XQ + (size_t)(row0 + r0 + rr) * D + 512 * j + 8 * lane) = o; } } } }
        LDS_WAIT();
        { const float bb0 = br[c16], bb1 = br[c16 + 16];
#pragma unroll
          for (int r = 0; r < 4; ++r) { const float rr = rsd2[wid * 16 + 4 * kq + r]; lg[(wid * 16 + 4 * kq + r) * 33 + c16] = acc0[r] * rr + bb0; lg[(wid * 16 + 4 * kq + r) * 33 + c16 + 16] = acc1[r] * rr + bb1; } }
        LDS_WAIT();
        if (lane < 16) {
            const LAS float* lr = lg + (wid * 16 + lane) * 33; unsigned taken = 0u; float tv[4]; int te[4];
#pragma unroll
            for (int k = 0; k < 4; ++k) { float best = -INFINITY; int bi = 0;
                for (int e = 0; e < NE; ++e) { const float v = lr[e]; const bool ok = !((taken >> e) & 1u) && (v > best); best = ok ? v : best; bi = ok ? e : bi; }
                taken |= 1u << bi; tv[k] = best; te[k] = bi; }
            float ex[4], sum = 0.f;
#pragma unroll
            for (int k = 0; k < 4; ++k) { ex[k] = __expf(tv[k] - tv[0]); sum += ex[k]; }
            const float inv = 1.0f / sum;
#pragma unroll
            for (int k = 0; k < 4; ++k) { sel_e[(wid * 16 + lane) * 4 + k] = te[k]; sel_g[(wid * 16 + lane) * 4 + k] = ex[k] * inv; }
        }
        __syncthreads();
        const int prow = wid * 16 + (lane >> 2), pk = lane & 3;
        const int pe = sel_e[prow * 4 + pk]; const float pg = sel_g[prow * 4 + pk];
        const int lr_ = __hip_atomic_fetch_add(hist + pe, 1, __ATOMIC_RELAXED, __HIP_MEMORY_SCOPE_WORKGROUP);
        __syncthreads();
        if (tid < NE) basep[tid] = (int)__hip_atomic_fetch_add(cur + 64 * tid, (unsigned)hist[tid], RLX_AGENT);
        __syncthreads();
        { const int pos = basep[pe] + lr_; const int token = tb * 128 + prow; const size_t li = (size_t)pe * CAP + pos;
          tokl[li] = token; gatel[li] = pg; destl[li] = token * 4 + pk; rsl[li] = rsd[prow]; }
        __syncthreads();
    }
}

__device__ __forceinline__ void combine_rows(Frame& F, const Args& a) {
    const int gw = F.vcu * NWAVES + F.wave, NGW = F.G * NWAVES, lane = F.lane;
    bf16_t* hb = (bf16_t*)(F.ws + WS_H); const signed char* YS = (const signed char*)(F.ws + WS_YS); const float* ysm = (const float*)(F.ws + WS_YS + 256 * MiB); signed char* XQ = (signed char*)(F.ws + WS_XN); float* sa3 = (float*)(F.ws + WS_SA3); const float* w3 = a.in[20];
    f32x4 wv[4][2]; u32x2 nyw[4][4]; float nys[4][4]; u32x4 nhw[4];
#pragma unroll
    for (int j = 0; j < 4; ++j) { const int c0 = 512 * j + 8 * lane; wv[j][0] = *(const f32x4*)(w3 + c0); wv[j][1] = *(const f32x4*)(w3 + c0 + 4); }
    if (gw < T) {
#pragma unroll
        for (int j = 0; j < 4; ++j) { const int c0 = 512 * j + 8 * lane; nhw[j] = *(const u32x4*)(hb + (size_t)gw * D + c0);
#pragma unroll
            for (int k = 0; k < 4; ++k) { nyw[j][k] = *(const u32x2*)(YS + ((size_t)gw * 4 + k) * D + c0); nys[j][k] = ysm[((size_t)gw * 4 + k) * 64 + 16 * j + (lane >> 2)]; } } }
    for (int m = gw; m < T; m += NGW) {
        bf16_t* hr = hb + (size_t)m * D; f32x4 v[4][2]; float s = 0.f;
#pragma unroll
        for (int j = 0; j < 4; ++j) { pg8::unpack8(nhw[j], v[j][0], v[j][1]);
#pragma unroll
            for (int k = 0; k < 4; ++k) { const int w0 = (int)nyw[j][k].x, w1 = (int)nyw[j][k].y; const float ys = nys[j][k] * (1.0f / 127.0f);
                v[j][0] += (f32x4){(float)((w0 << 24) >> 24), (float)((w0 << 16) >> 24), (float)((w0 << 8) >> 24), (float)(w0 >> 24)} * ys;
                v[j][1] += (f32x4){(float)((w1 << 24) >> 24), (float)((w1 << 16) >> 24), (float)((w1 << 8) >> 24), (float)(w1 >> 24)} * ys; } }
        if (m + NGW < T) { const int mn = m + NGW;
#pragma unroll
            for (int j = 0; j < 4; ++j) { const int c0 = 512 * j + 8 * lane; nhw[j] = *(const u32x4*)(hb + (size_t)mn * D + c0);
#pragma unroll
                for (int k = 0; k < 4; ++k) { nyw[j][k] = *(const u32x2*)(YS + ((size_t)mn * 4 + k) * D + c0); nys[j][k] = ysm[((size_t)mn * 4 + k) * 64 + 16 * j + (lane >> 2)]; } } }
#pragma unroll
        for (int j = 0; j < 4; ++j) { const int c0 = 512 * j + 8 * lane; *(u32x4*)(hr + c0) = pg8::pack8(v[j][0], v[j][1]);
#pragma unroll
            for (int q = 0; q < 2; ++q) s += (v[j][q].x * v[j][q].x + v[j][q].y * v[j][q].y) + (v[j][q].z * v[j][q].z + v[j][q].w * v[j][q].w); }
        const float rstd = 1.0f / sqrtf(wave_sum(s) * (1.f / D) + EPS); float amax = 0.f;
#pragma unroll
        for (int j = 0; j < 4; ++j) { v[j][0] = v[j][0] * rstd * wv[j][0]; v[j][1] = v[j][1] * rstd * wv[j][1]; amax = amax4(amax4(amax, v[j][0]), v[j][1]); }
        amax = fmaxf(wave_max(amax), 1e-30f); const float qs = 127.0f / amax;
        if (lane == 0) sa3[m] = amax * (1.0f / 127.0f);
#pragma unroll
        for (int j = 0; j < 4; ++j) { u32x2 o; o.x = q8x4m(v[j][0], qs); o.y = q8x4m(v[j][1], qs); *(u32x2*)(XQ + (size_t)m * D + 512 * j + 8 * lane) = o; }
    }
}
__device__ __forceinline__ void rescale_rows(Frame& F, const signed char* ACT, const float* am, signed char* AQ, float* sad, int nrows) {
    const int gw = F.vcu * NWAVES + F.wave, NGW = F.G * NWAVES, lane = F.lane;
    constexpr int R = 4;
    for (int m0 = gw * R; m0 < nrows; m0 += NGW * R) {
        u32x4 w[R][2]; float amx[R];
#pragma unroll
        for (int r = 0; r < R; ++r) { amx[r] = am[(size_t)(m0 + r) * 64 + lane]; w[r][0] = *(const u32x4*)(ACT + (size_t)(m0 + r) * DFF + 32 * lane); w[r][1] = *(const u32x4*)(ACT + (size_t)(m0 + r) * DFF + 32 * lane + 16); }
#pragma unroll
        for (int r = 0; r < R; ++r) { const float amax = fmaxf(wave_max(amx[r]), 1e-30f); const float ratio = amx[r] * __builtin_amdgcn_rcpf(amax);
            if (lane == 0) sad[m0 + r] = amax * (1.0f / 127.0f);
#pragma unroll
            for (int hb = 0; hb < 2; ++hb) { u32x4 o;
#pragma unroll
                for (int c = 0; c < 4; ++c) { const int wv = (int)w[r][hb][c];
                    const f32x4 f = (f32x4){(float)((wv << 24) >> 24), (float)((wv << 16) >> 24), (float)((wv << 8) >> 24), (float)(wv >> 24)}; o[c] = q8x4(f * ratio); }
                *(u32x4*)(AQ + (size_t)(m0 + r) * DFF + 32 * lane + 16 * hb) = o; } }
    }
}

__device__ __forceinline__ void phase_skew(int slot, int ticks_per_slot) {
    const unsigned long long t0 = __builtin_amdgcn_s_memrealtime(); const unsigned long long d = (unsigned long long)(slot * ticks_per_slot);
    while (__builtin_amdgcn_s_memrealtime() - t0 < d) __builtin_amdgcn_s_sleep(8);
}
__device__ __forceinline__ void ph_gemm1(Frame& F, const Args& a) {
    pg8::DenseSched S{(const bf16_t*)(F.ws + WS_XN), (const bf16_t*)(F.ws + WS_WIN), T / 256, NPROJ / 256, F.G, (int)blockIdx.x}; pg8::EpiProjI8 E{(bf16_t*)(F.ws + WS_PROJ), NPROJ, (const float*)(F.ws + WS_SA1), (const float*)(F.ws + WS_SWIN)};
    struct QHook { const Args* a; unsigned char* ws; LAS float* wmax; int G, c, wave, lane, nx, s0;
        __device__ __forceinline__ int job_of(int ui) const { if (ui < s0) return ui * G + c; return c >= nx ? s0 * G + (ui - s0) * (G - nx) + (c - nx) : QJ_HOOK; }
        __device__ __forceinline__ void operator()(int ui) const { const int job = job_of(ui); if (job < QJ_HOOK) quant_job(*a, ws, wmax, job, wave, lane); } };
    const int nunits = (T / 256) * (NPROJ / 256), nx = nunits % F.G, c = (int)blockIdx.x; int s0 = (QJ_HOOK - 2 * (F.G - nx)) / F.G; s0 = s0 < 0 ? 0 : s0;
    QHook H{&a, F.ws, (LAS float*)(F.lds + TAB_OFF), F.G, c, F.wave, F.lane, nx, s0};
    pg8::gemm_phase(F.lds, D, S, E, H);
    for (int ui = (nunits - c + F.G - 1) / F.G; H.job_of(ui) < QJ_HOOK; ++ui) H(ui); }
__device__ __forceinline__ void ph_mlstm(Frame& F, const Args& a) {
    const int half = F.G / 2;
    if (F.vcu < half) { for (int u = F.vcu; u < ml::NUNIT; u += half) ml::mlstm_unit(F.lds, (const bf16_t*)(F.ws + WS_PROJ), (bf16_t*)(F.ws + WS_HML), (float*)(F.ws + WS_GATES) + (size_t)u * ml::NC * 256, a.in[4], a.in[5], u >> 5, (u >> 2) & 7, u & 3); }
    else { for (int u = F.vcu - half; u < 1024; u += F.G - half) swa::swa_unit(F.lds, (const bf16_t*)(F.ws + WS_PROJ), (bf16_t*)(F.ws + WS_ASW), a.in[7], a.in[8], a.in[9], u >> 8, (u >> 2) & 63, u & 3);
        for (int job = QJ_HOOK + (F.vcu - half); job < QJ_ALL; job += F.G - half) quant_job(a, F.ws, (LAS float*)(F.lds + TAB_OFF), job, F.wave, F.lane); } }
__device__ __forceinline__ void ph_norm_swa(Frame& F, const Args& a) {
    ml_norm_rows(F, a);
    asw_quant_rows(F); }
__device__ __forceinline__ void ph_ya(Frame& F, const Args& a) {
    pg8::DenseSched S{(const bf16_t*)(F.ws + WS_AMLQ), (const bf16_t*)(F.ws + WS_WA), T / 256, D / 256, F.G, (int)blockIdx.x};
    pg8::EpiGate<false, true> E{(bf16_t*)(F.ws + WS_YA), (const bf16_t*)(F.ws + WS_PROJ) + C_GA, NPROJ, nullptr, (const float*)(F.ws + WS_SAML), (const float*)(F.ws + WS_SWA), nullptr}; pg8::gemm_phase(F.lds, D, S, E); }
__device__ __forceinline__ void ph_mix(Frame& F, const Args& a) {
    pg8::DenseSched S{(const bf16_t*)(F.ws + WS_ASWQ), (const bf16_t*)(F.ws + WS_WB), T / 256, D / 256, F.G, (int)blockIdx.x};
    pg8::EpiGate<true, true, true> E{(bf16_t*)(F.ws + WS_MIX), (const bf16_t*)(F.ws + WS_PROJ) + C_GB, NPROJ, (const bf16_t*)(F.ws + WS_YA), (const float*)(F.ws + WS_SASW), (const float*)(F.ws + WS_SWB), (float*)(F.ws + WS_AMAXM)}; pg8::gemm_phase(F.lds, D, S, E); }
__device__ __forceinline__ void ph_ya_mix(Frame& F, const Args& a) { ph_ya(F, a); ph_mix(F, a); }
__device__ __forceinline__ void ph_mixq(Frame& F, const Args& a) {
    rescale_rows(F, (const signed char*)(F.ws + WS_MIX), (const float*)(F.ws + WS_AMAXM), (signed char*)(F.ws + WS_MIXQ), (float*)(F.ws + WS_SMIX), T); }
__device__ __forceinline__ void ph_h1(Frame& F, const Args& a) {
    pg8::DenseSched S{(const bf16_t*)(F.ws + WS_MIXQ), (const bf16_t*)(F.ws + WS_WOUT), T / 256, D / 256, F.G, (int)blockIdx.x}; pg8::EpiResF32 E{a.in[0], (bf16_t*)(F.ws + WS_H), (const float*)(F.ws + WS_SMIX), (const float*)(F.ws + WS_SWOUT)}; pg8::gemm_phase(F.lds, D, S, E); }
__device__ __forceinline__ void ph_up(Frame& F, const Args& a) {
    const int nrt = moe::build_tables(F.lds + TAB_OFF, F.ctl + CW_CUR);
    moe::Tables tb{(const LAS int*)(F.lds + TAB_OFF), (const LAS int*)(F.lds + TAB_OFF + 256), (const LAS int*)(F.lds + TAB_OFF + 512)};
    moe::UpSched S{(const void*)(F.ws + WS_XN), (const void*)(F.ws + WS_WUP), (const int*)(F.ws + WS_TOKL), tb, nrt, 2 * DFF / 256, F.G, (int)blockIdx.x}; moe::EpiUp E{(signed char*)(F.ws + WS_ACT), a.in[17], (const float*)(F.ws + WS_RSL), (const float*)(F.ws + WS_SWUP), (float*)(F.ws + WS_AMAX)}; pg8::gemm_phase(F.lds, D, S, E); }
__device__ __forceinline__ void ph_actq(Frame& F, const Args& a) {
    const int nrt = moe::build_tables(F.lds + TAB_OFF, F.ctl + CW_CUR); rescale_rows(F, (const signed char*)(F.ws + WS_ACT), (const float*)(F.ws + WS_AMAX), (signed char*)(F.ws + WS_ACTQ), (float*)(F.ws + WS_SAD), nrt * 256); }
__device__ __forceinline__ void ph_down(Frame& F, const Args& a) {
    const int nrt = moe::build_tables(F.lds + TAB_OFF, F.ctl + CW_CUR);
    moe::Tables tb{(const LAS int*)(F.lds + TAB_OFF), (const LAS int*)(F.lds + TAB_OFF + 256), (const LAS int*)(F.lds + TAB_OFF + 512)};
    moe::DownSched S{(const bf16_t*)(F.ws + WS_ACTQ), (const bf16_t*)(F.ws + WS_WDN), tb, nrt, D / 256, F.G, (int)blockIdx.x};
    moe::EpiDown E{(signed char*)(F.ws + WS_YS), (float*)(F.ws + WS_YS + 256 * MiB), a.in[19], (const float*)(F.ws + WS_GATEL), (const int*)(F.ws + WS_DESTL), (const float*)(F.ws + WS_SAD), (const float*)(F.ws + WS_SWDN)}; pg8::gemm_phase(F.lds, DFF, S, E); }
__device__ __forceinline__ void ph_combine_pp(Frame& F, const Args& a) {
    combine_rows(F, a);
    pg8::DenseSched S{(const bf16_t*)(F.ws + WS_PBF), (const bf16_t*)(F.ws + WS_WPP), T / 256, D / 256, F.G, (int)blockIdx.x}; pg8::EpiStoreQ8 E{(signed char*)(F.ws + WS_PP), (float*)(F.ws + WS_PP + 64 * MiB)}; int kb = PLE * 2; asm volatile("" : "+s"(kb));
    pg8::gemm_phase(F.lds, kb, S, E); }
__device__ __forceinline__ void ph_out(Frame& F, const Args& a) {
    pg8::DenseSched S{(const bf16_t*)(F.ws + WS_XN), (const bf16_t*)(F.ws + WS_WPG), T / 256, D / 256, F.G, (int)blockIdx.x}; pg8::EpiPle E{a.out, (const bf16_t*)(F.ws + WS_H), (const signed char*)(F.ws + WS_PP), (const float*)(F.ws + WS_PP + 64 * MiB), (const float*)(F.ws + WS_SA3), (const float*)(F.ws + WS_SWPG)}; pg8::gemm_phase(F.lds, D, S, E); }

constexpr int NPHASE = 13;
__global__ void __launch_bounds__(NWAVES * 64, 2) mk_fwd(Args args) {
    extern __shared__ __attribute__((aligned(16))) unsigned char lds_raw[];
    Frame F;
    F.lds = (LAS unsigned char*)lds_raw;
    F.tid = threadIdx.x; F.lane = F.tid & 63; F.wave = __builtin_amdgcn_readfirstlane(F.tid >> 6);
    F.G = gridDim.x; { const int bx = blockIdx.x; F.vcu = (F.G % 8 == 0) ? (bx % 8) * (F.G / 8) + bx / 8 : bx; }
    F.ws = args.ws; F.ctl = (unsigned*)(args.ws + WS_CTL);
    volatile LAS unsigned* MISC = (volatile LAS unsigned*)(F.lds + MISC_OFF);
    for (int u = F.tid; u < 64; u += NWAVES * 64) MISC[u] = 0u;
    __syncthreads();
    XcdBarrier bar; bar.bar = F.ctl + CW_BAR; bar.x = 0; bar.st = nullptr;
    if (MK_N_LAUNCHES == 1) bar = xcd_barrier_post(F.ctl + CW_BAR, MISC + 8);
    unsigned char* ws = args.ws;
    const int lo = args.ph_lo, hi = args.ph_hi;
#define IN(k) (lo <= (k) && (k) < hi)
#ifndef DUP_PHASE
#define DUP_PHASE -1
#endif
#define SEAM(k) do { if (IN(k) && IN((k) + 1)) xcd_barrier(bar); } while (0)

#define RUN(k, call) do { if (IN(k)) { call; if (DUP_PHASE == (k)) { xcd_barrier(bar); call; } } SEAM(k); } while (0)
    RUN(0, p0_prologue(F, args));
    RUN(1, ph_gemm1(F, args));
    RUN(2, ph_mlstm(F, args));
    RUN(3, ph_norm_swa(F, args));
    RUN(4, ph_ya_mix(F, args));
    RUN(5, ph_mixq(F, args));
    RUN(6, ph_h1(F, args));
    RUN(7, route_phase(F, args));
    RUN(8, ph_up(F, args));
    RUN(9, ph_actq(F, args));
    RUN(10, ph_down(F, args));
    RUN(11, ph_combine_pp(F, args));
    if (IN(12)) ph_out(F, args);
#undef RUN
#undef IN
#undef SEAM
}


#ifdef DBG_DUMP
__global__ void dbg_dump(const bf16_t* src, int ld, int coff, float* out) {
    for (size_t i = (size_t)blockIdx.x * blockDim.x + threadIdx.x; i < (size_t)T * D; i += (size_t)gridDim.x * blockDim.x) { const size_t r = i / D, c = i % D; out[i] = bf1(src[r * ld + coff + c]); }
}
#endif
extern "C" void kernel_launch(void* const* d_in, const int* in_sizes, int n_in, void* d_out, int out_size, void* d_ws, size_t ws_size, hipStream_t stream) {
    static int grid = 0;
    if (grid == 0) {
        if (n_in != 23 || in_sizes[0] != T * D || out_size != T * D || ws_size < WS_END) { fprintf(stderr, "kernel_launch: unexpected shapes (n_in %d, in0 %d, out %d, ws %zu; need ws >= %zu); nothing launched\n", n_in, n_in > 0 ? in_sizes[0] : -1, out_size, ws_size, (size_t)WS_END); grid = -1; return; }
        int dev = 0, cus = 0, per_cu = 0;
        if (hipGetDevice(&dev) != hipSuccess || hipDeviceGetAttribute(&cus, hipDeviceAttributeMultiprocessorCount, dev) != hipSuccess) { fprintf(stderr, "kernel_launch: device query failed\n"); grid = -1; return; }
        if (hipFuncSetAttribute((const void*)mk_fwd, hipFuncAttributeMaxDynamicSharedMemorySize, LDS_BYTES) != hipSuccess) { fprintf(stderr, "kernel_launch: hipFuncSetAttribute failed\n"); grid = -1; return; }
        if (hipOccupancyMaxActiveBlocksPerMultiprocessor(&per_cu, (const void*)mk_fwd, NWAVES * 64, LDS_BYTES) != hipSuccess || per_cu < 1) fprintf(stderr, "kernel_launch: occupancy query reports %d workgroups per CU\n", per_cu);
        (void)hipGetLastError();
        grid = cus;
    }
    if (grid < 0) return;
    if (hipMemsetAsync((char*)d_ws + WS_CTL, 0, CTL_ZERO_BYTES, stream) != hipSuccess) { fprintf(stderr, "kernel_launch: memset failed\n"); return; }
    Args a{};
    for (int i = 0; i < 23; ++i) a.in[i] = (const float*)d_in[i];
    a.out = (float*)d_out; a.ws = (unsigned char*)d_ws;
#ifndef DBG_LAST
#define DBG_LAST NPHASE
#endif
    for (int li = 0; li < MK_N_LAUNCHES && li < DBG_LAST; ++li) {
        a.ph_lo = (MK_N_LAUNCHES == 1) ? 0 : li; a.ph_hi = (MK_N_LAUNCHES == 1) ? NPHASE : li + 1;
        hipLaunchKernelGGL(mk_fwd, dim3(grid), dim3(NWAVES * 64), LDS_BYTES, stream, a);
        const hipError_t le = hipPeekAtLastError();
        if (le != hipSuccess) { fprintf(stderr, "kernel_launch: launch %d failed: %s\n", li, hipGetErrorName(le)); break; }
    }
#ifdef DBG_DUMP
    { const bf16_t* s = (const bf16_t*)((unsigned char*)d_ws + DBG_DUMP_OFF); hipLaunchKernelGGL(dbg_dump, dim3(2048), dim3(256), 0, stream, s, DBG_DUMP_LD, DBG_DUMP_COL, (float*)d_out); }
#endif
}
```
